# Optimizing an MI355X kernel written in HIP

```python
import jax
import jax.numpy as jnp
from jax import lax
import numpy as np

D_MODEL = 1024
BATCH = 4
SEQ = 8192
DEPTH = 4

CTX_LEN = 256
GRID_W = 64
HEAD_DIM = 64
NA_HEADS = 8
NA_WIDTH = NA_HEADS * HEAD_DIM
NA_KH = 8
NA_KW = 16
LRU_WIDTH = D_MODEL // 2
LRU_BLOCKS = 8
LRU_BLOCK_DIM = LRU_WIDTH // LRU_BLOCKS
LRU_C = 8.0
CONV_W = 4
SWA_Q_HEADS = 8
SWA_KV_HEADS = 2
SWA_Q_WIDTH = SWA_Q_HEADS * HEAD_DIM
SWA_KV_WIDTH = SWA_KV_HEADS * HEAD_DIM
SWA_WINDOW = 128
SWA_BLOCK = 128
ROPE_BASE = 10000.0
D_FF = 4 * D_MODEL
NORM_EPS = 1e-6
MASK_VALUE = -1e30
IN_SIZES = (NA_WIDTH, NA_WIDTH, NA_WIDTH, LRU_WIDTH, LRU_WIDTH, SWA_Q_WIDTH, SWA_KV_WIDTH, SWA_KV_WIDTH, D_MODEL, D_MODEL, D_MODEL)
IN_SPLITS = tuple(sum(IN_SIZES[:i + 1]) for i in range(len(IN_SIZES) - 1))
IN_WIDTH = sum(IN_SIZES)
BRANCH_SIZES = (NA_WIDTH, LRU_WIDTH, SWA_Q_WIDTH)
BRANCH_SPLITS = (NA_WIDTH, NA_WIDTH + LRU_WIDTH)
MIX_WIDTH = sum(BRANCH_SIZES)

kernel_name = 'hybrid_natten_rglru_swa_prefix_dit'


def rms_norm(x, g):
    xf = x.astype(jnp.float32)
    y = xf * lax.rsqrt(jnp.mean(xf * xf, axis=-1, keepdims=True) + NORM_EPS)
    return (y * g.astype(jnp.float32)).astype(x.dtype)


def modulate(h, shift, scale):
    return h * (1 + scale) + shift


def heads(t, n):
    return t.reshape(*t.shape[:-1], n, HEAD_DIM)


def axial_rope(n_tokens):
    t = jnp.arange(n_tokens, dtype=jnp.int32)
    row = (t // GRID_W).astype(jnp.float32)
    col = (t % GRID_W).astype(jnp.float32)
    n_freq = HEAD_DIM // 4
    inv_freq = ROPE_BASE ** (-jnp.arange(n_freq, dtype=jnp.float32) / n_freq)
    ang = jnp.concatenate([row[:, None] * inv_freq, col[:, None] * inv_freq], axis=-1)
    return jnp.cos(ang), jnp.sin(ang)


def apply_rope(t, cos, sin):
    tf = t.astype(jnp.float32)
    half = HEAD_DIM // 2
    t1, t2 = tf[..., :half], tf[..., half:]
    cs, sn = cos[None, :, None, :], sin[None, :, None, :]
    return jnp.concatenate([t1 * cs - t2 * sn, t2 * cs + t1 * sn], axis=-1).astype(t.dtype)


def context_attention(q, k, v, sink):
    B, T, H, d = q.shape
    G = k.shape[2]
    R = H // G
    qg = q.reshape(B, T, G, R, d)
    s = jnp.einsum('btgrd,bsgd->bgrts', qg, k, preferred_element_type=jnp.float32) * (d ** -0.5)
    if sink is not None:
        sk = jnp.broadcast_to(sink.astype(jnp.float32).reshape(1, G, R, 1, 1), (B, G, R, T, 1))
        s = jnp.concatenate([s, sk], axis=-1)
    p = jax.nn.softmax(s, axis=-1)
    if sink is not None:
        p = p[..., :-1]
    o = jnp.einsum('bgrts,bsgd->btgrd', p.astype(v.dtype), v)
    return o.reshape(B, T, H, d)


def neighbourhood_attention(q, k, v, kc, vc, rpb):
    B, S, H, d = q.shape
    rows = S // GRID_W
    kh = min(NA_KH, rows)
    kw = NA_KW
    scale = d ** -0.5
    qg = q.reshape(B, rows, GRID_W, H, d)
    kg = k.reshape(B, rows, GRID_W, H, d)
    vg = v.reshape(B, rows, GRID_W, H, d)
    col = np.arange(GRID_W)
    col_start = np.clip(col - kw // 2, 0, GRID_W - kw)
    col_idx = col_start[:, None] + np.arange(kw)[None, :]
    dc = col_idx - col[:, None] + (NA_KW - 1)
    rpb_c = rpb[:, :, dc]

    def one_row(r):
        rs = jnp.clip(r - kh // 2, 0, rows - kh)
        kn = lax.dynamic_slice_in_dim(kg, rs, kh, axis=1)[:, :, col_idx]
        vn = lax.dynamic_slice_in_dim(vg, rs, kh, axis=1)[:, :, col_idx]
        qr = lax.dynamic_index_in_dim(qg, r, axis=1, keepdims=False)
        s_loc = jnp.einsum('bwhd,biwjhd->bhwij', qr, kn, preferred_element_type=jnp.float32) * scale
        dr = rs + jnp.arange(kh) - r + (NA_KH - 1)
        bias = jnp.take(rpb_c, dr, axis=1).transpose(0, 2, 1, 3)
        s_loc = s_loc + bias.astype(jnp.float32)[None]
        s_ctx = jnp.einsum('bwhd,bchd->bhwc', qr, kc, preferred_element_type=jnp.float32) * scale
        logits = jnp.concatenate([s_loc.reshape(B, H, GRID_W, kh * kw), s_ctx], axis=-1)
        p = jax.nn.softmax(logits, axis=-1)
        p_loc = p[..., :kh * kw].reshape(B, H, GRID_W, kh, kw).astype(v.dtype)
        p_ctx = p[..., kh * kw:].astype(v.dtype)
        return (jnp.einsum('bhwij,biwjhd->bwhd', p_loc, vn)
                + jnp.einsum('bhwc,bchd->bwhd', p_ctx, vc))

    out = lax.map(one_row, jnp.arange(rows))
    return out.transpose(1, 0, 2, 3, 4).reshape(B, S, H, d)


def sliding_window_attention(q, k, v, kc, vc, sink):
    B, S, H, d = q.shape
    G = k.shape[2]
    R = H // G
    blk = SWA_BLOCK
    nb = S // blk
    qb = q.reshape(B, nb, blk, G, R, d)

    def band(t):
        tp = jnp.pad(t, ((0, 0), (blk, blk), (0, 0), (0, 0))).reshape(B, nb + 2, blk, G, d)
        return jnp.concatenate([tp[:, :-2], tp[:, 1:-1], tp[:, 2:]], axis=2)

    kb, vb = band(k), band(v)
    qpos = np.arange(blk)[:, None]
    kpos = np.arange(3 * blk)[None, :] - blk
    kabs = np.arange(nb)[:, None] * blk + kpos
    valid = ((np.abs(kpos - qpos) <= SWA_WINDOW)[None]
             & ((kabs >= 0) & (kabs < S))[:, None, :])
    scale = d ** -0.5
    s_loc = jnp.einsum('bnqgrd,bnkgd->bngrqk', qb, kb, preferred_element_type=jnp.float32) * scale
    s_loc = jnp.where(valid[None, :, None, None], s_loc, MASK_VALUE)
    s_ctx = jnp.einsum('bnqgrd,bcgd->bngrqc', qb, kc, preferred_element_type=jnp.float32) * scale
    sk = jnp.broadcast_to(sink.astype(jnp.float32).reshape(1, 1, G, R, 1, 1), (B, nb, G, R, blk, 1))
    p = jax.nn.softmax(jnp.concatenate([s_loc, s_ctx, sk], axis=-1), axis=-1)
    n_loc = 3 * blk
    p_loc = p[..., :n_loc].astype(v.dtype)
    p_ctx = p[..., n_loc:-1].astype(v.dtype)
    o = (jnp.einsum('bngrqk,bnkgd->bnqgrd', p_loc, vb)
         + jnp.einsum('bngrqc,bcgd->bnqgrd', p_ctx, vc))
    return o.reshape(B, S, H, d)


def centred_dwconv(x, w, b):
    T = x.shape[1]
    left = CONV_W // 2
    right = CONV_W - 1 - left
    xp = jnp.pad(x, ((0, 0), (left, right), (0, 0)))
    y = xp[:, 0:T] * w[0]
    for i in range(1, CONV_W):
        y = y + xp[:, i:i + T] * w[i]
    return y + b


def block_diag_linear(x, w, b):
    xb = x.reshape(*x.shape[:-1], LRU_BLOCKS, LRU_BLOCK_DIM)
    y = jnp.einsum('...nc,ncd->...nd', xb, w)
    return y.reshape(x.shape) + b


def rglru_coeffs(u, w_a, b_a, w_x, b_x, lam):
    r = jax.nn.sigmoid(block_diag_linear(u, w_a, b_a).astype(jnp.float32))
    i = jax.nn.sigmoid(block_diag_linear(u, w_x, b_x).astype(jnp.float32))
    log_a = -LRU_C * r * jax.nn.softplus(-lam.astype(jnp.float32))
    a = jnp.exp(log_a)
    mult = jnp.sqrt(-jnp.expm1(2.0 * log_a))
    return a, mult * i * u.astype(jnp.float32)


def linear_scan(a, b, h0, reverse):
    if reverse:
        a, b = jnp.flip(a, axis=1), jnp.flip(b, axis=1)
    b = b.at[:, 0].add(a[:, 0] * h0)

    def combine(l, r):
        return l[0] * r[0], r[0] * l[1] + r[1]

    _, h = lax.associative_scan(combine, (a, b), axis=1)
    return jnp.flip(h, axis=1) if reverse else h


def rg_lru_bidirectional(u_lat, u_ctx, w_a, b_a, w_x, b_x, lam):
    B, _, C = u_lat.shape
    y_lat = jnp.zeros(u_lat.shape, jnp.float32)
    y_ctx = jnp.zeros(u_ctx.shape, jnp.float32)
    for d in range(2):
        rev = d == 1
        a_c, b_c = rglru_coeffs(u_ctx, w_a[d], b_a[d], w_x[d], b_x[d], lam[d])
        h_c = linear_scan(a_c, b_c, jnp.zeros((B, C), jnp.float32), rev)
        h_c_final = h_c[:, 0] if rev else h_c[:, -1]
        a_l, b_l = rglru_coeffs(u_lat, w_a[d], b_a[d], w_x[d], b_x[d], lam[d])
        h_l = linear_scan(a_l, b_l, h_c_final, rev)
        y_lat = y_lat + h_l
        y_ctx = y_ctx + h_c
    return y_lat, y_ctx


def merge_branches(ys, gates, w_branch, w_out):
    w_parts = jnp.split(w_branch, BRANCH_SPLITS, axis=0)
    m = jax.nn.sigmoid(gates[0]) * (ys[0] @ w_parts[0])
    for y, g, w in zip(ys[1:], gates[1:], w_parts[1:]):
        m = m + jax.nn.sigmoid(g) * (y @ w)
    return m @ w_out


def sq_relu_mlp(h, w1, w2):
    return jnp.square(jax.nn.relu(h @ w1)) @ w2


def setup_inputs(seed: int = 0) -> dict:
    key = jax.random.key(seed)
    ks = jax.random.split(key, 24)
    f32 = jnp.float32
    L = DEPTH

    def nrm(k, shape, s):
        return s * jax.random.normal(k, shape, f32)

    u = jax.random.uniform(ks[16], (L, 2, LRU_WIDTH), f32, 0.9, 0.999)
    a0 = u ** (1.0 / LRU_C)
    lru_lambda = jnp.log(a0) - jnp.log1p(-a0)
    return {
        'x': nrm(ks[0], (BATCH, SEQ, D_MODEL), 1.0),
        'c': nrm(ks[1], (BATCH, D_MODEL), 1.0),
        'ctx': nrm(ks[2], (BATCH, CTX_LEN, D_MODEL), 1.0),
        'c_ctx': nrm(ks[3], (D_MODEL,), 1.0),
        'w_mod': nrm(ks[4], (L, D_MODEL, 6 * D_MODEL), 0.5 * D_MODEL ** -0.5),
        'b_mod': nrm(ks[5], (L, 6 * D_MODEL), 0.02),
        'norm1_g': 1.0 + nrm(ks[6], (L, D_MODEL), 0.05),
        'norm2_g': 1.0 + nrm(ks[7], (L, D_MODEL), 0.05),
        'w_in': nrm(ks[8], (L, D_MODEL, IN_WIDTH), D_MODEL ** -0.5),
        'na_rpb': nrm(ks[9], (L, NA_HEADS, 2 * NA_KH - 1, 2 * NA_KW - 1), 0.1),
        'conv_w': nrm(ks[10], (L, CONV_W, LRU_WIDTH), CONV_W ** -0.5),
        'conv_b': nrm(ks[11], (L, LRU_WIDTH), 0.01),
        'lru_wa': nrm(ks[12], (L, 2, LRU_BLOCKS, LRU_BLOCK_DIM, LRU_BLOCK_DIM), LRU_BLOCK_DIM ** -0.5),
        'lru_ba': nrm(ks[13], (L, 2, LRU_WIDTH), 0.01),
        'lru_wx': nrm(ks[14], (L, 2, LRU_BLOCKS, LRU_BLOCK_DIM, LRU_BLOCK_DIM), LRU_BLOCK_DIM ** -0.5),
        'lru_bx': nrm(ks[15], (L, 2, LRU_WIDTH), 0.01),
        'lru_lambda': lru_lambda,
        'swa_sink': nrm(ks[17], (L, SWA_Q_HEADS), 0.5),
        'w_branch': nrm(ks[18], (L, MIX_WIDTH, D_MODEL), NA_WIDTH ** -0.5),
        'w_out': nrm(ks[19], (L, D_MODEL, D_MODEL), D_MODEL ** -0.5),
        'w_ff1': nrm(ks[20], (L, D_MODEL, D_FF), D_MODEL ** -0.5),
        'w_ff2': nrm(ks[21], (L, D_FF, D_MODEL), D_FF ** -0.5),
        'final_g': 1.0 + nrm(ks[22], (D_MODEL,), 0.05),
    }


def reference(x, c, ctx, c_ctx, w_mod, b_mod, norm1_g, norm2_g, w_in, na_rpb, conv_w, conv_b,
              lru_wa, lru_ba, lru_wx, lru_bx, lru_lambda, swa_sink, w_branch, w_out, w_ff1, w_ff2, final_g):
    dt = x.dtype
    B, S, _ = x.shape
    rope_cos, rope_sin = axial_rope(S)
    cond_lat = jax.nn.silu(c)[:, None, :]
    cond_ctx = jax.nn.silu(c_ctx)[None, None, :]
    xc = ctx
    for l in range(DEPTH):
        update_ctx = l < DEPTH - 1
        mod_l = jnp.split(cond_lat @ w_mod[l] + b_mod[l], 6, axis=-1)
        mod_c = jnp.split(cond_ctx @ w_mod[l] + b_mod[l], 6, axis=-1)

        h = modulate(rms_norm(x, norm1_g[l]), mod_l[0], mod_l[1])
        hc = modulate(rms_norm(xc, norm1_g[l]), mod_c[0], mod_c[1])
        qa, ka, va, xb, gb, qs, ks, vs, ga, gr, gs = jnp.split(h @ w_in[l], IN_SPLITS, axis=-1)
        qac, kac, vac, xbc, gbc, qsc, ksc, vsc, gac, grc, gsc = jnp.split(hc @ w_in[l], IN_SPLITS, axis=-1)

        kac_h, vac_h = heads(kac, NA_HEADS), heads(vac, NA_HEADS)
        y_a = neighbourhood_attention(heads(qa, NA_HEADS), heads(ka, NA_HEADS), heads(va, NA_HEADS),
                                      kac_h, vac_h, na_rpb[l]).reshape(B, S, NA_WIDTH)

        u_lat = centred_dwconv(xb, conv_w[l], conv_b[l])
        u_ctx = centred_dwconv(xbc, conv_w[l], conv_b[l])
        r_lat, r_ctx = rg_lru_bidirectional(u_lat, u_ctx, lru_wa[l], lru_ba[l], lru_wx[l], lru_bx[l], lru_lambda[l])
        y_b = r_lat.astype(dt) * jax.nn.gelu(gb)

        ksc_h, vsc_h = heads(ksc, SWA_KV_HEADS), heads(vsc, SWA_KV_HEADS)
        qs_r = apply_rope(heads(qs, SWA_Q_HEADS), rope_cos, rope_sin)
        ks_r = apply_rope(heads(ks, SWA_KV_HEADS), rope_cos, rope_sin)
        y_c = sliding_window_attention(qs_r, ks_r, heads(vs, SWA_KV_HEADS), ksc_h, vsc_h,
                                       swa_sink[l]).reshape(B, S, SWA_Q_WIDTH)

        x = x + mod_l[2] * merge_branches((y_a, y_b, y_c), (ga, gr, gs), w_branch[l], w_out[l])
        if update_ctx:
            y_ac = context_attention(heads(qac, NA_HEADS), kac_h, vac_h, None).reshape(B, -1, NA_WIDTH)
            y_bc = r_ctx.astype(dt) * jax.nn.gelu(gbc)
            y_cc = context_attention(heads(qsc, SWA_Q_HEADS), ksc_h, vsc_h, swa_sink[l]).reshape(B, -1, SWA_Q_WIDTH)
            xc = xc + mod_c[2] * merge_branches((y_ac, y_bc, y_cc), (gac, grc, gsc), w_branch[l], w_out[l])

        h2 = modulate(rms_norm(x, norm2_g[l]), mod_l[3], mod_l[4])
        x = x + mod_l[5] * sq_relu_mlp(h2, w_ff1[l], w_ff2[l])
        if update_ctx:
            h2c = modulate(rms_norm(xc, norm2_g[l]), mod_c[3], mod_c[4])
            xc = xc + mod_c[5] * sq_relu_mlp(h2c, w_ff1[l], w_ff2[l])
    return rms_norm(x, final_g)
```

```cpp
#include <hip/hip_runtime.h>
#include <hip/hip_cooperative_groups.h>
#include <cstdio>
#include <cstdint>
namespace cg = cooperative_groups;

#ifndef N_LAUNCHES
#define N_LAUNCHES 1
#endif

#define LAS __attribute__((address_space(3)))
typedef unsigned short bf16_t;
typedef short bf16x8 __attribute__((ext_vector_type(8)));
typedef short s16x4 __attribute__((ext_vector_type(4)));
typedef float f32x4 __attribute__((ext_vector_type(4)));
typedef unsigned u32x4 __attribute__((ext_vector_type(4)));
typedef unsigned u32x2 __attribute__((ext_vector_type(2)));

constexpr int D = 1024, NB = 4, S = 8192, CTX = 256, ML = NB * S, MC = NB * CTX, MT = ML + MC, NL = 4, DFF = 4096;
constexpr int PW = 5760;
constexpr int C_QA = 0, C_KA = 512, C_XB = 1024, C_GB = 1536, C_QS = 2048, C_KS = 2560, C_GA = 2688, C_GR = 3712, C_GS = 4736;
constexpr int VTOK = 8448;
constexpr int WIN = 6400;
constexpr size_t MiB = 1u << 20;
constexpr size_t WS_XC = 0, WS_H = 4 * MiB, WS_P = 70 * MiB, WS_VTA = WS_P + (size_t)MT * PW * 2, WS_VTS = WS_VTA + (size_t)NB * 8 * 64 * VTOK * 2,
                 WS_WB = WS_VTS + (size_t)NB * 2 * 64 * VTOK * 2, WS_MOD = WS_WB + 21 * MiB, WS_SUM = WS_MOD + MiB / 2, WS_LW = WS_SUM + 5 * MiB / 2, WS_END = WS_LW + MiB;
constexpr int WB_BR = 0, WB_OUT = 3 * 524288, WB_FF1 = WB_OUT + 1048576, WB_FF2 = WB_FF1 + 4194304;
constexpr int LDS_BYTES = 131072;
constexpr float LOG2E = 1.4426950408889634f;
constexpr float NEGBIG = -3.0e38f;

struct KArgs {
    const float *x, *c, *ctx, *c_ctx, *w_mod, *b_mod, *norm1_g, *norm2_g, *w_in, *na_rpb, *conv_w, *conv_b, *lru_wa, *lru_ba, *lru_wx, *lru_bx, *lru_lambda,
        *swa_sink, *w_branch, *w_out, *w_ff1, *w_ff2, *final_g;
    float* out; unsigned char* ws; int ph_lo, ph_hi;
};

__device__ __forceinline__ unsigned pk2(float lo, float hi) { unsigned r; asm("v_cvt_pk_bf16_f32 %0, %1, %2" : "=v"(r) : "v"(lo), "v"(hi)); return r; }
__device__ __forceinline__ float bf2f(unsigned short b) { return __uint_as_float(((unsigned)b) << 16); }
__device__ __forceinline__ float bflo(unsigned w) { return __uint_as_float(w << 16); }
__device__ __forceinline__ float bfhi(unsigned w) { return __uint_as_float(w & 0xffff0000u); }
__device__ __forceinline__ float fexp2(float x) { return __builtin_amdgcn_exp2f(x); }
__device__ __forceinline__ float frcp(float x) { return __builtin_amdgcn_rcpf(x); }
__device__ __forceinline__ float wave_sum(float v) {
#pragma unroll
    for (int o = 1; o < 64; o <<= 1) v += __shfl_xor(v, o);
    return v;
}
#define MFMA16(a, b, c) __builtin_amdgcn_mfma_f32_16x16x32_bf16((a), (b), (c), 0, 0, 0)

namespace pg8 {
constexpr int BM = 256, BK = 64, HALF = 128, HTB = HALF * BK * 2, STAGE_BYTES = 8 * HTB, NXCD = 8, WGM = 8;
__host__ __device__ __forceinline__ int lds_byte(int r, int c) { const int st = (r >> 4) * 2 + (c >> 5), rr = r & 15, cc = c & 31, ob = rr * 64 + cc * 2; return st * 1024 + (ob ^ (((ob >> 9) & 1) << 5)); }
__host__ __device__ __forceinline__ void stage_rc(int b, int& R, int& C) { const int st = b / 1024, sb = b % 1024, swz = sb ^ (((sb >> 9) & 1) << 5); R = (st >> 1) * 16 + swz / 64; C = (st & 1) * 32 + (swz % 64) / 2; }
__host__ __device__ __forceinline__ int perm32(int rho) { const int n = rho >> 4, i = rho & 15; return 8 * (i >> 2) + 4 * n + (i & 3); }

struct Unit { int pm, pn, sub; };
struct Gemm { const bf16_t* A; const bf16_t* Bt; int nsub; };
struct Order {
    int nM, nN, nwg, G, c, nsub;
    __device__ void init(int M, int N, int G_, int c_, int nsub_) { nM = M / BM; nN = N / BM; nwg = nM * nN; G = G_; c = c_; nsub = nsub_; }
    __device__ bool next(int i, Unit& u) const {
        const int ti = i / nsub; u.sub = i - ti * nsub;
        const long L = (long)ti * G + c; if (L >= nwg) return false;
        int wgid = (int)L; { const int q = nwg / NXCD, r = nwg % NXCD, xcd = wgid % NXCD, off = wgid / NXCD; wgid = (xcd < r ? xcd * (q + 1) : r * (q + 1) + (xcd - r) * q) + off; }
        const int nig = WGM * nN, gid = wgid / nig, fm = gid * WGM, gsz = (nM - fm) < WGM ? (nM - fm) : WGM;
        u.pm = fm + ((wgid % nig) % gsz); u.pn = (wgid % nig) / gsz; return true;
    }
};

template <class Epi, int LDA, int LDB, int K, int A0 = 0, int A1 = 0, int A2 = 0, int BS = 0>
__device__ __forceinline__ void gemm_phase(LAS unsigned char* lds, const Gemm g, const Order& S, const Epi& E) {
    int tid_ = threadIdx.x; asm volatile("" : "+v"(tid_));
    const int tid = tid_, wid = __builtin_amdgcn_readfirstlane(tid >> 6), lane = tid & 63, wr = wid >> 2, wc = wid & 3, fr = lane & 15, fq = lane >> 4;
    constexpr int nt = K / BK;
    unsigned voffA[2], voffB[2];
#pragma unroll
    for (int i = 0; i < 2; ++i) { int R, C; stage_rc(tid * 16 + i * 8192, R, C); const int Rb = Epi::PERM ? ((R & ~31) + perm32(R & 31)) : R;
        voffA[i] = (unsigned)(R * LDA + C) * 2u; voffB[i] = (unsigned)(Rb * LDB + C) * 2u; }
    constexpr size_t kstep = (size_t)(BK * 2);
    constexpr size_t hstepA = (size_t)HALF * LDA * 2, hstepB = (size_t)HALF * LDB * 2;
    constexpr size_t tstepA = 2 * hstepA, tstepB = 2 * hstepB;
    const unsigned ldsw = (unsigned)wid * 1024u;
    const int aoff = lds_byte(wr * 64 + fr, fq * 8), boff = lds_byte(wc * 32 + fr, fq * 8);
#define PG8_SA(b, h) (((b) * 2 + (h)) * HTB)
#define PG8_SB(b, h) ((4 + (b) * 2 + (h)) * HTB)
#define PG8_STAGE(bufoff, gbase, voff) do { _Pragma("unroll") for (int _i = 0; _i < 2; ++_i) \
        __builtin_amdgcn_global_load_lds((const unsigned*)((const char*)(gbase) + (voff)[_i]), (LAS unsigned*)(lds + (bufoff) + ldsw + _i * 8192), 16, 0, 0); } while (0)
#define PG8_LDA(dst, b, h) do { _Pragma("unroll") for (int m = 0; m < 4; ++m) _Pragma("unroll") for (int k = 0; k < 2; ++k) dst[m][k] = *(const LAS bf16x8*)(lds + PG8_SA(b, h) + aoff + m * 2048 + k * 1024); } while (0)
#define PG8_LDB(dst, b, h) do { _Pragma("unroll") for (int n = 0; n < 2; ++n) _Pragma("unroll") for (int k = 0; k < 2; ++k) dst[n][k] = *(const LAS bf16x8*)(lds + PG8_SB(b, h) + boff + n * 2048 + k * 1024); } while (0)
#define PG8_MMA(ai, bj, At, Bt) do { __builtin_amdgcn_s_setprio(1); _Pragma("unroll") for (int m = 0; m < 4; ++m) _Pragma("unroll") for (int n = 0; n < 2; ++n) _Pragma("unroll") for (int k = 0; k < 2; ++k) \
        acc[ai][bj][m][n] = __builtin_amdgcn_mfma_f32_16x16x32_bf16(Bt[n][k], At[m][k], acc[ai][bj][m][n], 0, 0, 0); __builtin_amdgcn_s_setprio(0); } while (0)
#define PG8_WAIT_V(n) asm volatile("s_waitcnt vmcnt(" #n ")" ::: "memory")
#define PG8_WAIT_L(n) asm volatile("s_waitcnt lgkmcnt(" #n ")" ::: "memory")
#define PG8_BAR __builtin_amdgcn_s_barrier()
#define PG8_SCHED __builtin_amdgcn_sched_barrier(0)
    Unit cur, nxt; int ui = 0;
    if (!S.next(0, cur)) return;
    f32x4 acc[2][2][4][2];
#pragma unroll
    for (int a = 0; a < 2; ++a)
#pragma unroll
        for (int b = 0; b < 2; ++b)
#pragma unroll
            for (int m = 0; m < 4; ++m)
#pragma unroll
                for (int n = 0; n < 2; ++n) acc[a][b][m][n] = (f32x4){0.f, 0.f, 0.f, 0.f};
    bf16x8 At[4][2], B0[2][2], B1[2][2];
    const char* cA = (const char*)(g.A + (cur.sub == 0 ? A0 : (cur.sub == 1 ? A1 : A2))) + (size_t)cur.pm * tstepA; const char* cB = (const char*)(g.Bt + (cur.sub * BS)) + (size_t)cur.pn * tstepB;
    PG8_STAGE(PG8_SB(0, 0), cB, voffB); PG8_STAGE(PG8_SA(0, 0), cA, voffA); PG8_STAGE(PG8_SB(0, 1), cB + hstepB, voffB); PG8_STAGE(PG8_SA(0, 1), cA + hstepA, voffA);
    if (wr == 1) PG8_BAR;
    PG8_WAIT_V(4); PG8_BAR;
    PG8_STAGE(PG8_SB(1, 0), cB + kstep, voffB); PG8_STAGE(PG8_SA(1, 0), cA + kstep, voffA); PG8_STAGE(PG8_SB(1, 1), cB + hstepB + kstep, voffB);
    PG8_WAIT_V(6); PG8_BAR;
    for (;;) {
        const bool has_next = S.next(ui + 1, nxt);
        const char* nA = has_next ? (const char*)(g.A + (nxt.sub == 0 ? A0 : (nxt.sub == 1 ? A1 : A2))) + (size_t)nxt.pm * tstepA : cA; const char* nB = has_next ? (const char*)(g.Bt + (nxt.sub * BS)) + (size_t)nxt.pn * tstepB : cB;
        for (int t = 0; t < nt; t += 2) {
            const bool last = (t == nt - 2);
            const char* a1 = cA + (size_t)(t + 1) * kstep;
            const char* a2 = last ? nA : cA + (size_t)(t + 2) * kstep; const char* b2 = last ? nB : cB + (size_t)(t + 2) * kstep;
            const char* a3 = a2 + kstep; const char* b3 = b2 + kstep;
            PG8_LDB(B0, 0, 0); PG8_SCHED; PG8_LDA(At, 0, 0); PG8_STAGE(PG8_SA(1, 1), a1 + hstepA, voffA);
            PG8_WAIT_L(8); PG8_BAR; PG8_WAIT_L(0); PG8_MMA(0, 0, At, B0); PG8_BAR; PG8_SCHED;
            PG8_LDB(B1, 0, 1); PG8_STAGE(PG8_SB(0, 0), b2, voffB);
            PG8_BAR; PG8_WAIT_L(0); PG8_MMA(0, 1, At, B1); PG8_BAR;
            PG8_LDA(At, 0, 1); PG8_STAGE(PG8_SA(0, 0), a2, voffA);
            PG8_BAR; PG8_WAIT_L(0); PG8_MMA(1, 0, At, B0); PG8_BAR; PG8_SCHED;
            PG8_STAGE(PG8_SB(0, 1), b2 + hstepB, voffB);
            PG8_WAIT_V(6); PG8_BAR; PG8_MMA(1, 1, At, B1); PG8_BAR;
            PG8_LDB(B0, 1, 0); PG8_SCHED; PG8_LDA(At, 1, 0); PG8_STAGE(PG8_SA(0, 1), a2 + hstepA, voffA);
            PG8_WAIT_L(8); PG8_BAR; PG8_WAIT_L(0); PG8_MMA(0, 0, At, B0); PG8_BAR; PG8_SCHED;
            PG8_LDB(B1, 1, 1); PG8_STAGE(PG8_SB(1, 0), b3, voffB);
            PG8_BAR; PG8_WAIT_L(0); PG8_MMA(0, 1, At, B1); PG8_BAR;
            PG8_LDA(At, 1, 1); PG8_STAGE(PG8_SA(1, 0), a3, voffA);
            PG8_BAR; PG8_WAIT_L(0); PG8_MMA(1, 0, At, B0); PG8_BAR; PG8_SCHED;
            PG8_STAGE(PG8_SB(1, 1), b3 + hstepB, voffB);
            PG8_WAIT_V(6); PG8_BAR; PG8_MMA(1, 1, At, B1); PG8_BAR;
        }
        E(acc, cur, wr, wc, fr, fq);
        if (!has_next) break;
        if (!(Epi::KEEP && cur.sub + 1 < g.nsub)) {
#pragma unroll
            for (int a = 0; a < 2; ++a)
#pragma unroll
                for (int b = 0; b < 2; ++b)
#pragma unroll
                    for (int m = 0; m < 4; ++m)
#pragma unroll
                        for (int n = 0; n < 2; ++n) acc[a][b][m][n] = (f32x4){0.f, 0.f, 0.f, 0.f};
        }
        cur = nxt; cA = nA; cB = nB; ++ui;
    }
    PG8_WAIT_V(0);
    if (wr == 0) PG8_BAR;
    PG8_BAR;
#undef PG8_SA
#undef PG8_SB
#undef PG8_STAGE
#undef PG8_LDA
#undef PG8_LDB
#undef PG8_MMA
#undef PG8_WAIT_V
#undef PG8_WAIT_L
#undef PG8_BAR
#undef PG8_SCHED
}
}

typedef f32x4 AccT[2][2][4][2];
struct EpiIn {
    static constexpr bool PERM = true, KEEP = false;
    bf16_t* P; bf16_t* VTa; bf16_t* VTs;
    __device__ __forceinline__ void operator()(AccT& acc, const pg8::Unit& u, int wr, int wc, int fr, int fq) const {
        const int row0 = u.pm * 256 + wr * 64 + fr, trow = u.pm * 256;
        int b, tokbase; if (trow < ML) { b = trow >> 13; tokbase = trow & 8191; } else { b = (trow - ML) >> 8; tokbase = 8192; }
#pragma unroll
        for (int bj = 0; bj < 2; ++bj) {
            int pc = -1;
            if (u.pn < 10) pc = 256 * u.pn + 128 * bj; else if (u.pn == 10) { if (bj == 0) pc = 2560; } else if (u.pn >= 13) pc = 2688 + 256 * (u.pn - 13) + 128 * bj;
            if (pc >= 0) {
#pragma unroll
                for (int ai = 0; ai < 2; ++ai)
#pragma unroll
                    for (int m = 0; m < 4; ++m) { bf16_t* rowp = P + (size_t)(row0 + ai * 128 + m * 16) * PW + pc + wc * 32 + 8 * fq;
                        const f32x4 v0 = acc[ai][bj][m][0], v1 = acc[ai][bj][m][1];
                        u32x4 w; w.x = pk2(v0[0], v0[1]); w.y = pk2(v0[2], v0[3]); w.z = pk2(v1[0], v1[1]); w.w = pk2(v1[2], v1[3]);
                        *(u32x4*)rowp = w; }
            } else {
                const bool isS = (u.pn == 10); bf16_t* VT = isS ? VTs : VTa; const int nh = isS ? 2 : 8;
                const int cl = (isS ? 0 : 256 * (u.pn - 11) + 128 * bj) + 32 * wc + 8 * fq;
#pragma unroll
                for (int ai = 0; ai < 2; ++ai)
#pragma unroll
                    for (int m = 0; m < 4; ++m) { const int tok = tokbase + wr * 64 + fr + ai * 128 + m * 16;
#pragma unroll
                        for (int n = 0; n < 2; ++n) { const f32x4 v = acc[ai][bj][m][n]; const unsigned w0 = pk2(v[0], v[1]), w1 = pk2(v[2], v[3]);
                            const int c = cl + 4 * n; bf16_t* base = VT + ((size_t)(b * nh + (c >> 6)) * 64 + (c & 63)) * VTOK + tok;
                            base[0] = (bf16_t)(w0 & 0xffff); base[VTOK] = (bf16_t)(w0 >> 16); base[2 * VTOK] = (bf16_t)(w1 & 0xffff); base[3 * VTOK] = (bf16_t)(w1 >> 16); } }
            }
        }
    }
};
struct EpiMerge {
    static constexpr bool PERM = true, KEEP = true;
    const bf16_t* P; bf16_t* Mo;
    __device__ __forceinline__ void operator()(AccT& acc, const pg8::Unit& u, int wr, int wc, int fr, int fq) const {
        const int row0 = u.pm * 256 + wr * 64 + fr, col0 = u.pn * 256 + wc * 32 + 8 * fq;
        const int gc = (u.sub == 0) ? C_GA : (u.sub == 1 ? C_GR : C_GS), gn = (u.sub == 0) ? C_GR : C_GS;
        const bool lastsub = (u.sub == 2);
#pragma unroll
        for (int ai = 0; ai < 2; ++ai)
#pragma unroll
            for (int m = 0; m < 4; ++m) { const size_t row = (size_t)(row0 + ai * 128 + m * 16);
#pragma unroll
                for (int bj = 0; bj < 2; ++bj) { const int col = col0 + bj * 128;
                    const u32x4 wcur = *(const u32x4*)(P + row * PW + gc + col);
                    u32x4 wnx = wcur; if (!lastsub) wnx = *(const u32x4*)(P + row * PW + gn + col);
                    float f[8];
#pragma unroll
                    for (int q = 0; q < 4; ++q) {
                        const float c0 = bflo(wcur[q]), c1 = bfhi(wcur[q]), n0 = bflo(wnx[q]), n1 = bfhi(wnx[q]);
                        const float d0 = 1.f + fexp2(fminf(-c0 * LOG2E, 100.f)), d1 = 1.f + fexp2(fminf(-c1 * LOG2E, 100.f));
                        const float u0 = lastsub ? 1.f : 1.f + fexp2(fminf(-n0 * LOG2E, 100.f)), u1 = lastsub ? 1.f : 1.f + fexp2(fminf(-n1 * LOG2E, 100.f));
                        f[2 * q] = u0 * frcp(d0); f[2 * q + 1] = u1 * frcp(d1);
                    }
                    f32x4 v0 = acc[ai][bj][m][0], v1 = acc[ai][bj][m][1];
                    v0[0] *= f[0]; v0[1] *= f[1]; v0[2] *= f[2]; v0[3] *= f[3]; v1[0] *= f[4]; v1[1] *= f[5]; v1[2] *= f[6]; v1[3] *= f[7];
                    acc[ai][bj][m][0] = v0; acc[ai][bj][m][1] = v1;
                    if (lastsub) { u32x4 w; w.x = pk2(v0[0], v0[1]); w.y = pk2(v0[2], v0[3]); w.z = pk2(v1[0], v1[1]); w.w = pk2(v1[2], v1[3]);
                        *(u32x4*)(Mo + row * D + col) = w; }
                } }
    }
};
struct EpiRes {
    static constexpr bool PERM = false, KEEP = false;
    float* XL; float* XCp; const float* modl; int gidx;
    __device__ __forceinline__ void operator()(AccT& acc, const pg8::Unit& u, int wr, int wc, int fr, int fq) const {
        const int trow = u.pm * 256, row0 = trow + wr * 64 + fr, col0 = u.pn * 256 + wc * 32 + 4 * fq;
        const int v = trow < ML ? (trow >> 13) : 4;
        float* Xb = trow < ML ? XL + (size_t)row0 * D : XCp + (size_t)(row0 - ML) * D;
        f32x4 gv[2][2];
#pragma unroll
        for (int bj = 0; bj < 2; ++bj)
#pragma unroll
            for (int n = 0; n < 2; ++n) gv[bj][n] = *(const f32x4*)(modl + v * 6144 + gidx * 1024 + col0 + bj * 128 + n * 16);
#pragma unroll
        for (int ai = 0; ai < 2; ++ai)
#pragma unroll
            for (int m = 0; m < 4; ++m) { float* rowp = Xb + (size_t)(ai * 128 + m * 16) * D + col0;
#pragma unroll
                for (int bj = 0; bj < 2; ++bj)
#pragma unroll
                    for (int n = 0; n < 2; ++n) { f32x4* p = (f32x4*)(rowp + bj * 128 + n * 16); f32x4 xv = *p; xv += gv[bj][n] * acc[ai][bj][m][n]; *p = xv; } }
    }
};
struct EpiFF1 {
    static constexpr bool PERM = true, KEEP = false;
    bf16_t* Hd;
    __device__ __forceinline__ void operator()(AccT& acc, const pg8::Unit& u, int wr, int wc, int fr, int fq) const {
        const int row0 = u.pm * 256 + wr * 64 + fr, col0 = u.pn * 256 + wc * 32 + 8 * fq;
#pragma unroll
        for (int ai = 0; ai < 2; ++ai)
#pragma unroll
            for (int m = 0; m < 4; ++m) { bf16_t* rowp = Hd + (size_t)(row0 + ai * 128 + m * 16) * DFF + col0;
#pragma unroll
                for (int bj = 0; bj < 2; ++bj) { f32x4 v0 = acc[ai][bj][m][0], v1 = acc[ai][bj][m][1];
#pragma unroll
                    for (int j = 0; j < 4; ++j) { const float a = fmaxf(v0[j], 0.f), b = fmaxf(v1[j], 0.f); v0[j] = a * a; v1[j] = b * b; }
                    u32x4 w; w.x = pk2(v0[0], v0[1]); w.y = pk2(v0[2], v0[3]); w.z = pk2(v1[0], v1[1]); w.w = pk2(v1[2], v1[3]);
                    *(u32x4*)(rowp + bj * 128) = w; } }
    }
};

__device__ __forceinline__ void transpose_item(const float* W, int ldn, int k0, int nsrc0, bf16_t* WT, int ldt, int ndst0, LAS float* scr, int lane) {
#pragma unroll 8
    for (int i = 0; i < 32; ++i) { const int kk = 2 * i + (lane >> 5); scr[kk * 33 + (lane & 31)] = W[(size_t)(k0 + kk) * ldn + nsrc0 + (lane & 31)]; }
    asm volatile("s_waitcnt lgkmcnt(0)" ::: "memory");
    const int c = lane & 7;
#pragma unroll
    for (int j = 0; j < 4; ++j) { const int n = (lane >> 3) + 8 * j; const LAS float* s = scr + (8 * c) * 33 + n;
        u32x4 o; o.x = pk2(s[0 * 33], s[1 * 33]); o.y = pk2(s[2 * 33], s[3 * 33]); o.z = pk2(s[4 * 33], s[5 * 33]); o.w = pk2(s[6 * 33], s[7 * 33]);
        *(u32x4*)(WT + (size_t)(ndst0 + n) * ldt + k0 + 8 * c) = o; }
    asm volatile("s_waitcnt lgkmcnt(0)" ::: "memory");
}
__device__ __forceinline__ void conv_seg(int& base, int gw, int NGW, const float* W, int K, int ldn, int nsrc0, int ncols, bf16_t* WT, int ldt, int ndst0, LAS float* scr, int lane) {
    const int nblk = ncols / 32, nitems = (K / 64) * nblk;
    int first = base + (((gw - base) % NGW) + NGW) % NGW;
    for (int it = first; it < base + nitems; it += NGW) { const int r = it - base, kb = r / nblk, nb = r - kb * nblk;
        transpose_item(W, ldn, 64 * kb, nsrc0 + 32 * nb, WT, ldt, ndst0 + 32 * nb, scr, lane); }
    base += nitems;
}
__device__ __forceinline__ void convert_stage_a(const KArgs& a, int l, int gw, int NGW, LAS float* scr, int lane) {
    const float* W = a.w_in + (size_t)l * D * WIN; bf16_t* WT = (bf16_t*)(a.ws + WS_WB); int base = 0;
    conv_seg(base, gw, NGW, W, D, WIN, 0, 1024, WT, D, 0, scr, lane);
    conv_seg(base, gw, NGW, W, D, WIN, 1536, 1024, WT, D, 1024, scr, lane);
    conv_seg(base, gw, NGW, W, D, WIN, 2560, 512, WT, D, 2048, scr, lane);
    conv_seg(base, gw, NGW, W, D, WIN, 3072, 256, WT, D, 2560, scr, lane);
    conv_seg(base, gw, NGW, W, D, WIN, 1024, 512, WT, D, 2816, scr, lane);
    conv_seg(base, gw, NGW, W, D, WIN, 3328, 3072, WT, D, 3328, scr, lane);
}
__device__ __forceinline__ void convert_stage_b(const KArgs& a, int l, int gw, int NGW, LAS float* scr, int lane) {
    bf16_t* WB = (bf16_t*)(a.ws + WS_WB); int base = 0;
    const float* wbr = a.w_branch + (size_t)l * 1536 * D;
    for (int i = 0; i < 3; ++i) conv_seg(base, gw, NGW, wbr + (size_t)i * 512 * D, 512, D, 0, D, WB + WB_BR + i * 524288, 512, 0, scr, lane);
    conv_seg(base, gw, NGW, a.w_out + (size_t)l * D * D, D, D, 0, D, WB + WB_OUT, D, 0, scr, lane);
    conv_seg(base, gw, NGW, a.w_ff1 + (size_t)l * D * DFF, D, DFF, 0, DFF, WB + WB_FF1, D, 0, scr, lane);
    conv_seg(base, gw, NGW, a.w_ff2 + (size_t)l * DFF * D, DFF, D, 0, D, WB + WB_FF2, DFF, 0, scr, lane);
}

__device__ __forceinline__ void phase0(const KArgs& a, LAS unsigned char* lds, int gw, int NGW, int wave, int lane) {
    LAS float* cond = (LAS float*)lds;
    LAS float* red = (LAS float*)(lds + 20480);
    const int tid = wave * 64 + lane;
    for (int i = tid; i < 5 * D; i += 512) { const int v = i >> 10, k = i & 1023; const float cv = v < 4 ? a.c[v * D + k] : a.c_ctx[k]; cond[i] = cv / (1.f + __expf(-cv)); }
    __syncthreads();
    float* mods = (float*)(a.ws + WS_MOD);
    const int col = tid & 127, kq = tid >> 7;
    for (int task = blockIdx.x; task < NL * 48; task += gridDim.x) {
        const int l = task / 48, cc = (task % 48) * 128 + col;
        const float* W = a.w_mod + (size_t)l * D * 6144 + cc;
        float s0 = 0.f, s1 = 0.f, s2 = 0.f, s3 = 0.f, s4 = 0.f;
#pragma unroll 8
        for (int k = kq * 256; k < kq * 256 + 256; ++k) { const float w = W[(size_t)k * 6144];
            s0 += w * cond[k]; s1 += w * cond[1024 + k]; s2 += w * cond[2048 + k]; s3 += w * cond[3072 + k]; s4 += w * cond[4096 + k]; }
        red[(kq * 5 + 0) * 128 + col] = s0; red[(kq * 5 + 1) * 128 + col] = s1; red[(kq * 5 + 2) * 128 + col] = s2; red[(kq * 5 + 3) * 128 + col] = s3; red[(kq * 5 + 4) * 128 + col] = s4;
        __syncthreads();
        for (int o = tid; o < 5 * 128; o += 512) { const int v = o >> 7, c2 = o & 127, ccol = (task % 48) * 128 + c2;
            const float r = red[(0 * 5 + v) * 128 + c2] + red[(1 * 5 + v) * 128 + c2] + red[(2 * 5 + v) * 128 + c2] + red[(3 * 5 + v) * 128 + c2];
            mods[((size_t)l * 5 + v) * 6144 + ccol] = r + a.b_mod[l * 6144 + ccol]; }
        __syncthreads();
    }
    __syncthreads();
    LAS float* scr = (LAS float*)(lds + 32768 + wave * 8448);
    bf16_t* LW = (bf16_t*)(a.ws + WS_LW);
    for (int it = gw; it < NL * 2 * 2 * 8 * 2; it += NGW) { const int half = it & 1, mi = it >> 1, n = mi & 7, mat = (mi >> 3) & 1, ld = mi >> 4;
        const float* W = (mat ? a.lru_wx : a.lru_wa) + ((size_t)ld * 8 + n) * 4096;
        transpose_item(W, 64, 0, 32 * half, LW + ((size_t)(ld * 2 + mat) * 8 + n) * 4096, 64, 32 * half, scr, lane); }
    convert_stage_a(a, 0, gw, NGW, scr, lane);
}

__device__ __forceinline__ void norm_phase(const KArgs& a, int l, bool second, int nrows, int gw, int NGW, int lane) {
    const bool first_read = (l == 0 && !second);
    const float* srcL = first_read ? a.x : a.out; const float* srcC = first_read ? a.ctx : (const float*)(a.ws + WS_XC);
    float* XC = (float*)(a.ws + WS_XC); bf16_t* H = (bf16_t*)(a.ws + WS_H);
    const float* g = (second ? a.norm2_g : a.norm1_g) + l * D; const float* modl = (const float*)(a.ws + WS_MOD) + (size_t)l * 5 * 6144; const int sidx = second ? 3 : 0;
    for (int row = gw; row < nrows; row += NGW) {
        const float* src = row < ML ? srcL + (size_t)row * D : srcC + (size_t)(row - ML) * D; const int v = row < ML ? (row >> 13) : 4;
        const f32x4* xr = (const f32x4*)src + lane; f32x4 xv[4]; float s = 0.f;
#pragma unroll
        for (int j = 0; j < 4; ++j) { xv[j] = xr[64 * j]; s += (xv[j][0] * xv[j][0] + xv[j][1] * xv[j][1]) + (xv[j][2] * xv[j][2] + xv[j][3] * xv[j][3]); }
        const float rstd = 1.0f / sqrtf(wave_sum(s) * (1.f / D) + 1e-6f);
        if (first_read) { f32x4* cp = (f32x4*)(row < ML ? a.out + (size_t)row * D : XC + (size_t)(row - ML) * D) + lane;
#pragma unroll
            for (int j = 0; j < 4; ++j) cp[64 * j] = xv[j]; }
        u32x2* o8 = (u32x2*)(H + (size_t)row * D) + lane;
#pragma unroll
        for (int j = 0; j < 4; ++j) { const int c = 4 * lane + 256 * j; const f32x4 gg = *(const f32x4*)(g + c), sh = *(const f32x4*)(modl + v * 6144 + sidx * 1024 + c), sc = *(const f32x4*)(modl + v * 6144 + (sidx + 1) * 1024 + c);
            f32x4 h = xv[j] * rstd * gg * (sc + 1.0f) + sh; u32x2 w; w.x = pk2(h[0], h[1]); w.y = pk2(h[2], h[3]); o8[64 * j] = w; }
    }
}
__device__ __forceinline__ void final_norm(const KArgs& a, int gw, int NGW, int lane) {
    for (int row = gw; row < ML; row += NGW) {
        f32x4* xr = (f32x4*)(a.out + (size_t)row * D) + lane; f32x4 xv[4]; float s = 0.f;
#pragma unroll
        for (int j = 0; j < 4; ++j) { xv[j] = xr[64 * j]; s += (xv[j][0] * xv[j][0] + xv[j][1] * xv[j][1]) + (xv[j][2] * xv[j][2] + xv[j][3] * xv[j][3]); }
        const float rstd = 1.0f / sqrtf(wave_sum(s) * (1.f / D) + 1e-6f);
#pragma unroll
        for (int j = 0; j < 4; ++j) { const f32x4 gg = *(const f32x4*)(a.final_g + 4 * lane + 256 * j); xr[64 * j] = xv[j] * rstd * gg; }
    }
}

struct AttnSt { f32x4 o[4]; float m, l; };
template <class BiasF>
__device__ __forceinline__ void attn_block(AttnSt& st, const bf16_t* k0p, const bf16_t* k1p, const bf16_t* vtp, const bf16x8 (&qf)[2], BiasF bias) {
    const bf16x8 ka0 = *(const bf16x8*)k0p, ka1 = *(const bf16x8*)(k0p + 32), kb0 = *(const bf16x8*)k1p, kb1 = *(const bf16x8*)(k1p + 32);
    s16x4 vv[4][2];
#pragma unroll
    for (int dt = 0; dt < 4; ++dt) { vv[dt][0] = *(const s16x4*)(vtp + (size_t)dt * 16 * VTOK); vv[dt][1] = *(const s16x4*)(vtp + (size_t)dt * 16 * VTOK + 16); }
    f32x4 s0 = {0.f, 0.f, 0.f, 0.f}, s1 = {0.f, 0.f, 0.f, 0.f};
    s0 = MFMA16(ka0, qf[0], s0); s0 = MFMA16(ka1, qf[1], s0); s1 = MFMA16(kb0, qf[0], s1); s1 = MFMA16(kb1, qf[1], s1);
    float t[8]; const float SC = 0.125f * LOG2E;
#pragma unroll
    for (int j = 0; j < 4; ++j) { t[j] = bias(0, j, s0[j] * SC); t[4 + j] = bias(1, j, s1[j] * SC); }
    float bm = fmaxf(fmaxf(fmaxf(t[0], t[1]), fmaxf(t[2], t[3])), fmaxf(fmaxf(t[4], t[5]), fmaxf(t[6], t[7])));
    bm = fmaxf(bm, __shfl_xor(bm, 16)); bm = fmaxf(bm, __shfl_xor(bm, 32));
    const float mn = fmaxf(st.m, bm), alpha = fexp2(st.m - mn); st.m = mn;
    float ls = 0.f;
#pragma unroll
    for (int j = 0; j < 8; ++j) { t[j] = fexp2(t[j] - mn); ls += t[j]; }
    st.l = st.l * alpha + ls;
    u32x4 pw; pw.x = pk2(t[0], t[1]); pw.y = pk2(t[2], t[3]); pw.z = pk2(t[4], t[5]); pw.w = pk2(t[6], t[7]);
    const bf16x8 pf = __builtin_bit_cast(bf16x8, pw);
#pragma unroll
    for (int dt = 0; dt < 4; ++dt) { st.o[dt] *= alpha; const bf16x8 vf = __builtin_shufflevector(vv[dt][0], vv[dt][1], 0, 1, 2, 3, 4, 5, 6, 7); st.o[dt] = MFMA16(vf, pf, st.o[dt]); }
}
__device__ __forceinline__ void attn_init(AttnSt& st) {
#pragma unroll
    for (int dt = 0; dt < 4; ++dt) st.o[dt] = (f32x4){0.f, 0.f, 0.f, 0.f};
    st.m = -1.0e30f; st.l = 0.f;
}
__device__ __forceinline__ void attn_ctx_blocks(AttnSt& st, const bf16_t* P, const bf16_t* VT, int b, int kcol, int vrow0, const bf16x8 (&qf)[2], int lane) {
    const int c16 = lane & 15, g = lane >> 4;
    for (int cb = 0; cb < 8; ++cb) {
        const bf16_t* k0p = P + (size_t)(ML + b * CTX + 32 * cb + c16) * PW + kcol + 8 * g;
        const bf16_t* vtp = VT + (size_t)(vrow0 + c16) * VTOK + 8192 + 32 * cb + 4 * g;
        attn_block(st, k0p, k0p + (size_t)16 * PW, vtp, qf, [](int, int, float s) { return s; });
    }
}
__device__ __forceinline__ void attn_store(const AttnSt& st, float lextra, bf16_t* orow, int lane) {
    float l = st.l; l += __shfl_xor(l, 16); l += __shfl_xor(l, 32); l += lextra;
    const float inv = 1.0f / l; const int g = lane >> 4;
#pragma unroll
    for (int dt = 0; dt < 4; ++dt) { const f32x4 o = st.o[dt] * inv; u32x2 w; w.x = pk2(o[0], o[1]); w.y = pk2(o[2], o[3]); *(u32x2*)(orow + 16 * dt + 4 * g) = w; }
}
__device__ __forceinline__ void na_item(const KArgs& a, int l, int item, int lane) {
    bf16_t* P = (bf16_t*)(a.ws + WS_P); const bf16_t* VT = (const bf16_t*)(a.ws + WS_VTA);
    const int i = item & 3, h = (item >> 2) & 7, r = (item >> 5) & 127, b = item >> 12;
    const int c16 = lane & 15, g = lane >> 4;
    const int cq = 16 * i + c16; const size_t qrow = (size_t)b * S + r * 64 + cq;
    bf16x8 qf[2]; qf[0] = *(const bf16x8*)(P + qrow * PW + C_QA + h * 64 + 8 * g); qf[1] = *(const bf16x8*)(P + qrow * PW + C_QA + h * 64 + 32 + 8 * g);
    const int c0 = (i == 0) ? 0 : (i == 1 ? 8 : (i == 2 ? 24 : 32));
    const int rs = min(max(r - 4, 0), 120), cs = min(max(cq - 8, 0), 48);
    AttnSt st; attn_init(st);
    const float* rpb = a.na_rpb + ((size_t)l * 8 + h) * 15 * 31;
    for (int kr = 0; kr < 8; ++kr) {
        const int R = rs + kr; const float* rp = rpb + (R - r + 7) * 31;
        const size_t tok0 = (size_t)R * 64 + c0;
        const bf16_t* k0p = P + ((size_t)b * S + tok0 + c16) * PW + C_KA + h * 64 + 8 * g;
        const bf16_t* vtp = VT + (size_t)((b * 8 + h) * 64 + c16) * VTOK + tok0 + 4 * g;
        attn_block(st, k0p, k0p + (size_t)16 * PW, vtp, qf, [&](int mt, int j, float s) {
            const int kc = c0 + 16 * mt + 4 * g + j; const bool ok = (kc >= cs) && (kc < cs + 16);
            const int idx = min(max(kc - cq + 15, 0), 30); const float bv = rp[idx] * LOG2E;
            return ok ? s + bv : NEGBIG; });
    }
    attn_ctx_blocks(st, P, VT, b, C_KA + h * 64, (b * 8 + h) * 64, qf, lane);
    attn_store(st, 0.f, P + qrow * PW + C_QA + h * 64, lane);
}
__device__ __forceinline__ void ctx_item(const KArgs& a, int l, int item, bool swa, int lane) {
    bf16_t* P = (bf16_t*)(a.ws + WS_P);
    const int i = item & 15, h = (item >> 4) & 7, b = item >> 7;
    const int c16 = lane & 15, g = lane >> 4;
    const size_t qrow = (size_t)ML + b * CTX + 16 * i + c16; const int qc = (swa ? C_QS : C_QA) + h * 64;
    bf16x8 qf[2]; qf[0] = *(const bf16x8*)(P + qrow * PW + qc + 8 * g); qf[1] = *(const bf16x8*)(P + qrow * PW + qc + 32 + 8 * g);
    AttnSt st; attn_init(st);
    if (swa) attn_ctx_blocks(st, P, (const bf16_t*)(a.ws + WS_VTS), b, C_KS + (h >> 2) * 64, (b * 2 + (h >> 2)) * 64, qf, lane);
    else attn_ctx_blocks(st, P, (const bf16_t*)(a.ws + WS_VTA), b, C_KA + h * 64, (b * 8 + h) * 64, qf, lane);
    const float lex = swa ? fexp2(a.swa_sink[l * 8 + h] * LOG2E - st.m) : 0.f;
    attn_store(st, lex, P + qrow * PW + qc, lane);
}
__device__ __forceinline__ float inv_freq(int f) { return exp2f(-(float)f * (13.287712379549449f / 16.0f)); }
__device__ __forceinline__ void rope_cs(int pos, int f, float& c, float& s) {
    const float ang = (float)pos * inv_freq(f); float rev = ang * 0.15915494309189535f; rev -= rintf(rev);
    c = __builtin_amdgcn_cosf(rev); s = __builtin_amdgcn_sinf(rev);
}
__device__ __forceinline__ void swa_item(const KArgs& a, int l, int item, int lane) {
    bf16_t* P = (bf16_t*)(a.ws + WS_P); const bf16_t* VT = (const bf16_t*)(a.ws + WS_VTS);
    const int qt = item & 511, h = (item >> 9) & 7, b = item >> 12, kvh = h >> 2;
    const int c16 = lane & 15, g = lane >> 4;
    const int tq = 16 * qt + c16; const size_t qrow = (size_t)b * S + tq;
    bf16x8 qf[2]; qf[0] = *(const bf16x8*)(P + qrow * PW + C_QS + h * 64 + 8 * g); qf[1] = *(const bf16x8*)(P + qrow * PW + C_QS + h * 64 + 32 + 8 * g);
    {
        const int pos = (g < 2) ? (tq >> 6) : (tq & 63);
        u32x4 w0 = __builtin_bit_cast(u32x4, qf[0]), w1 = __builtin_bit_cast(u32x4, qf[1]);
#pragma unroll
        for (int q = 0; q < 4; ++q) {
            float c0, s0, c1, s1; rope_cs(pos, 8 * (g & 1) + 2 * q, c0, s0); rope_cs(pos, 8 * (g & 1) + 2 * q + 1, c1, s1);
            const float a0 = bflo(w0[q]), a1 = bfhi(w0[q]), b0 = bflo(w1[q]), b1 = bfhi(w1[q]);
            w0[q] = pk2(a0 * c0 - b0 * s0, a1 * c1 - b1 * s1); w1[q] = pk2(b0 * c0 + a0 * s0, b1 * c1 + a1 * s1);
        }
        qf[0] = __builtin_bit_cast(bf16x8, w0); qf[1] = __builtin_bit_cast(bf16x8, w1);
    }
    AttnSt st; attn_init(st);
    const int kstart = 16 * qt - 128;
    for (int kb = 0; kb < 9; ++kb) {
        const int k0 = kstart + 32 * kb; if (k0 + 31 < 0 || k0 >= S) continue;
        const int ka = min(max(k0 + c16, 0), S - 1), kbk = min(max(k0 + 16 + c16, 0), S - 1);
        const bf16_t* k0p = P + ((size_t)b * S + ka) * PW + C_KS + kvh * 64 + 8 * g;
        const bf16_t* k1p = P + ((size_t)b * S + kbk) * PW + C_KS + kvh * 64 + 8 * g;
        const int v0 = min(max(k0 + 4 * g, 0), S - 4), v1 = min(max(k0 + 16 + 4 * g, 0), S - 4);
        const bf16_t* vrow = VT + (size_t)((b * 2 + kvh) * 64 + c16) * VTOK;
        const bool inr = (k0 >= 0) && (k0 + 31 < S);
        const bf16_t* vtp = vrow + (inr ? (k0 + 4 * g) : ((v1 == v0 + 16) ? v0 : min(v0, S - 20)));
        attn_block(st, k0p, k1p, vtp, qf, [&](int mt, int j, float s) {
            const int k = k0 + 16 * mt + 4 * g + j; const int dlt = k - tq;
            const bool ok = (k >= 0) && (k < S) && (dlt <= 128) && (dlt >= -128);
            return ok ? s : NEGBIG; });
    }
    attn_ctx_blocks(st, P, VT, b, C_KS + kvh * 64, (b * 2 + kvh) * 64, qf, lane);
    const float lex = fexp2(a.swa_sink[l * 8 + h] * LOG2E - st.m);
    attn_store(st, lex, P + qrow * PW + C_QS + h * 64, lane);
}
__device__ __forceinline__ void rope_k_phase(const KArgs& a, int gw, int NGW, int lane) {
    bf16_t* P = (bf16_t*)(a.ws + WS_P);
    const int hd = lane >> 5, i = lane & 31;
    for (int row = gw; row < ML; row += NGW) {
        const int t = row & (S - 1); const int pos = (i < 16) ? (t >> 6) : (t & 63);
        float c, s; rope_cs(pos, i & 15, c, s);
        bf16_t* p = P + (size_t)row * PW + C_KS + hd * 64;
        const float t1 = bf2f(p[i]), t2 = bf2f(p[i + 32]);
        const unsigned w = pk2(t1 * c - t2 * s, t2 * c + t1 * s);
        p[i] = (bf16_t)(w & 0xffff); p[i + 32] = (bf16_t)(w >> 16);
    }
}

__device__ __forceinline__ float neg_expm1(float x) {
    const float ser = -x * (1.f + x * (0.5f + x * (0.16666667f + x * (0.041666668f + x * (0.0083333338f + x * 0.0013888889f)))));
    return x > -0.25f ? ser : 1.f - __expf(x);
}
template <int DIR, bool WRITE>
__device__ __forceinline__ void lru_sweep(const KArgs& a, int l, int b, int n, int sp, float (&carry)[4], float (&arun)[4], int lane) {
    bf16_t* P = (bf16_t*)(a.ws + WS_P); float* HT = (float*)(a.ws + WS_H); const bf16_t* LW = (const bf16_t*)(a.ws + WS_LW);
    const int c16 = lane & 15, g = lane >> 4; const int gg = DIR ? 3 - g : g;
    const bool lat = sp < 64; const int rowbase = lat ? b * S : ML + b * CTX, seglen = lat ? S : CTX, t0 = (lat ? sp : sp - 64) * 128;
    float ba[4], bx[4], spc[4];
#pragma unroll
    for (int nt = 0; nt < 4; ++nt) { const int ch = n * 64 + 16 * nt + c16, o = (l * 2 + DIR) * 512 + ch;
        ba[nt] = a.lru_ba[o]; bx[nt] = a.lru_bx[o]; const float lam = a.lru_lambda[o]; spc[nt] = (lam < -15.f) ? -lam : log1pf(__expf(-lam)); }
    const bf16_t* lwa = LW + ((size_t)((l * 2 + DIR) * 2 + 0) * 8 + n) * 4096 + c16 * 64 + 8 * g;
    const bf16_t* lwx = LW + ((size_t)((l * 2 + DIR) * 2 + 1) * 8 + n) * 4096 + c16 * 64 + 8 * g;
    const float* cw = a.conv_w + (size_t)l * 4 * 512; const float* cbias = a.conv_b + (size_t)l * 512;
    const int srcm = DIR ? lane + 16 : lane - 16, srcm2 = DIR ? lane + 32 : lane - 32, srct = DIR ? c16 : 48 + c16;
    for (int ti = 0; ti < 8; ++ti) {
        asm volatile("" ::: "memory");
        const int tile = DIR ? 7 - ti : ti; const int tt = t0 + 16 * tile; const int t = tt + c16;
        bf16x8 uf[2];
#pragma unroll
        for (int ks = 0; ks < 2; ++ks) { const int chb = n * 64 + 32 * ks + 8 * g;
            f32x4 u0 = *(const f32x4*)(cbias + chb), u1 = *(const f32x4*)(cbias + chb + 4);
#pragma unroll
            for (int i = 0; i < 4; ++i) { const int tp = t + i - 2; const bool ok = (tp >= 0) && (tp < seglen); const int tc = min(max(tp, 0), seglen - 1);
                const u32x4 xw = *(const u32x4*)(P + (size_t)(rowbase + tc) * PW + C_XB + chb);
                f32x4 w0 = *(const f32x4*)(cw + i * 512 + chb), w1 = *(const f32x4*)(cw + i * 512 + chb + 4);
                if (!ok) { w0 = (f32x4){0.f, 0.f, 0.f, 0.f}; w1 = w0; }
                u0[0] += w0[0] * bflo(xw[0]); u0[1] += w0[1] * bfhi(xw[0]); u0[2] += w0[2] * bflo(xw[1]); u0[3] += w0[3] * bfhi(xw[1]);
                u1[0] += w1[0] * bflo(xw[2]); u1[1] += w1[1] * bfhi(xw[2]); u1[2] += w1[2] * bflo(xw[3]); u1[3] += w1[3] * bfhi(xw[3]); }
            u32x4 pw; pw.x = pk2(u0[0], u0[1]); pw.y = pk2(u0[2], u0[3]); pw.z = pk2(u1[0], u1[1]); pw.w = pk2(u1[2], u1[3]);
            uf[ks] = __builtin_bit_cast(bf16x8, pw); }
#pragma unroll
        for (int nt = 0; nt < 4; ++nt) {
            f32x4 ga = {0.f, 0.f, 0.f, 0.f}, gx = ga, ud = ga;
#pragma unroll
            for (int ks = 0; ks < 2; ++ks) {
                const bf16x8 wa = *(const bf16x8*)(lwa + nt * 1024 + 32 * ks), wx = *(const bf16x8*)(lwx + nt * 1024 + 32 * ks);
                bf16x8 idf;
#pragma unroll
                for (int j = 0; j < 8; ++j) idf[j] = (32 * ks + 8 * g + j == 16 * nt + c16) ? (short)0x3F80 : (short)0;
                ga = MFMA16(uf[ks], wa, ga); gx = MFMA16(uf[ks], wx, gx); ud = MFMA16(uf[ks], idf, ud);
            }
            float av[4], bv[4];
#pragma unroll
            for (int j = 0; j < 4; ++j) {
                const float r = frcp(1.f + __expf(-(ga[j] + ba[nt]))), ii = frcp(1.f + __expf(-(gx[j] + bx[nt])));
                const float la = -8.0f * r * spc[nt];
                av[j] = __expf(la); bv[j] = sqrtf(neg_expm1(2.0f * la)) * ii * ud[j];
            }
            float Pj[4], Hj[4];
#pragma unroll
            for (int jj = 0; jj < 4; ++jj) { const int j = DIR ? 3 - jj : jj;
                if (jj == 0) { Pj[0] = av[j]; Hj[0] = bv[j]; } else { Pj[jj] = Pj[jj - 1] * av[j]; Hj[jj] = av[j] * Hj[jj - 1] + bv[j]; } }
            float Ai = Pj[3], Hi = Hj[3];
            { const float A1 = __shfl(Ai, srcm), H1 = __shfl(Hi, srcm); if (gg >= 1) { Hi = Ai * H1 + Hi; Ai = Ai * A1; } }
            { const float A2 = __shfl(Ai, srcm2), H2 = __shfl(Hi, srcm2); if (gg >= 2) { Hi = Ai * H2 + Hi; Ai = Ai * A2; } }
            float Ae = __shfl(Ai, srcm), He = __shfl(Hi, srcm); if (gg == 0) { Ae = 1.f; He = 0.f; }
            const float At = __shfl(Ai, srct), Ht = __shfl(Hi, srct);
            const float cin = Ae * carry[nt] + He;
            if (WRITE) {
#pragma unroll
                for (int jj = 0; jj < 4; ++jj) { const int j = DIR ? 3 - jj : jj; const float hv = Hj[jj] + Pj[jj] * cin;
                    const size_t row = (size_t)(rowbase + tt + 4 * g + j); const int ch = n * 64 + 16 * nt + c16;
                    if (DIR == 0) HT[row * 512 + ch] = hv;
                    else { bf16_t* gp = P + row * PW + C_GB + ch; const float gbv = bf2f(*gp); const float y = HT[row * 512 + ch] + hv;
                        const float z = 0.7978845608028654f * (gbv + 0.044715f * gbv * gbv * gbv); const float th = 1.f - 2.f * frcp(1.f + __expf(2.f * z));
                        const float ge = 0.5f * gbv * (1.f + th); *gp = (bf16_t)(pk2(y * ge, 0.f) & 0xffff); } }
            }
            carry[nt] = At * carry[nt] + Ht; arun[nt] *= At;
        }
    }
}
__device__ __forceinline__ void lru_pass1_item(const KArgs& a, int l, int item, int lane) {
    const int dir = item & 1, n = (item >> 1) & 7, rest = item >> 4, sp = rest % 66, b = rest / 66;
    float carry[4] = {0.f, 0.f, 0.f, 0.f}, arun[4] = {1.f, 1.f, 1.f, 1.f};
    if (dir) lru_sweep<1, false>(a, l, b, n, sp, carry, arun, lane); else lru_sweep<0, false>(a, l, b, n, sp, carry, arun, lane);
    float* SUM = (float*)(a.ws + WS_SUM);
    if (lane < 16) {
#pragma unroll
        for (int nt = 0; nt < 4; ++nt) { float* p = SUM + ((size_t)((b * 66 + sp) * 2 + dir) * 512 + n * 64 + 16 * nt + lane) * 2; p[0] = arun[nt]; p[1] = carry[nt]; }
    }
}
__device__ __forceinline__ void lru_fold(const float* SUM, int b, int p, int dir, int n, int c16, float (&carry)[4]) {
#pragma unroll
    for (int nt = 0; nt < 4; ++nt) { const float* q = SUM + ((size_t)((b * 66 + p) * 2 + dir) * 512 + n * 64 + 16 * nt + c16) * 2; carry[nt] = q[0] * carry[nt] + q[1]; }
}
__device__ __forceinline__ void lru_pass2_item(const KArgs& a, int l, int item, int lane) {
    const int n = item & 7, rest = item >> 3, sp = rest % 66, b = rest / 66; const int c16 = lane & 15;
    const float* SUM = (const float*)(a.ws + WS_SUM);
    float carry[4] = {0.f, 0.f, 0.f, 0.f}, arun[4] = {1.f, 1.f, 1.f, 1.f};
    if (sp < 64) { lru_fold(SUM, b, 64, 0, n, c16, carry); lru_fold(SUM, b, 65, 0, n, c16, carry); for (int p = 0; p < sp; ++p) lru_fold(SUM, b, p, 0, n, c16, carry); }
    else if (sp == 65) lru_fold(SUM, b, 64, 0, n, c16, carry);
    lru_sweep<0, true>(a, l, b, n, sp, carry, arun, lane);
#pragma unroll
    for (int nt = 0; nt < 4; ++nt) carry[nt] = 0.f;
    if (sp < 64) { lru_fold(SUM, b, 65, 1, n, c16, carry); lru_fold(SUM, b, 64, 1, n, c16, carry); for (int p = 63; p > sp; --p) lru_fold(SUM, b, p, 1, n, c16, carry); }
    else if (sp == 64) lru_fold(SUM, b, 65, 1, n, c16, carry);
    lru_sweep<1, true>(a, l, b, n, sp, carry, arun, lane);
}

__global__ void __launch_bounds__(512, 2) fwd_kernel(KArgs a) {
    extern __shared__ __attribute__((aligned(16))) unsigned char smem[];
    LAS unsigned char* lds = (LAS unsigned char*)smem;
    cg::grid_group grid = cg::this_grid();
    const int G = gridDim.x, NGW = G * 8;
    bf16_t* P = (bf16_t*)(a.ws + WS_P); bf16_t* H = (bf16_t*)(a.ws + WS_H); bf16_t* WB = (bf16_t*)(a.ws + WS_WB);
    float* XC = (float*)(a.ws + WS_XC);
    for (int ph = a.ph_lo; ph < a.ph_hi; ++ph) {
        int tid_ = threadIdx.x; asm volatile("" : "+v"(tid_));
        const int lane = tid_ & 63, wave = __builtin_amdgcn_readfirstlane(tid_ >> 6), gw = blockIdx.x * 8 + wave;
        if (ph == 0) phase0(a, lds, gw, NGW, wave, lane);
        else if (ph == 37) final_norm(a, gw, NGW, lane);
        else {
            const int l = (ph - 1) / 9, k = (ph - 1) % 9; const bool lastl = (l == NL - 1); const int Mrows = lastl ? ML : MT;
            const float* modl = (const float*)(a.ws + WS_MOD) + (size_t)l * 5 * 6144;
            if (k == 0) {
                norm_phase(a, l, false, MT, gw, NGW, lane);
                if (l > 0) convert_stage_a(a, l, gw, NGW, (LAS float*)(lds + wave * 8448), lane);
            } else if (k == 1) {
                pg8::Gemm g{H, WB, 1}; pg8::Order So; So.init(MT, WIN, G, blockIdx.x, 1);
                EpiIn E{P, (bf16_t*)(a.ws + WS_VTA), (bf16_t*)(a.ws + WS_VTS)};
                #ifndef NO_EPIIN
                pg8::gemm_phase<EpiIn, D, D, D>(lds, g, So, E);
#endif
            } else if (k == 2) {
                convert_stage_b(a, l, gw, NGW, (LAS float*)(lds + wave * 8448), lane);
                rope_k_phase(a, gw, NGW, lane);
                #ifndef NO_LRU
                for (int it = gw; it < NB * 66 * 8 * 2; it += NGW) lru_pass1_item(a, l, it, lane);
#endif
#ifndef NO_ATTN
                for (int it = gw; it < NB * 128 * 8 * 4; it += NGW) na_item(a, l, it, lane);
                if (!lastl) for (int it = gw; it < NB * 8 * 16; it += NGW) ctx_item(a, l, it, false, lane);
#endif
            } else if (k == 3) {
                #ifndef NO_LRU
                for (int it = gw; it < NB * 66 * 8; it += NGW) lru_pass2_item(a, l, it, lane);
#endif
#ifndef NO_ATTN
                for (int it = gw; it < NB * 8 * 512; it += NGW) swa_item(a, l, it, lane);
                if (!lastl) for (int it = gw; it < NB * 8 * 16; it += NGW) ctx_item(a, l, it, true, lane);
#endif
            } else if (k == 4) {
                pg8::Gemm g{P, WB + WB_BR, 3}; pg8::Order So; So.init(Mrows, D, G, blockIdx.x, 3);
                EpiMerge E{P, H};
                #ifndef NO_EPIMERGE
                pg8::gemm_phase<EpiMerge, PW, 512, 512, C_QA, C_GB, C_QS, 524288>(lds, g, So, E);
#endif
            } else if (k == 5) {
                pg8::Gemm g{H, WB + WB_OUT, 1}; pg8::Order So; So.init(Mrows, D, G, blockIdx.x, 1);
                EpiRes E{a.out, XC, modl, 2};
#ifndef NO_EPIRES
                pg8::gemm_phase<EpiRes, D, D, D>(lds, g, So, E);
#endif
            } else if (k == 8) {
                pg8::Gemm g{P, WB + WB_FF2, 1}; pg8::Order So; So.init(Mrows, D, G, blockIdx.x, 1);
                EpiRes E{a.out, XC, modl, 5};
#ifndef NO_EPIRES
                pg8::gemm_phase<EpiRes, DFF, DFF, DFF>(lds, g, So, E);
#endif
            } else if (k == 6) {
                norm_phase(a, l, true, Mrows, gw, NGW, lane);
            } else if (k == 7) {
                pg8::Gemm g{H, WB + WB_FF1, 1}; pg8::Order So; So.init(Mrows, DFF, G, blockIdx.x, 1);
                EpiFF1 E{P};
                #ifndef NO_EPIFF1
                pg8::gemm_phase<EpiFF1, D, D, D>(lds, g, So, E);
#endif
            }
        }
        if (ph + 1 < a.ph_hi) { __syncthreads(); grid.sync(); }
    }
}

extern "C" void kernel_launch(void* const* d_in, const int* in_sizes, int n_in, void* d_out, int out_size, void* d_ws, size_t ws_size, hipStream_t stream) {
    static int grid = 0;
    if (grid == 0) {
        if (n_in != 23 || ws_size < WS_END) { fprintf(stderr, "kernel_launch: unexpected n_in %d or ws_size %zu (< %zu)\n", n_in, ws_size, (size_t)WS_END); grid = -1; return; }
        int dev = 0, cus = 0, per_cu = 0;
        hipGetDevice(&dev); hipDeviceGetAttribute(&cus, hipDeviceAttributeMultiprocessorCount, dev);
        if (hipFuncSetAttribute((const void*)fwd_kernel, hipFuncAttributeMaxDynamicSharedMemorySize, LDS_BYTES) != hipSuccess) { fprintf(stderr, "hipFuncSetAttribute failed\n"); grid = -1; return; }
        if (hipOccupancyMaxActiveBlocksPerMultiprocessor(&per_cu, (const void*)fwd_kernel, 512, LDS_BYTES) != hipSuccess || per_cu < 1) { fprintf(stderr, "occupancy query: %d\n", per_cu); per_cu = 1; }
        (void)hipGetLastError();
        grid = cus;
    }
    if (grid < 0) return;
    KArgs a{};
    const float** f = (const float**)&a;
    for (int i = 0; i < 23; ++i) f[i] = (const float*)d_in[i];
    a.out = (float*)d_out; a.ws = (unsigned char*)d_ws;
#if N_LAUNCHES == 1
    a.ph_lo = 0; a.ph_hi = 38;
    void* args[] = {&a};
    hipError_t e = hipLaunchCooperativeKernel((const void*)fwd_kernel, dim3(grid), dim3(512), args, LDS_BYTES, stream);
    if (e != hipSuccess) fprintf(stderr, "cooperative launch failed: %s (grid %d)\n", hipGetErrorString(e), grid);
#else
    for (int ph = 0; ph < 38; ++ph) { a.ph_lo = ph; a.ph_hi = ph + 1; hipLaunchKernelGGL(fwd_kernel, dim3(grid), dim3(512), LDS_BYTES, stream, a); }
#endif
}
```

```cpp
#include <hip/hip_runtime.h>
#include <hip/hip_cooperative_groups.h>
#include <cstdio>
#include <cstdint>
namespace cg = cooperative_groups;

#ifndef N_LAUNCHES
#define N_LAUNCHES 1
#endif

#ifndef PROBE_MASK
#define PROBE_MASK 0
#endif
#define LAS __attribute__((address_space(3)))
typedef unsigned short bf16_t;
typedef short bf16x8 __attribute__((ext_vector_type(8)));
typedef short s16x4 __attribute__((ext_vector_type(4)));
typedef float f32x4 __attribute__((ext_vector_type(4)));
typedef unsigned u32x4 __attribute__((ext_vector_type(4)));
typedef unsigned u32x2 __attribute__((ext_vector_type(2)));

constexpr int D = 1024, NB = 4, S = 8192, CTX = 256, ML = NB * S, MC = NB * CTX, MT = ML + MC, NL = 4, DFF = 4096;
constexpr int PW = 5760;
constexpr int C_QA = 0, C_KA = 512, C_XB = 1024, C_GB = 1536, C_QS = 2048, C_KS = 2560, C_GA = 2688, C_GR = 3712, C_GS = 4736;
constexpr int VTOK = 8448;
constexpr int WIN = 6400;
constexpr size_t MiB = 1u << 20;
constexpr size_t WS_XC = 0, WS_H = 4 * MiB, WS_P = 70 * MiB, WS_VTA = WS_P + (size_t)MT * PW * 2, WS_VTS = WS_VTA + (size_t)NB * 8 * 64 * VTOK * 2,
                 WS_WB = WS_VTS + (size_t)NB * 2 * 64 * VTOK * 2, WS_MOD = WS_WB + 21 * MiB, WS_SUM = WS_MOD + MiB / 2, WS_LW = WS_SUM + 5 * MiB / 2, WS_BAR = WS_LW + MiB, WS_END = WS_BAR + 16384;
constexpr int WB_BR = 0, WB_OUT = 3 * 524288, WB_FF1 = WB_OUT + 1048576, WB_FF2 = WB_FF1 + 4194304;
constexpr int LDS_BYTES = 131072 + 64;
constexpr float LOG2E = 1.4426950408889634f;
constexpr float NEGBIG = -3.0e38f;

struct KArgs {
    const float *x, *c, *ctx, *c_ctx, *w_mod, *b_mod, *norm1_g, *norm2_g, *w_in, *na_rpb, *conv_w, *conv_b, *lru_wa, *lru_ba, *lru_wx, *lru_bx, *lru_lambda,
        *swa_sink, *w_branch, *w_out, *w_ff1, *w_ff2, *final_g;
    float* out; unsigned char* ws; int ph_lo, ph_hi;
};

__device__ __forceinline__ unsigned pk2(float lo, float hi) { unsigned r; asm("v_cvt_pk_bf16_f32 %0, %1, %2" : "=v"(r) : "v"(lo), "v"(hi)); return r; }
__device__ __forceinline__ float bf2f(unsigned short b) { return __uint_as_float(((unsigned)b) << 16); }
__device__ __forceinline__ float bflo(unsigned w) { return __uint_as_float(w << 16); }
__device__ __forceinline__ float bfhi(unsigned w) { return __uint_as_float(w & 0xffff0000u); }
__device__ __forceinline__ float fexp2(float x) { return __builtin_amdgcn_exp2f(x); }
__device__ __forceinline__ float frcp(float x) { return __builtin_amdgcn_rcpf(x); }
__device__ __forceinline__ int lane_id_asm() { int l; asm volatile("v_mbcnt_lo_u32_b32 %0, -1, 0\n\tv_mbcnt_hi_u32_b32 %0, -1, %0" : "=v"(l)); return l; }
__device__ __forceinline__ float wave_sum(float v) {
#pragma unroll
    for (int o = 1; o < 64; o <<= 1) v += __shfl_xor(v, o);
    return v;
}
#define MFMA16(a, b, c) __builtin_amdgcn_mfma_f32_16x16x32_bf16((a), (b), (c), 0, 0, 0)

namespace pg8 {
constexpr int BM = 256, BK = 64, HALF = 128, HTB = HALF * BK * 2, STAGE_BYTES = 8 * HTB, NXCD = 8, WGM = 8;
__host__ __device__ __forceinline__ int lds_byte(int r, int c) { const int st = (r >> 4) * 2 + (c >> 5), rr = r & 15, cc = c & 31, ob = rr * 64 + cc * 2; return st * 1024 + (ob ^ (((ob >> 9) & 1) << 5)); }
__host__ __device__ __forceinline__ void stage_rc(int b, int& R, int& C) { const int st = b / 1024, sb = b % 1024, swz = sb ^ (((sb >> 9) & 1) << 5); R = (st >> 1) * 16 + swz / 64; C = (st & 1) * 32 + (swz % 64) / 2; }
__host__ __device__ __forceinline__ int perm32(int rho) { const int n = rho >> 4, i = rho & 15; return 8 * (i >> 2) + 4 * n + (i & 3); }

struct Unit { int pm, pn, sub; };
struct Gemm { const bf16_t* A; const bf16_t* Bt; int nsub; };
struct Order {
    int nM, nN, nwg, G, c, nsub;
    __device__ void init(int M, int N, int G_, int c_, int nsub_) { nM = M / BM; nN = N / BM; nwg = nM * nN; G = G_; c = c_; nsub = nsub_; }
    __device__ bool next(int i, Unit& u) const {
        const int ti = i / nsub; u.sub = i - ti * nsub;
        const long L = (long)ti * G + c; if (L >= nwg) return false;
        int wgid = (int)L; { const int q = nwg / NXCD, r = nwg % NXCD, xcd = wgid % NXCD, off = wgid / NXCD; wgid = (xcd < r ? xcd * (q + 1) : r * (q + 1) + (xcd - r) * q) + off; }
        const int nig = WGM * nN, gid = wgid / nig, fm = gid * WGM, gsz = (nM - fm) < WGM ? (nM - fm) : WGM;
        u.pm = fm + ((wgid % nig) % gsz); u.pn = (wgid % nig) / gsz; return true;
    }
};

template <class Epi, int LDA, int LDB, int K, int A0 = 0, int A1 = 0, int A2 = 0, int BS = 0>
__device__ __forceinline__ void gemm_phase(LAS unsigned char* lds, const Gemm g, const Order& S, const Epi& E, int wid) {
    const int lane = lane_id_asm(), tid = wid * 64 + lane, wr = wid >> 2, wc = wid & 3, fr = lane & 15, fq = lane >> 4;
    constexpr int nt = K / BK;
    unsigned voffA[2], voffB[2];
#pragma unroll
    for (int i = 0; i < 2; ++i) { int R, C; stage_rc(tid * 16 + i * 8192, R, C); const int Rb = Epi::PERM ? ((R & ~31) + perm32(R & 31)) : R;
        voffA[i] = (unsigned)(R * LDA + C) * 2u; voffB[i] = (unsigned)(Rb * LDB + C) * 2u; }
    constexpr size_t kstep = (size_t)(BK * 2);
    constexpr size_t hstepA = (size_t)HALF * LDA * 2, hstepB = (size_t)HALF * LDB * 2;
    constexpr size_t tstepA = 2 * hstepA, tstepB = 2 * hstepB;
    const unsigned ldsw = (unsigned)wid * 1024u;
    const int aoff = lds_byte(wr * 64 + fr, fq * 8), boff = lds_byte(wc * 32 + fr, fq * 8);
#define PG8_SA(b, h) (((b) * 2 + (h)) * HTB)
#define PG8_SB(b, h) ((4 + (b) * 2 + (h)) * HTB)
#define PG8_STAGE(bufoff, gbase, voff) do { _Pragma("unroll") for (int _i = 0; _i < 2; ++_i) \
        __builtin_amdgcn_global_load_lds((const unsigned*)((const char*)(gbase) + (voff)[_i]), (LAS unsigned*)(lds + (bufoff) + ldsw + _i * 8192), 16, 0, 0); } while (0)
#define PG8_LDA(dst, b, h) do { _Pragma("unroll") for (int m = 0; m < 4; ++m) _Pragma("unroll") for (int k = 0; k < 2; ++k) dst[m][k] = *(const LAS bf16x8*)(lds + PG8_SA(b, h) + aoff + m * 2048 + k * 1024); } while (0)
#define PG8_LDB(dst, b, h) do { _Pragma("unroll") for (int n = 0; n < 2; ++n) _Pragma("unroll") for (int k = 0; k < 2; ++k) dst[n][k] = *(const LAS bf16x8*)(lds + PG8_SB(b, h) + boff + n * 2048 + k * 1024); } while (0)
#define PG8_MMA(ai, bj, At, Bt) do { __builtin_amdgcn_s_setprio(1); _Pragma("unroll") for (int m = 0; m < 4; ++m) _Pragma("unroll") for (int n = 0; n < 2; ++n) _Pragma("unroll") for (int k = 0; k < 2; ++k) \
        acc[ai][bj][m][n] = __builtin_amdgcn_mfma_f32_16x16x32_bf16(Bt[n][k], At[m][k], acc[ai][bj][m][n], 0, 0, 0); __builtin_amdgcn_s_setprio(0); } while (0)
#define PG8_WAIT_V(n) asm volatile("s_waitcnt vmcnt(" #n ")" ::: "memory")
#define PG8_WAIT_L(n) asm volatile("s_waitcnt lgkmcnt(" #n ")" ::: "memory")
#define PG8_BAR __builtin_amdgcn_s_barrier()
#define PG8_SCHED __builtin_amdgcn_sched_barrier(0)
    Unit cur, nxt; int ui = 0;
    if (!S.next(0, cur)) return;
    f32x4 acc[2][2][4][2];
#pragma unroll
    for (int a = 0; a < 2; ++a)
#pragma unroll
        for (int b = 0; b < 2; ++b)
#pragma unroll
            for (int m = 0; m < 4; ++m)
#pragma unroll
                for (int n = 0; n < 2; ++n) acc[a][b][m][n] = (f32x4){0.f, 0.f, 0.f, 0.f};
    bf16x8 At[4][2], B0[2][2], B1[2][2];
    const char* cA = (const char*)(g.A + (cur.sub == 0 ? A0 : (cur.sub == 1 ? A1 : A2))) + (size_t)cur.pm * tstepA; const char* cB = (const char*)(g.Bt + (cur.sub * BS)) + (size_t)cur.pn * tstepB;
    PG8_STAGE(PG8_SB(0, 0), cB, voffB); PG8_STAGE(PG8_SA(0, 0), cA, voffA); PG8_STAGE(PG8_SB(0, 1), cB + hstepB, voffB); PG8_STAGE(PG8_SA(0, 1), cA + hstepA, voffA);
    if (wr == 1) PG8_BAR;
    PG8_WAIT_V(4); PG8_BAR;
    PG8_STAGE(PG8_SB(1, 0), cB + kstep, voffB); PG8_STAGE(PG8_SA(1, 0), cA + kstep, voffA); PG8_STAGE(PG8_SB(1, 1), cB + hstepB + kstep, voffB);
    PG8_WAIT_V(6); PG8_BAR;
    for (;;) {
        const bool has_next = S.next(ui + 1, nxt);
        const char* nA = has_next ? (const char*)(g.A + (nxt.sub == 0 ? A0 : (nxt.sub == 1 ? A1 : A2))) + (size_t)nxt.pm * tstepA : cA; const char* nB = has_next ? (const char*)(g.Bt + (nxt.sub * BS)) + (size_t)nxt.pn * tstepB : cB;
        for (int t = 0; t < nt; t += 2) {
            const bool last = (t == nt - 2);
            const char* a1 = cA + (size_t)(t + 1) * kstep;
            const char* a2 = last ? nA : cA + (size_t)(t + 2) * kstep; const char* b2 = last ? nB : cB + (size_t)(t + 2) * kstep;
            const char* a3 = a2 + kstep; const char* b3 = b2 + kstep;
            PG8_LDB(B0, 0, 0); PG8_SCHED; PG8_LDA(At, 0, 0); PG8_STAGE(PG8_SA(1, 1), a1 + hstepA, voffA);
            PG8_WAIT_L(8); PG8_BAR; PG8_WAIT_L(0); PG8_MMA(0, 0, At, B0); PG8_BAR; PG8_SCHED;
            PG8_LDB(B1, 0, 1); PG8_STAGE(PG8_SB(0, 0), b2, voffB);
            PG8_BAR; PG8_WAIT_L(0); PG8_MMA(0, 1, At, B1); PG8_BAR;
            PG8_LDA(At, 0, 1); PG8_STAGE(PG8_SA(0, 0), a2, voffA);
            PG8_BAR; PG8_WAIT_L(0); PG8_MMA(1, 0, At, B0); PG8_BAR; PG8_SCHED;
            PG8_STAGE(PG8_SB(0, 1), b2 + hstepB, voffB);
            PG8_WAIT_V(6); PG8_BAR; PG8_MMA(1, 1, At, B1); PG8_BAR;
            PG8_LDB(B0, 1, 0); PG8_SCHED; PG8_LDA(At, 1, 0); PG8_STAGE(PG8_SA(0, 1), a2 + hstepA, voffA);
            PG8_WAIT_L(8); PG8_BAR; PG8_WAIT_L(0); PG8_MMA(0, 0, At, B0); PG8_BAR; PG8_SCHED;
            PG8_LDB(B1, 1, 1); PG8_STAGE(PG8_SB(1, 0), b3, voffB);
            PG8_BAR; PG8_WAIT_L(0); PG8_MMA(0, 1, At, B1); PG8_BAR;
            PG8_LDA(At, 1, 1); PG8_STAGE(PG8_SA(1, 0), a3, voffA);
            PG8_BAR; PG8_WAIT_L(0); PG8_MMA(1, 0, At, B0); PG8_BAR; PG8_SCHED;
            PG8_STAGE(PG8_SB(1, 1), b3 + hstepB, voffB);
            PG8_WAIT_V(6); PG8_BAR; PG8_MMA(1, 1, At, B1); PG8_BAR;
        }
        E(acc, cur, wr, wc, fr, fq);
        if (!has_next) break;
        if (!(Epi::KEEP && cur.sub + 1 < g.nsub)) {
#pragma unroll
            for (int a = 0; a < 2; ++a)
#pragma unroll
                for (int b = 0; b < 2; ++b)
#pragma unroll
                    for (int m = 0; m < 4; ++m)
#pragma unroll
                        for (int n = 0; n < 2; ++n) acc[a][b][m][n] = (f32x4){0.f, 0.f, 0.f, 0.f};
        }
        cur = nxt; cA = nA; cB = nB; ++ui;
    }
    PG8_WAIT_V(0);
    if (wr == 0) PG8_BAR;
    PG8_BAR;
#undef PG8_SA
#undef PG8_SB
#undef PG8_STAGE
#undef PG8_LDA
#undef PG8_LDB
#undef PG8_MMA
#undef PG8_WAIT_V
#undef PG8_WAIT_L
#undef PG8_BAR
#undef PG8_SCHED
}
}

typedef f32x4 AccT[2][2][4][2];
struct EpiIn {
    static constexpr bool PERM = true, KEEP = false;
    bf16_t* P; bf16_t* VTa; bf16_t* VTs;
    __device__ __forceinline__ void operator()(AccT& acc, const pg8::Unit& u, int wr, int wc, int fr, int fq) const {
        const int row0 = u.pm * 256 + wr * 64 + fr, trow = u.pm * 256;
        int b, tokbase; if (trow < ML) { b = trow >> 13; tokbase = trow & 8191; } else { b = (trow - ML) >> 8; tokbase = 8192; }
#pragma unroll
        for (int bj = 0; bj < 2; ++bj) {
            int pc = -1;
            if (u.pn < 10) pc = 256 * u.pn + 128 * bj; else if (u.pn == 10) { if (bj == 0) pc = 2560; } else if (u.pn >= 13) pc = 2688 + 256 * (u.pn - 13) + 128 * bj;
            if (pc >= 0) {
#pragma unroll
                for (int ai = 0; ai < 2; ++ai)
#pragma unroll
                    for (int m = 0; m < 4; ++m) { bf16_t* rowp = P + (size_t)(row0 + ai * 128 + m * 16) * PW + pc + wc * 32 + 8 * fq;
                        const f32x4 v0 = acc[ai][bj][m][0], v1 = acc[ai][bj][m][1];
                        u32x4 w; w.x = pk2(v0[0], v0[1]); w.y = pk2(v0[2], v0[3]); w.z = pk2(v1[0], v1[1]); w.w = pk2(v1[2], v1[3]);
                        *(u32x4*)rowp = w; }
            } else {
                const bool isS = (u.pn == 10); bf16_t* VT = isS ? VTs : VTa; const int nh = isS ? 2 : 8;
                const int cl = (isS ? 0 : 256 * (u.pn - 11) + 128 * bj) + 32 * wc + 8 * fq;
#pragma unroll
                for (int ai = 0; ai < 2; ++ai)
#pragma unroll
                    for (int m = 0; m < 4; ++m) { const int tok = tokbase + wr * 64 + fr + ai * 128 + m * 16;
#pragma unroll
                        for (int n = 0; n < 2; ++n) { const f32x4 v = acc[ai][bj][m][n]; const unsigned w0 = pk2(v[0], v[1]), w1 = pk2(v[2], v[3]);
                            const int c = cl + 4 * n; bf16_t* base = VT + ((size_t)(b * nh + (c >> 6)) * 64 + (c & 63)) * VTOK + tok;
                            base[0] = (bf16_t)(w0 & 0xffff); base[VTOK] = (bf16_t)(w0 >> 16); base[2 * VTOK] = (bf16_t)(w1 & 0xffff); base[3 * VTOK] = (bf16_t)(w1 >> 16); } }
            }
        }
    }
};
struct EpiMerge {
    static constexpr bool PERM = true, KEEP = true;
    const bf16_t* P; bf16_t* Mo;
    __device__ __forceinline__ void operator()(AccT& acc, const pg8::Unit& u, int wr, int wc, int fr, int fq) const {
        const int row0 = u.pm * 256 + wr * 64 + fr, col0 = u.pn * 256 + wc * 32 + 8 * fq;
        const int gc = (u.sub == 0) ? C_GA : (u.sub == 1 ? C_GR : C_GS), gn = (u.sub == 0) ? C_GR : C_GS;
        const bool lastsub = (u.sub == 2);
#pragma unroll
        for (int ai = 0; ai < 2; ++ai)
#pragma unroll
            for (int m = 0; m < 4; ++m) { const size_t row = (size_t)(row0 + ai * 128 + m * 16);
#pragma unroll
                for (int bj = 0; bj < 2; ++bj) { const int col = col0 + bj * 128;
                    const u32x4 wcur = *(const u32x4*)(P + row * PW + gc + col);
                    u32x4 wnx = wcur; if (!lastsub) wnx = *(const u32x4*)(P + row * PW + gn + col);
                    float f[8];
#pragma unroll
                    for (int q = 0; q < 4; ++q) {
                        const float c0 = bflo(wcur[q]), c1 = bfhi(wcur[q]), n0 = bflo(wnx[q]), n1 = bfhi(wnx[q]);
                        const float d0 = 1.f + fexp2(fminf(-c0 * LOG2E, 100.f)), d1 = 1.f + fexp2(fminf(-c1 * LOG2E, 100.f));
                        const float u0 = lastsub ? 1.f : 1.f + fexp2(fminf(-n0 * LOG2E, 100.f)), u1 = lastsub ? 1.f : 1.f + fexp2(fminf(-n1 * LOG2E, 100.f));
                        f[2 * q] = u0 * frcp(d0); f[2 * q + 1] = u1 * frcp(d1);
                    }
                    f32x4 v0 = acc[ai][bj][m][0], v1 = acc[ai][bj][m][1];
                    v0[0] *= f[0]; v0[1] *= f[1]; v0[2] *= f[2]; v0[3] *= f[3]; v1[0] *= f[4]; v1[1] *= f[5]; v1[2] *= f[6]; v1[3] *= f[7];
                    acc[ai][bj][m][0] = v0; acc[ai][bj][m][1] = v1;
                    if (lastsub) { u32x4 w; w.x = pk2(v0[0], v0[1]); w.y = pk2(v0[2], v0[3]); w.z = pk2(v1[0], v1[1]); w.w = pk2(v1[2], v1[3]);
                        *(u32x4*)(Mo + row * D + col) = w; }
                } }
    }
};
struct EpiRes {
    static constexpr bool PERM = false, KEEP = false;
    float* XL; float* XCp; const float* modl; int gidx; bool dry;
    __device__ __forceinline__ void operator()(AccT& acc, const pg8::Unit& u, int wr, int wc, int fr, int fq) const {
        const int trow = u.pm * 256, row0 = trow + wr * 64 + fr, col0 = u.pn * 256 + wc * 32 + 4 * fq;
        const int v = trow < ML ? (trow >> 13) : 4;
        float* Xb = trow < ML ? XL + (size_t)row0 * D : XCp + (size_t)(row0 - ML) * D;
        f32x4 gv[2][2];
#pragma unroll
        for (int bj = 0; bj < 2; ++bj)
#pragma unroll
            for (int n = 0; n < 2; ++n) gv[bj][n] = *(const f32x4*)(modl + v * 6144 + gidx * 1024 + col0 + bj * 128 + n * 16);
#pragma unroll
        for (int ai = 0; ai < 2; ++ai)
#pragma unroll
            for (int m = 0; m < 4; ++m) { float* rowp = Xb + (size_t)(ai * 128 + m * 16) * D + col0;
#pragma unroll
                for (int bj = 0; bj < 2; ++bj)
#pragma unroll
                    for (int n = 0; n < 2; ++n) { f32x4* p = (f32x4*)(rowp + bj * 128 + n * 16); f32x4 xv = *p; xv += gv[bj][n] * acc[ai][bj][m][n]; if (!dry) *p = xv; } }
    }
};
struct EpiFF1 {
    static constexpr bool PERM = true, KEEP = false;
    bf16_t* Hd;
    __device__ __forceinline__ void operator()(AccT& acc, const pg8::Unit& u, int wr, int wc, int fr, int fq) const {
        const int row0 = u.pm * 256 + wr * 64 + fr, col0 = u.pn * 256 + wc * 32 + 8 * fq;
#pragma unroll
        for (int ai = 0; ai < 2; ++ai)
#pragma unroll
            for (int m = 0; m < 4; ++m) { bf16_t* rowp = Hd + (size_t)(row0 + ai * 128 + m * 16) * DFF + col0;
#pragma unroll
                for (int bj = 0; bj < 2; ++bj) { f32x4 v0 = acc[ai][bj][m][0], v1 = acc[ai][bj][m][1];
#pragma unroll
                    for (int j = 0; j < 4; ++j) { const float a = fmaxf(v0[j], 0.f), b = fmaxf(v1[j], 0.f); v0[j] = a * a; v1[j] = b * b; }
                    u32x4 w; w.x = pk2(v0[0], v0[1]); w.y = pk2(v0[2], v0[3]); w.z = pk2(v1[0], v1[1]); w.w = pk2(v1[2], v1[3]);
                    *(u32x4*)(rowp + bj * 128) = w; } }
    }
};

__device__ __forceinline__ void transpose_item(const float* W, int ldn, int k0, int nsrc0, bf16_t* WT, int ldt, int ndst0, LAS float* scr, int lane) {
#pragma unroll 8
    for (int i = 0; i < 32; ++i) { const int kk = 2 * i + (lane >> 5); scr[kk * 33 + (lane & 31)] = W[(size_t)(k0 + kk) * ldn + nsrc0 + (lane & 31)]; }
    asm volatile("s_waitcnt lgkmcnt(0)" ::: "memory");
    const int c = lane & 7;
#pragma unroll
    for (int j = 0; j < 4; ++j) { const int n = (lane >> 3) + 8 * j; const LAS float* s = scr + (8 * c) * 33 + n;
        u32x4 o; o.x = pk2(s[0 * 33], s[1 * 33]); o.y = pk2(s[2 * 33], s[3 * 33]); o.z = pk2(s[4 * 33], s[5 * 33]); o.w = pk2(s[6 * 33], s[7 * 33]);
        *(u32x4*)(WT + (size_t)(ndst0 + n) * ldt + k0 + 8 * c) = o; }
    asm volatile("s_waitcnt lgkmcnt(0)" ::: "memory");
}
__device__ __forceinline__ void conv_seg(int& base, int gw, int NGW, const float* W, int K, int ldn, int nsrc0, int ncols, bf16_t* WT, int ldt, int ndst0, LAS float* scr, int lane) {
    const int nblk = ncols / 32, nitems = (K / 64) * nblk;
    int first = base + (((gw - base) % NGW) + NGW) % NGW;
    for (int it = first; it < base + nitems; it += NGW) { const int r = it - base, kb = r / nblk, nb = r - kb * nblk;
        transpose_item(W, ldn, 64 * kb, nsrc0 + 32 * nb, WT, ldt, ndst0 + 32 * nb, scr, lane); }
    base += nitems;
}
__device__ __forceinline__ void convert_stage_a(const KArgs& a, int l, int gw, int NGW, LAS float* scr, int) {
    const int lane = lane_id_asm();
    const float* W = a.w_in + (size_t)l * D * WIN; bf16_t* WT = (bf16_t*)(a.ws + WS_WB); int base = 0;
    conv_seg(base, gw, NGW, W, D, WIN, 0, 1024, WT, D, 0, scr, lane);
    conv_seg(base, gw, NGW, W, D, WIN, 1536, 1024, WT, D, 1024, scr, lane);
    conv_seg(base, gw, NGW, W, D, WIN, 2560, 512, WT, D, 2048, scr, lane);
    conv_seg(base, gw, NGW, W, D, WIN, 3072, 256, WT, D, 2560, scr, lane);
    conv_seg(base, gw, NGW, W, D, WIN, 1024, 512, WT, D, 2816, scr, lane);
    conv_seg(base, gw, NGW, W, D, WIN, 3328, 3072, WT, D, 3328, scr, lane);
}
__device__ __forceinline__ void convert_stage_b(const KArgs& a, int l, int gw, int NGW, LAS float* scr, int) {
    const int lane = lane_id_asm();
    bf16_t* WB = (bf16_t*)(a.ws + WS_WB); int base = 0;
    const float* wbr = a.w_branch + (size_t)l * 1536 * D;
    for (int i = 0; i < 3; ++i) conv_seg(base, gw, NGW, wbr + (size_t)i * 512 * D, 512, D, 0, D, WB + WB_BR + i * 524288, 512, 0, scr, lane);
    conv_seg(base, gw, NGW, a.w_out + (size_t)l * D * D, D, D, 0, D, WB + WB_OUT, D, 0, scr, lane);
    conv_seg(base, gw, NGW, a.w_ff1 + (size_t)l * D * DFF, D, DFF, 0, DFF, WB + WB_FF1, D, 0, scr, lane);
    conv_seg(base, gw, NGW, a.w_ff2 + (size_t)l * DFF * D, DFF, D, 0, D, WB + WB_FF2, DFF, 0, scr, lane);
}

__device__ __forceinline__ void phase0(const KArgs& a, LAS unsigned char* lds, int gw, int NGW, int wave, int lane) {
    LAS float* cond = (LAS float*)lds;
    LAS float* red = (LAS float*)(lds + 20480);
    const int tid = wave * 64 + lane;
    for (int i = tid; i < 5 * D; i += 512) { const int v = i >> 10, k = i & 1023; const float cv = v < 4 ? a.c[v * D + k] : a.c_ctx[k]; cond[i] = cv / (1.f + __expf(-cv)); }
    __syncthreads();
    float* mods = (float*)(a.ws + WS_MOD);
    const int col = tid & 127, kq = tid >> 7;
    for (int task = blockIdx.x; task < NL * 48; task += gridDim.x) {
        const int l = task / 48, cc = (task % 48) * 128 + col;
        const float* W = a.w_mod + (size_t)l * D * 6144 + cc;
        float s0 = 0.f, s1 = 0.f, s2 = 0.f, s3 = 0.f, s4 = 0.f;
#pragma unroll 8
        for (int k = kq * 256; k < kq * 256 + 256; ++k) { const float w = W[(size_t)k * 6144];
            s0 += w * cond[k]; s1 += w * cond[1024 + k]; s2 += w * cond[2048 + k]; s3 += w * cond[3072 + k]; s4 += w * cond[4096 + k]; }
        red[(kq * 5 + 0) * 128 + col] = s0; red[(kq * 5 + 1) * 128 + col] = s1; red[(kq * 5 + 2) * 128 + col] = s2; red[(kq * 5 + 3) * 128 + col] = s3; red[(kq * 5 + 4) * 128 + col] = s4;
        __syncthreads();
        for (int o = tid; o < 5 * 128; o += 512) { const int v = o >> 7, c2 = o & 127, ccol = (task % 48) * 128 + c2;
            const float r = red[(0 * 5 + v) * 128 + c2] + red[(1 * 5 + v) * 128 + c2] + red[(2 * 5 + v) * 128 + c2] + red[(3 * 5 + v) * 128 + c2];
            mods[((size_t)l * 5 + v) * 6144 + ccol] = r + a.b_mod[l * 6144 + ccol]; }
        __syncthreads();
    }
    __syncthreads();
    LAS float* scr = (LAS float*)(lds + 32768 + wave * 8448);
    bf16_t* LW = (bf16_t*)(a.ws + WS_LW);
    for (int it = gw; it < NL * 2 * 2 * 8 * 2; it += NGW) { const int half = it & 1, mi = it >> 1, n = mi & 7, mat = (mi >> 3) & 1, ld = mi >> 4;
        const float* W = (mat ? a.lru_wx : a.lru_wa) + ((size_t)ld * 8 + n) * 4096;
        transpose_item(W, 64, 0, 32 * half, LW + ((size_t)(ld * 2 + mat) * 8 + n) * 4096, 64, 32 * half, scr, lane); }
    convert_stage_a(a, 0, gw, NGW, scr, lane);
}

__device__ __forceinline__ void norm_phase(const KArgs& a, int l, bool second, int nrows, int gw, int NGW, int lane) {
    const bool first_read = (l == 0 && !second);
    const float* srcL = first_read ? a.x : a.out; const float* srcC = first_read ? a.ctx : (const float*)(a.ws + WS_XC);
    float* XC = (float*)(a.ws + WS_XC); bf16_t* H = (bf16_t*)(a.ws + WS_H);
    const float* g = (second ? a.norm2_g : a.norm1_g) + l * D; const float* modl = (const float*)(a.ws + WS_MOD) + (size_t)l * 5 * 6144; const int sidx = second ? 3 : 0;
    for (int row = gw; row < nrows; row += NGW) {
        const float* src = row < ML ? srcL + (size_t)row * D : srcC + (size_t)(row - ML) * D; const int v = row < ML ? (row >> 13) : 4;
        const f32x4* xr = (const f32x4*)src + lane; f32x4 xv[4]; float s = 0.f;
#pragma unroll
        for (int j = 0; j < 4; ++j) { xv[j] = xr[64 * j]; s += (xv[j][0] * xv[j][0] + xv[j][1] * xv[j][1]) + (xv[j][2] * xv[j][2] + xv[j][3] * xv[j][3]); }
        const float rstd = 1.0f / sqrtf(wave_sum(s) * (1.f / D) + 1e-6f);
        if (first_read) { f32x4* cp = (f32x4*)(row < ML ? a.out + (size_t)row * D : XC + (size_t)(row - ML) * D) + lane;
#pragma unroll
            for (int j = 0; j < 4; ++j) cp[64 * j] = xv[j]; }
        u32x2* o8 = (u32x2*)(H + (size_t)row * D) + lane;
#pragma unroll
        for (int j = 0; j < 4; ++j) { const int c = 4 * lane + 256 * j; const f32x4 gg = *(const f32x4*)(g + c), sh = *(const f32x4*)(modl + v * 6144 + sidx * 1024 + c), sc = *(const f32x4*)(modl + v * 6144 + (sidx + 1) * 1024 + c);
            f32x4 h = xv[j] * rstd * gg * (sc + 1.0f) + sh; u32x2 w; w.x = pk2(h[0], h[1]); w.y = pk2(h[2], h[3]); o8[64 * j] = w; }
    }
}
__device__ __forceinline__ void final_norm(const KArgs& a, int gw, int NGW, int lane) {
    for (int row = gw; row < ML; row += NGW) {
        f32x4* xr = (f32x4*)(a.out + (size_t)row * D) + lane; f32x4 xv[4]; float s = 0.f;
#pragma unroll
        for (int j = 0; j < 4; ++j) { xv[j] = xr[64 * j]; s += (xv[j][0] * xv[j][0] + xv[j][1] * xv[j][1]) + (xv[j][2] * xv[j][2] + xv[j][3] * xv[j][3]); }
        const float rstd = 1.0f / sqrtf(wave_sum(s) * (1.f / D) + 1e-6f);
#pragma unroll
        for (int j = 0; j < 4; ++j) { const f32x4 gg = *(const f32x4*)(a.final_g + 4 * lane + 256 * j); xr[64 * j] = xv[j] * rstd * gg; }
    }
}

struct AttnSt { f32x4 o[4]; float m, l; };
template <class BiasF>
__device__ __forceinline__ void attn_block(AttnSt& st, const bf16_t* k0p, const bf16_t* k1p, const bf16_t* vtp, const bf16x8 (&qf)[2], BiasF bias) {
    const bf16x8 ka0 = *(const bf16x8*)k0p, ka1 = *(const bf16x8*)(k0p + 32), kb0 = *(const bf16x8*)k1p, kb1 = *(const bf16x8*)(k1p + 32);
    s16x4 vv[4][2];
#pragma unroll
    for (int dt = 0; dt < 4; ++dt) { vv[dt][0] = *(const s16x4*)(vtp + (size_t)dt * 16 * VTOK); vv[dt][1] = *(const s16x4*)(vtp + (size_t)dt * 16 * VTOK + 16); }
    f32x4 s0 = {0.f, 0.f, 0.f, 0.f}, s1 = {0.f, 0.f, 0.f, 0.f};
    s0 = MFMA16(ka0, qf[0], s0); s0 = MFMA16(ka1, qf[1], s0); s1 = MFMA16(kb0, qf[0], s1); s1 = MFMA16(kb1, qf[1], s1);
    float t[8]; const float SC = 0.125f * LOG2E;
#pragma unroll
    for (int j = 0; j < 4; ++j) { t[j] = bias(0, j, s0[j] * SC); t[4 + j] = bias(1, j, s1[j] * SC); }
    float bm = fmaxf(fmaxf(fmaxf(t[0], t[1]), fmaxf(t[2], t[3])), fmaxf(fmaxf(t[4], t[5]), fmaxf(t[6], t[7])));
    bm = fmaxf(bm, __shfl_xor(bm, 16)); bm = fmaxf(bm, __shfl_xor(bm, 32));
    const float mn = fmaxf(st.m, bm), alpha = fexp2(st.m - mn); st.m = mn;
    float ls = 0.f;
#pragma unroll
    for (int j = 0; j < 8; ++j) { t[j] = fexp2(t[j] - mn); ls += t[j]; }
    st.l = st.l * alpha + ls;
    u32x4 pw; pw.x = pk2(t[0], t[1]); pw.y = pk2(t[2], t[3]); pw.z = pk2(t[4], t[5]); pw.w = pk2(t[6], t[7]);
    const bf16x8 pf = __builtin_bit_cast(bf16x8, pw);
#pragma unroll
    for (int dt = 0; dt < 4; ++dt) { st.o[dt] *= alpha; const bf16x8 vf = __builtin_shufflevector(vv[dt][0], vv[dt][1], 0, 1, 2, 3, 4, 5, 6, 7); st.o[dt] = MFMA16(vf, pf, st.o[dt]); }
}
__device__ __forceinline__ void attn_init(AttnSt& st) {
#pragma unroll
    for (int dt = 0; dt < 4; ++dt) st.o[dt] = (f32x4){0.f, 0.f, 0.f, 0.f};
    st.m = -1.0e30f; st.l = 0.f;
}
__device__ __forceinline__ void attn_ctx_blocks(AttnSt& st, const bf16_t* P, const bf16_t* VT, int b, int kcol, int vrow0, const bf16x8 (&qf)[2], int lane) {
    const int c16 = lane & 15, g = lane >> 4;
    for (int cb = 0; cb < 8; ++cb) {
        const bf16_t* k0p = P + (size_t)(ML + b * CTX + 32 * cb + c16) * PW + kcol + 8 * g;
        const bf16_t* vtp = VT + (size_t)(vrow0 + c16) * VTOK + 8192 + 32 * cb + 4 * g;
        attn_block(st, k0p, k0p + (size_t)16 * PW, vtp, qf, [](int, int, float s) { return s; });
    }
}
__device__ __forceinline__ void attn_store(const AttnSt& st, float lextra, bf16_t* orow, int lane, bool dry) {
    float l = st.l; l += __shfl_xor(l, 16); l += __shfl_xor(l, 32); l += lextra;
    const float inv = 1.0f / l; const int g = lane >> 4;
#pragma unroll
    for (int dt = 0; dt < 4; ++dt) { const f32x4 o = st.o[dt] * inv; u32x2 w; w.x = pk2(o[0], o[1]); w.y = pk2(o[2], o[3]); if (!dry) *(u32x2*)(orow + 16 * dt + 4 * g) = w; }
}
__device__ __forceinline__ void na_item(const KArgs& a, int l, int item, int lane, bool dry) {
    bf16_t* P = (bf16_t*)(a.ws + WS_P); const bf16_t* VT = (const bf16_t*)(a.ws + WS_VTA);
    const int i = item & 3, h = (item >> 2) & 7, r = (item >> 5) & 127, b = item >> 12;
    const int c16 = lane & 15, g = lane >> 4;
    const int cq = 16 * i + c16; const size_t qrow = (size_t)b * S + r * 64 + cq;
    bf16x8 qf[2]; qf[0] = *(const bf16x8*)(P + qrow * PW + C_QA + h * 64 + 8 * g); qf[1] = *(const bf16x8*)(P + qrow * PW + C_QA + h * 64 + 32 + 8 * g);
    const int c0 = (i == 0) ? 0 : (i == 1 ? 8 : (i == 2 ? 24 : 32));
    const int rs = min(max(r - 4, 0), 120), cs = min(max(cq - 8, 0), 48);
    AttnSt st; attn_init(st);
    const float* rpb = a.na_rpb + ((size_t)l * 8 + h) * 15 * 31;
    for (int kr = 0; kr < 8; ++kr) {
        const int R = rs + kr; const float* rp = rpb + (R - r + 7) * 31;
        const size_t tok0 = (size_t)R * 64 + c0;
        const bf16_t* k0p = P + ((size_t)b * S + tok0 + c16) * PW + C_KA + h * 64 + 8 * g;
        const bf16_t* vtp = VT + (size_t)((b * 8 + h) * 64 + c16) * VTOK + tok0 + 4 * g;
        attn_block(st, k0p, k0p + (size_t)16 * PW, vtp, qf, [&](int mt, int j, float s) {
            const int kc = c0 + 16 * mt + 4 * g + j; const bool ok = (kc >= cs) && (kc < cs + 16);
            const int idx = min(max(kc - cq + 15, 0), 30); const float bv = rp[idx] * LOG2E;
            return ok ? s + bv : NEGBIG; });
    }
    attn_ctx_blocks(st, P, VT, b, C_KA + h * 64, (b * 8 + h) * 64, qf, lane);
    attn_store(st, 0.f, P + qrow * PW + C_QA + h * 64, lane, dry);
}
__device__ __forceinline__ void ctx_item(const KArgs& a, int l, int item, bool swa, int lane, bool dry) {
    bf16_t* P = (bf16_t*)(a.ws + WS_P);
    const int i = item & 15, h = (item >> 4) & 7, b = item >> 7;
    const int c16 = lane & 15, g = lane >> 4;
    const size_t qrow = (size_t)ML + b * CTX + 16 * i + c16; const int qc = (swa ? C_QS : C_QA) + h * 64;
    bf16x8 qf[2]; qf[0] = *(const bf16x8*)(P + qrow * PW + qc + 8 * g); qf[1] = *(const bf16x8*)(P + qrow * PW + qc + 32 + 8 * g);
    AttnSt st; attn_init(st);
    if (swa) attn_ctx_blocks(st, P, (const bf16_t*)(a.ws + WS_VTS), b, C_KS + (h >> 2) * 64, (b * 2 + (h >> 2)) * 64, qf, lane);
    else attn_ctx_blocks(st, P, (const bf16_t*)(a.ws + WS_VTA), b, C_KA + h * 64, (b * 8 + h) * 64, qf, lane);
    const float lex = swa ? fexp2(a.swa_sink[l * 8 + h] * LOG2E - st.m) : 0.f;
    attn_store(st, lex, P + qrow * PW + qc, lane, dry);
}
__device__ __forceinline__ float inv_freq(int f) { return exp2f(-(float)f * (13.287712379549449f / 16.0f)); }
__device__ __forceinline__ void rope_cs(int pos, int f, float& c, float& s) {
    const float ang = (float)pos * inv_freq(f); float rev = ang * 0.15915494309189535f; rev -= rintf(rev);
    c = __builtin_amdgcn_cosf(rev); s = __builtin_amdgcn_sinf(rev);
}
__device__ __forceinline__ void swa_item(const KArgs& a, int l, int item, int lane, bool dry) {
    bf16_t* P = (bf16_t*)(a.ws + WS_P); const bf16_t* VT = (const bf16_t*)(a.ws + WS_VTS);
    const int qt = item & 511, h = (item >> 9) & 7, b = item >> 12, kvh = h >> 2;
    const int c16 = lane & 15, g = lane >> 4;
    const int tq = 16 * qt + c16; const size_t qrow = (size_t)b * S + tq;
    bf16x8 qf[2]; qf[0] = *(const bf16x8*)(P + qrow * PW + C_QS + h * 64 + 8 * g); qf[1] = *(const bf16x8*)(P + qrow * PW + C_QS + h * 64 + 32 + 8 * g);
    {
        const int pos = (g < 2) ? (tq >> 6) : (tq & 63);
        u32x4 w0 = __builtin_bit_cast(u32x4, qf[0]), w1 = __builtin_bit_cast(u32x4, qf[1]);
#pragma unroll
        for (int q = 0; q < 4; ++q) {
            float c0, s0, c1, s1; rope_cs(pos, 8 * (g & 1) + 2 * q, c0, s0); rope_cs(pos, 8 * (g & 1) + 2 * q + 1, c1, s1);
            const float a0 = bflo(w0[q]), a1 = bfhi(w0[q]), b0 = bflo(w1[q]), b1 = bfhi(w1[q]);
            w0[q] = pk2(a0 * c0 - b0 * s0, a1 * c1 - b1 * s1); w1[q] = pk2(b0 * c0 + a0 * s0, b1 * c1 + a1 * s1);
        }
        qf[0] = __builtin_bit_cast(bf16x8, w0); qf[1] = __builtin_bit_cast(bf16x8, w1);
    }
    AttnSt st; attn_init(st);
    const int kstart = 16 * qt - 128;
    for (int kb = 0; kb < 9; ++kb) {
        const int k0 = kstart + 32 * kb; if (k0 + 31 < 0 || k0 >= S) continue;
        const int ka = min(max(k0 + c16, 0), S - 1), kbk = min(max(k0 + 16 + c16, 0), S - 1);
        const bf16_t* k0p = P + ((size_t)b * S + ka) * PW + C_KS + kvh * 64 + 8 * g;
        const bf16_t* k1p = P + ((size_t)b * S + kbk) * PW + C_KS + kvh * 64 + 8 * g;
        const int v0 = min(max(k0 + 4 * g, 0), S - 4), v1 = min(max(k0 + 16 + 4 * g, 0), S - 4);
        const bf16_t* vrow = VT + (size_t)((b * 2 + kvh) * 64 + c16) * VTOK;
        const bool inr = (k0 >= 0) && (k0 + 31 < S);
        const bf16_t* vtp = vrow + (inr ? (k0 + 4 * g) : ((v1 == v0 + 16) ? v0 : min(v0, S - 20)));
        attn_block(st, k0p, k1p, vtp, qf, [&](int mt, int j, float s) {
            const int k = k0 + 16 * mt + 4 * g + j; const int dlt = k - tq;
            const bool ok = (k >= 0) && (k < S) && (dlt <= 128) && (dlt >= -128);
            return ok ? s : NEGBIG; });
    }
    attn_ctx_blocks(st, P, VT, b, C_KS + kvh * 64, (b * 2 + kvh) * 64, qf, lane);
    const float lex = fexp2(a.swa_sink[l * 8 + h] * LOG2E - st.m);
    attn_store(st, lex, P + qrow * PW + C_QS + h * 64, lane, dry);
}
__device__ __forceinline__ void rope_k_phase(const KArgs& a, int gw, int NGW, int lane, bool dry) {
    bf16_t* P = (bf16_t*)(a.ws + WS_P);
    const int hd = lane >> 5, i = lane & 31;
    for (int row = gw; row < ML; row += NGW) {
        const int t = row & (S - 1); const int pos = (i < 16) ? (t >> 6) : (t & 63);
        float c, s; rope_cs(pos, i & 15, c, s);
        bf16_t* p = P + (size_t)row * PW + C_KS + hd * 64;
        const float t1 = bf2f(p[i]), t2 = bf2f(p[i + 32]);
        const unsigned w = pk2(t1 * c - t2 * s, t2 * c + t1 * s);
        if (!dry) { p[i] = (bf16_t)(w & 0xffff); p[i + 32] = (bf16_t)(w >> 16); }
    }
}

__device__ __forceinline__ float neg_expm1(float x) {
    const float ser = -x * (1.f + x * (0.5f + x * (0.16666667f + x * (0.041666668f + x * (0.0083333338f + x * 0.0013888889f)))));
    return x > -0.25f ? ser : 1.f - __expf(x);
}
template <int DIR, bool WRITE>
__device__ __forceinline__ void lru_sweep(const KArgs& a, int l, int b, int n, int sp, float (&carry)[4], float (&arun)[4], int lane, bool dry = false) {
    bf16_t* P = (bf16_t*)(a.ws + WS_P); float* HT = (float*)(a.ws + WS_H); const bf16_t* LW = (const bf16_t*)(a.ws + WS_LW);
    const int c16 = lane & 15, g = lane >> 4; const int gg = DIR ? 3 - g : g;
    const bool lat = sp < 64; const int rowbase = lat ? b * S : ML + b * CTX, seglen = lat ? S : CTX, t0 = (lat ? sp : sp - 64) * 128;
    float ba[4], bx[4], spc[4];
#pragma unroll
    for (int nt = 0; nt < 4; ++nt) { const int ch = n * 64 + 16 * nt + c16, o = (l * 2 + DIR) * 512 + ch;
        ba[nt] = a.lru_ba[o]; bx[nt] = a.lru_bx[o]; const float lam = a.lru_lambda[o]; spc[nt] = (lam < -15.f) ? -lam : log1pf(__expf(-lam)); }
    const bf16_t* lwa = LW + ((size_t)((l * 2 + DIR) * 2 + 0) * 8 + n) * 4096 + c16 * 64 + 8 * g;
    const bf16_t* lwx = LW + ((size_t)((l * 2 + DIR) * 2 + 1) * 8 + n) * 4096 + c16 * 64 + 8 * g;
    const float* cw = a.conv_w + (size_t)l * 4 * 512; const float* cbias = a.conv_b + (size_t)l * 512;
    const int srcm = DIR ? lane + 16 : lane - 16, srcm2 = DIR ? lane + 32 : lane - 32, srct = DIR ? c16 : 48 + c16;
    for (int ti = 0; ti < 8; ++ti) {
        asm volatile("" ::: "memory");
        const int tile = DIR ? 7 - ti : ti; const int tt = t0 + 16 * tile; const int t = tt + c16;
        bf16x8 uf[2];
#pragma unroll
        for (int ks = 0; ks < 2; ++ks) { const int chb = n * 64 + 32 * ks + 8 * g;
            f32x4 u0 = *(const f32x4*)(cbias + chb), u1 = *(const f32x4*)(cbias + chb + 4);
#pragma unroll
            for (int i = 0; i < 4; ++i) { const int tp = t + i - 2; const bool ok = (tp >= 0) && (tp < seglen); const int tc = min(max(tp, 0), seglen - 1);
                const u32x4 xw = *(const u32x4*)(P + (size_t)(rowbase + tc) * PW + C_XB + chb);
                f32x4 w0 = *(const f32x4*)(cw + i * 512 + chb), w1 = *(const f32x4*)(cw + i * 512 + chb + 4);
                if (!ok) { w0 = (f32x4){0.f, 0.f, 0.f, 0.f}; w1 = w0; }
                u0[0] += w0[0] * bflo(xw[0]); u0[1] += w0[1] * bfhi(xw[0]); u0[2] += w0[2] * bflo(xw[1]); u0[3] += w0[3] * bfhi(xw[1]);
                u1[0] += w1[0] * bflo(xw[2]); u1[1] += w1[1] * bfhi(xw[2]); u1[2] += w1[2] * bflo(xw[3]); u1[3] += w1[3] * bfhi(xw[3]); }
            u32x4 pw; pw.x = pk2(u0[0], u0[1]); pw.y = pk2(u0[2], u0[3]); pw.z = pk2(u1[0], u1[1]); pw.w = pk2(u1[2], u1[3]);
            uf[ks] = __builtin_bit_cast(bf16x8, pw); }
#pragma unroll
        for (int nt = 0; nt < 4; ++nt) {
            f32x4 ga = {0.f, 0.f, 0.f, 0.f}, gx = ga, ud = ga;
#pragma unroll
            for (int ks = 0; ks < 2; ++ks) {
                const bf16x8 wa = *(const bf16x8*)(lwa + nt * 1024 + 32 * ks), wx = *(const bf16x8*)(lwx + nt * 1024 + 32 * ks);
                bf16x8 idf;
#pragma unroll
                for (int j = 0; j < 8; ++j) idf[j] = (32 * ks + 8 * g + j == 16 * nt + c16) ? (short)0x3F80 : (short)0;
                ga = MFMA16(uf[ks], wa, ga); gx = MFMA16(uf[ks], wx, gx); ud = MFMA16(uf[ks], idf, ud);
            }
            float av[4], bv[4];
#pragma unroll
            for (int j = 0; j < 4; ++j) {
                const float r = frcp(1.f + __expf(-(ga[j] + ba[nt]))), ii = frcp(1.f + __expf(-(gx[j] + bx[nt])));
                const float la = -8.0f * r * spc[nt];
                av[j] = __expf(la); bv[j] = sqrtf(neg_expm1(2.0f * la)) * ii * ud[j];
            }
            float Pj[4], Hj[4];
#pragma unroll
            for (int jj = 0; jj < 4; ++jj) { const int j = DIR ? 3 - jj : jj;
                if (jj == 0) { Pj[0] = av[j]; Hj[0] = bv[j]; } else { Pj[jj] = Pj[jj - 1] * av[j]; Hj[jj] = av[j] * Hj[jj - 1] + bv[j]; } }
            float Ai = Pj[3], Hi = Hj[3];
            { const float A1 = __shfl(Ai, srcm), H1 = __shfl(Hi, srcm); if (gg >= 1) { Hi = Ai * H1 + Hi; Ai = Ai * A1; } }
            { const float A2 = __shfl(Ai, srcm2), H2 = __shfl(Hi, srcm2); if (gg >= 2) { Hi = Ai * H2 + Hi; Ai = Ai * A2; } }
            float Ae = __shfl(Ai, srcm), He = __shfl(Hi, srcm); if (gg == 0) { Ae = 1.f; He = 0.f; }
            const float At = __shfl(Ai, srct), Ht = __shfl(Hi, srct);
            const float cin = Ae * carry[nt] + He;
            if (WRITE) {
#pragma unroll
                for (int jj = 0; jj < 4; ++jj) { const int j = DIR ? 3 - jj : jj; const float hv = Hj[jj] + Pj[jj] * cin;
                    const size_t row = (size_t)(rowbase + tt + 4 * g + j); const int ch = n * 64 + 16 * nt + c16;
                    if (DIR == 0) HT[row * 512 + ch] = hv;
                    else { bf16_t* gp = P + row * PW + C_GB + ch; const float gbv = bf2f(*gp); const float y = HT[row * 512 + ch] + hv;
                        const float z = 0.7978845608028654f * (gbv + 0.044715f * gbv * gbv * gbv); const float th = 1.f - 2.f * frcp(1.f + __expf(2.f * z));
                        const float ge = 0.5f * gbv * (1.f + th); if (!dry) *gp = (bf16_t)(pk2(y * ge, 0.f) & 0xffff); } }
            }
            carry[nt] = At * carry[nt] + Ht; arun[nt] *= At;
        }
    }
}
__device__ __forceinline__ void lru_pass1_item(const KArgs& a, int l, int item, int lane) {
    const int dir = item & 1, n = (item >> 1) & 7, rest = item >> 4, sp = rest % 66, b = rest / 66;
    float carry[4] = {0.f, 0.f, 0.f, 0.f}, arun[4] = {1.f, 1.f, 1.f, 1.f};
    if (dir) lru_sweep<1, false>(a, l, b, n, sp, carry, arun, lane); else lru_sweep<0, false>(a, l, b, n, sp, carry, arun, lane);
    float* SUM = (float*)(a.ws + WS_SUM);
    if (lane < 16) {
#pragma unroll
        for (int nt = 0; nt < 4; ++nt) { float* p = SUM + ((size_t)((b * 66 + sp) * 2 + dir) * 512 + n * 64 + 16 * nt + lane) * 2; p[0] = arun[nt]; p[1] = carry[nt]; }
    }
}
__device__ __forceinline__ void lru_fold(const float* SUM, int b, int p, int dir, int n, int c16, float (&carry)[4]) {
#pragma unroll
    for (int nt = 0; nt < 4; ++nt) { const float* q = SUM + ((size_t)((b * 66 + p) * 2 + dir) * 512 + n * 64 + 16 * nt + c16) * 2; carry[nt] = q[0] * carry[nt] + q[1]; }
}
__device__ __forceinline__ void lru_pass2_item(const KArgs& a, int l, int item, int lane, bool dry) {
    const int n = item & 7, rest = item >> 3, sp = rest % 66, b = rest / 66; const int c16 = lane & 15;
    const float* SUM = (const float*)(a.ws + WS_SUM);
    float carry[4] = {0.f, 0.f, 0.f, 0.f}, arun[4] = {1.f, 1.f, 1.f, 1.f};
    if (sp < 64) { lru_fold(SUM, b, 64, 0, n, c16, carry); lru_fold(SUM, b, 65, 0, n, c16, carry); for (int p = 0; p < sp; ++p) lru_fold(SUM, b, p, 0, n, c16, carry); }
    else if (sp == 65) lru_fold(SUM, b, 64, 0, n, c16, carry);
    lru_sweep<0, true>(a, l, b, n, sp, carry, arun, lane);
#pragma unroll
    for (int nt = 0; nt < 4; ++nt) carry[nt] = 0.f;
    if (sp < 64) { lru_fold(SUM, b, 65, 1, n, c16, carry); lru_fold(SUM, b, 64, 1, n, c16, carry); for (int p = 63; p > sp; --p) lru_fold(SUM, b, p, 1, n, c16, carry); }
    else if (sp == 64) lru_fold(SUM, b, 65, 1, n, c16, carry);
    lru_sweep<1, true>(a, l, b, n, sp, carry, arun, lane, dry);
}


#define XB_TMO      128
#define XB_XCNT(j)  (256  + 64 * (j))
#define XB_XSUB(j)  (1280 + 64 * (j))
#define XB_XGEN(j)  (2304 + 64 * (j))
#define XB_TOP      3328
#define XB_TOPGEN   3392
#define XCD_BAR_WORDS 3456
#define XB_SPIN_CAP (1u << 18)
__device__ __forceinline__ unsigned xb_ld(unsigned* p)              { return __hip_atomic_load(p, __ATOMIC_RELAXED, __HIP_MEMORY_SCOPE_AGENT); }
__device__ __forceinline__ unsigned xb_add(unsigned* p, unsigned v) { return __hip_atomic_fetch_add(p, v, __ATOMIC_RELAXED, __HIP_MEMORY_SCOPE_AGENT); }
__device__ __forceinline__ unsigned xb_xcc_id() { return (unsigned)__builtin_amdgcn_s_getreg((3 << 11) | 20) & 0xFu; }
#define XB_SPIN(cond, bar) do { unsigned _sp = 0; while (cond) { __builtin_amdgcn_s_sleep(1); \
    if ((++_sp & 255u) == 0u) { if (xb_ld(&(bar)[XB_TMO])) break; if (_sp > XB_SPIN_CAP) { atomicAdd(&(bar)[XB_TMO], 1u); break; } } } } while (0)
struct XcdBarrier { unsigned* bar; unsigned x; volatile LAS unsigned* st; };
__device__ __forceinline__ XcdBarrier xcd_barrier_post(unsigned* bar, volatile LAS unsigned* st) {
    XcdBarrier b; b.bar = bar; b.x = xb_xcc_id(); b.st = st;
    if (threadIdx.x == 0) (void)xb_add(&bar[XB_XCNT(b.x)], 1u);
    return b;
}
__device__ __forceinline__ void xcd_barrier_complete(unsigned* bar, unsigned x, unsigned& nloc, unsigned& nx) {
    const unsigned G = gridDim.x * gridDim.y * gridDim.z;
    unsigned sum, cnt, mine, sp = 0u;
    for (;;) {
        sum = 0u; cnt = 0u; mine = 0u;
#pragma unroll
        for (unsigned j = 0; j < 16; ++j) { const unsigned c = xb_ld(&bar[XB_XCNT(j)]); sum += c; cnt += (c > 0u) ? 1u : 0u; mine = (j == x) ? c : mine; }
        if (sum == G) break;
        __builtin_amdgcn_s_sleep(1);
        if ((++sp & 255u) == 0u) { if (xb_ld(&bar[XB_TMO])) break; if (sp > XB_SPIN_CAP) { atomicAdd(&bar[XB_TMO], 1u); break; } }
    }
    nloc = mine > 0u ? mine : 1u; nx = cnt > 0u ? cnt : 1u;
}
__device__ __forceinline__ void xcd_barrier(const XcdBarrier& b) {
    asm volatile("s_waitcnt vmcnt(0)" ::: "memory");
    __syncthreads();
    if (threadIdx.x == 0) {
        unsigned* bar = b.bar;
        __builtin_amdgcn_s_waitcnt(0);
        unsigned nloc = b.st[0], nx = b.st[1];
        if (nloc == 0u) { xcd_barrier_complete(bar, b.x, nloc, nx); b.st[0] = nloc; b.st[1] = nx; }
        const unsigned old = xb_add(&bar[XB_XSUB(b.x)], 1u);
        const unsigned gen = old / nloc;
        if (old + 1u == (gen + 1u) * nloc) {
            __builtin_amdgcn_fence(__ATOMIC_RELEASE, "agent");
            asm volatile("s_waitcnt vmcnt(0)" ::: "memory");
            const unsigned og = xb_add(&bar[XB_TOP], 1u);
            const unsigned tg = og / nx;
            if (og + 1u == (tg + 1u) * nx) xb_add(&bar[XB_TOPGEN], 1u);
            else XB_SPIN(xb_ld(&bar[XB_TOPGEN]) == tg, bar);
            __builtin_amdgcn_fence(__ATOMIC_ACQUIRE, "agent");
            xb_add(&bar[XB_XGEN(b.x)], 1u);
            asm volatile("s_waitcnt vmcnt(0)" ::: "memory");
        } else {
            XB_SPIN(xb_ld(&bar[XB_XGEN(b.x)]) == gen, bar);
            __builtin_amdgcn_fence(__ATOMIC_ACQUIRE, "agent");
            asm volatile("s_waitcnt vmcnt(0)" ::: "memory");
        }
    }
    __syncthreads();
}

__global__ void __launch_bounds__(512, 2) fwd_kernel(KArgs a) {
    extern __shared__ __attribute__((aligned(16))) unsigned char smem[];
    LAS unsigned char* lds = (LAS unsigned char*)smem;
    cg::grid_group grid = cg::this_grid();
    const int G = gridDim.x, NGW = G * 8;
    const int wave = __builtin_amdgcn_readfirstlane(threadIdx.x >> 6);
    volatile LAS unsigned* bst = (volatile LAS unsigned*)(lds + 131072);
    if (threadIdx.x < 2) bst[threadIdx.x] = 0u;
    __syncthreads();
    XcdBarrier xbar; xbar.bar = (unsigned*)(a.ws + WS_BAR); xbar.x = 0; xbar.st = bst;
    if (a.ph_hi - a.ph_lo > 1) xbar = xcd_barrier_post((unsigned*)(a.ws + WS_BAR), bst);
    for (int ph = a.ph_lo; ph < a.ph_hi; ++ph) {
        bf16_t* P = (bf16_t*)(a.ws + WS_P); bf16_t* H = (bf16_t*)(a.ws + WS_H); bf16_t* WB = (bf16_t*)(a.ws + WS_WB);
        float* XC = (float*)(a.ws + WS_XC);
        int lane = lane_id_asm(); const int gw = blockIdx.x * 8 + wave;
        if (ph == 0) phase0(a, lds, gw, NGW, wave, lane);
        else if (ph == 37) final_norm(a, gw, NGW, lane);
        else {
            const int l = (ph - 1) / 9, k = (ph - 1) % 9; const bool lastl = (l == NL - 1); const int Mrows = lastl ? ML : MT;
            const float* modl = (const float*)(a.ws + WS_MOD) + (size_t)l * 5 * 6144;
            const int reps = ((PROBE_MASK >> k) & 1) ? 2 : 1;
            for (int rep = 0; rep < reps; ++rep) { const bool dry = (rep + 1 < reps);
            if (rep) { xcd_barrier(xbar); lane = lane_id_asm(); }
            if (k == 0) {
                norm_phase(a, l, false, MT, gw, NGW, lane);
                if (l > 0) convert_stage_a(a, l, gw, NGW, (LAS float*)(lds + wave * 8448), lane);
            } else if (k == 1) {
                pg8::Gemm g{H, WB, 1}; pg8::Order So; So.init(MT, WIN, G, blockIdx.x, 1);
                EpiIn E{P, (bf16_t*)(a.ws + WS_VTA), (bf16_t*)(a.ws + WS_VTS)};
                #ifndef NO_EPIIN
                pg8::gemm_phase<EpiIn, D, D, D>(lds, g, So, E, wave);
#endif
            } else if (k == 2) {
                if ((PROBE_MASK >> 10) & 1) convert_stage_b(a, l, gw, NGW, (LAS float*)(lds + wave * 8448), lane);
                convert_stage_b(a, l, gw, NGW, (LAS float*)(lds + wave * 8448), lane);
                if ((PROBE_MASK >> 11) & 1) rope_k_phase(a, gw, NGW, lane, true);
                rope_k_phase(a, gw, NGW, lane, dry);
                if ((PROBE_MASK >> 12) & 1) for (int it = gw; it < NB * 66 * 8 * 2; it += NGW) lru_pass1_item(a, l, it, lane);
                if ((PROBE_MASK >> 13) & 1) for (int it = gw; it < NB * 128 * 8 * 4; it += NGW) na_item(a, l, it, lane, true);
                #ifndef NO_LRU
                for (int it = gw; it < NB * 66 * 8 * 2; it += NGW) lru_pass1_item(a, l, it, lane);
#endif
#ifndef NO_ATTN
                for (int it = gw; it < NB * 128 * 8 * 4; it += NGW) na_item(a, l, it, lane, dry);
                if (!lastl) for (int it = gw; it < NB * 8 * 16; it += NGW) ctx_item(a, l, it, false, lane, dry);
#endif
            } else if (k == 3) {
                if ((PROBE_MASK >> 14) & 1) for (int it = gw; it < NB * 66 * 8; it += NGW) lru_pass2_item(a, l, it, lane, true);
                if ((PROBE_MASK >> 15) & 1) for (int it = gw; it < NB * 8 * 512; it += NGW) swa_item(a, l, it, lane, true);
                #ifndef NO_LRU
                for (int it = gw; it < NB * 66 * 8; it += NGW) lru_pass2_item(a, l, it, lane, dry);
#endif
#ifndef NO_ATTN
                for (int it = gw; it < NB * 8 * 512; it += NGW) swa_item(a, l, it, lane, dry);
                if (!lastl) for (int it = gw; it < NB * 8 * 16; it += NGW) ctx_item(a, l, it, true, lane, dry);
#endif
            } else if (k == 4) {
                pg8::Gemm g{P, WB + WB_BR, 3}; pg8::Order So; So.init(Mrows, D, G, blockIdx.x, 3);
                EpiMerge E{P, H};
                #ifndef NO_EPIMERGE
                pg8::gemm_phase<EpiMerge, PW, 512, 512, C_QA, C_GB, C_QS, 524288>(lds, g, So, E, wave);
#endif
            } else if (k == 5) {
                pg8::Gemm g{H, WB + WB_OUT, 1}; pg8::Order So; So.init(Mrows, D, G, blockIdx.x, 1);
                EpiRes E{a.out, XC, modl, 2, dry};
#ifndef NO_EPIRES
                pg8::gemm_phase<EpiRes, D, D, D>(lds, g, So, E, wave);
#endif
            } else if (k == 8) {
                pg8::Gemm g{P, WB + WB_FF2, 1}; pg8::Order So; So.init(Mrows, D, G, blockIdx.x, 1);
                EpiRes E{a.out, XC, modl, 5, dry};
#ifndef NO_EPIRES
                pg8::gemm_phase<EpiRes, DFF, DFF, DFF>(lds, g, So, E, wave);
#endif
            } else if (k == 6) {
                norm_phase(a, l, true, Mrows, gw, NGW, lane);
            } else if (k == 7) {
                pg8::Gemm g{H, WB + WB_FF1, 1}; pg8::Order So; So.init(Mrows, DFF, G, blockIdx.x, 1);
                EpiFF1 E{P};
                #ifndef NO_EPIFF1
                pg8::gemm_phase<EpiFF1, D, D, D>(lds, g, So, E, wave);
#endif
            }
            }
        }
        if (ph + 1 < a.ph_hi) { if (ph == 0) { __syncthreads(); grid.sync(); } else xcd_barrier(xbar); if ((PROBE_MASK >> 9) & 1) xcd_barrier(xbar); }
    }
}

extern "C" void kernel_launch(void* const* d_in, const int* in_sizes, int n_in, void* d_out, int out_size, void* d_ws, size_t ws_size, hipStream_t stream) {
    static int grid = 0;
    if (grid == 0) {
        if (n_in != 23 || ws_size < WS_END) { fprintf(stderr, "kernel_launch: unexpected n_in %d or ws_size %zu (< %zu)\n", n_in, ws_size, (size_t)WS_END); grid = -1; return; }
        int dev = 0, cus = 0, per_cu = 0;
        hipGetDevice(&dev); hipDeviceGetAttribute(&cus, hipDeviceAttributeMultiprocessorCount, dev);
        if (hipFuncSetAttribute((const void*)fwd_kernel, hipFuncAttributeMaxDynamicSharedMemorySize, LDS_BYTES) != hipSuccess) { fprintf(stderr, "hipFuncSetAttribute failed\n"); grid = -1; return; }
        if (hipOccupancyMaxActiveBlocksPerMultiprocessor(&per_cu, (const void*)fwd_kernel, 512, LDS_BYTES) != hipSuccess || per_cu < 1) { fprintf(stderr, "occupancy query: %d\n", per_cu); per_cu = 1; }
        (void)hipGetLastError();
        grid = cus;
    }
    if (grid < 0) return;
    KArgs a{};
    const float** f = (const float**)&a;
    for (int i = 0; i < 23; ++i) f[i] = (const float*)d_in[i];
    a.out = (float*)d_out; a.ws = (unsigned char*)d_ws;
#if N_LAUNCHES == 1
    a.ph_lo = 0; a.ph_hi = 38;
    if (hipMemsetAsync((unsigned char*)d_ws + WS_BAR, 0, XCD_BAR_WORDS * 4, stream) != hipSuccess) { fprintf(stderr, "memset failed\n"); return; }
    void* args[] = {&a};
    hipError_t e = hipLaunchCooperativeKernel((const void*)fwd_kernel, dim3(grid), dim3(512), args, LDS_BYTES, stream);
    if (e != hipSuccess) fprintf(stderr, "cooperative launch failed: %s (grid %d)\n", hipGetErrorString(e), grid);
#else
    for (int ph = 0; ph < 38; ++ph) { a.ph_lo = ph; a.ph_hi = ph + 1; hipLaunchKernelGGL(fwd_kernel, dim3(grid), dim3(512), LDS_BYTES, stream, a); }
#endif
}
```

```cpp
#include <hip/hip_runtime.h>
#include <hip/hip_cooperative_groups.h>
#include <cstdio>
#include <cstdint>
namespace cg = cooperative_groups;

#ifndef N_LAUNCHES
#define N_LAUNCHES 1
#endif

#ifndef USE_XCD_BAR
#define USE_XCD_BAR 1
#endif
#ifndef PROBE_MASK
#define PROBE_MASK 0
#endif
#define LAS __attribute__((address_space(3)))
typedef unsigned short bf16_t;
typedef short bf16x8 __attribute__((ext_vector_type(8)));
typedef short s16x4 __attribute__((ext_vector_type(4)));
typedef float f32x4 __attribute__((ext_vector_type(4)));
typedef unsigned u32x4 __attribute__((ext_vector_type(4)));
typedef unsigned u32x2 __attribute__((ext_vector_type(2)));

constexpr int D = 1024, NB = 4, S = 8192, CTX = 256, ML = NB * S, MC = NB * CTX, MT = ML + MC, NL = 4, DFF = 4096;
constexpr int PW = 5760;
constexpr int C_QA = 0, C_KA = 512, C_XB = 1024, C_GB = 1536, C_QS = 2048, C_KS = 2560, C_GA = 2688, C_GR = 3712, C_GS = 4736;
constexpr int VTOK = 8448;
constexpr int WIN = 6400;
constexpr size_t MiB = 1u << 20;
constexpr size_t WS_XC = 0, WS_H = 4 * MiB, WS_P = 70 * MiB, WS_VTA = WS_P + (size_t)MT * PW * 2, WS_VTS = WS_VTA + (size_t)NB * 8 * 64 * VTOK * 2,
                 WS_WB = WS_VTS + (size_t)NB * 2 * 64 * VTOK * 2, WS_MOD = WS_WB + 21 * MiB, WS_SUM = WS_MOD + MiB / 2, WS_LW = WS_SUM + 5 * MiB / 2, WS_BAR = WS_LW + MiB, WS_END = WS_BAR + 16384;
constexpr int WB_BR = 0, WB_OUT = 3 * 524288, WB_FF1 = WB_OUT + 1048576, WB_FF2 = WB_FF1 + 4194304;
constexpr int LDS_BYTES = 131072 + 64;
constexpr float LOG2E = 1.4426950408889634f;
constexpr float NEGBIG = -3.0e38f;

struct KArgs {
    const float *x, *c, *ctx, *c_ctx, *w_mod, *b_mod, *norm1_g, *norm2_g, *w_in, *na_rpb, *conv_w, *conv_b, *lru_wa, *lru_ba, *lru_wx, *lru_bx, *lru_lambda,
        *swa_sink, *w_branch, *w_out, *w_ff1, *w_ff2, *final_g;
    float* out; unsigned char* ws; int ph_lo, ph_hi;
};

typedef __bf16 bf16x2_t __attribute__((ext_vector_type(2)));
typedef float f32x2_t __attribute__((ext_vector_type(2)));
__device__ __forceinline__ unsigned pk2(float lo, float hi) { f32x2_t v = {lo, hi}; bf16x2_t r = __builtin_convertvector(v, bf16x2_t); return __builtin_bit_cast(unsigned, r); }
__device__ __forceinline__ float bf2f(unsigned short b) { return __uint_as_float(((unsigned)b) << 16); }
__device__ __forceinline__ float bflo(unsigned w) { return __uint_as_float(w << 16); }
__device__ __forceinline__ float bfhi(unsigned w) { return __uint_as_float(w & 0xffff0000u); }
__device__ __forceinline__ float fexp2(float x) { return __builtin_amdgcn_exp2f(x); }
__device__ __forceinline__ float frcp(float x) { return __builtin_amdgcn_rcpf(x); }
__device__ __forceinline__ int lane_id_asm() { int l; asm volatile("v_mbcnt_lo_u32_b32 %0, -1, 0\n\tv_mbcnt_hi_u32_b32 %0, -1, %0" : "=v"(l)); return l; }
__device__ __forceinline__ float wave_sum(float v) {
#pragma unroll
    for (int o = 1; o < 64; o <<= 1) v += __shfl_xor(v, o);
    return v;
}
#define MFMA16(a, b, c) __builtin_amdgcn_mfma_f32_16x16x32_bf16((a), (b), (c), 0, 0, 0)

namespace pg8 {
constexpr int BM = 256, BK = 64, HALF = 128, HTB = HALF * BK * 2, STAGE_BYTES = 8 * HTB, NXCD = 8, WGM = 8;
__host__ __device__ __forceinline__ int lds_byte(int r, int c) { const int st = (r >> 4) * 2 + (c >> 5), rr = r & 15, cc = c & 31, ob = rr * 64 + cc * 2; return st * 1024 + (ob ^ (((ob >> 9) & 1) << 5)); }
__host__ __device__ __forceinline__ void stage_rc(int b, int& R, int& C) { const int st = b / 1024, sb = b % 1024, swz = sb ^ (((sb >> 9) & 1) << 5); R = (st >> 1) * 16 + swz / 64; C = (st & 1) * 32 + (swz % 64) / 2; }
__host__ __device__ __forceinline__ int perm32(int rho) { const int n = rho >> 4, i = rho & 15; return 8 * (i >> 2) + 4 * n + (i & 3); }

struct Unit { int pm, pn, sub; };
struct Gemm { const bf16_t* A; const bf16_t* Bt; int nsub; };
struct Order {
    int nM, nN, nwg, G, c, nsub;
    __device__ void init(int M, int N, int G_, int c_, int nsub_) { nM = M / BM; nN = N / BM; nwg = nM * nN; G = G_; c = c_; nsub = nsub_; }
    __device__ bool next(int i, Unit& u) const {
        const int ti = i / nsub; u.sub = i - ti * nsub;
        const long L = (long)ti * G + c; if (L >= nwg) return false;
        int wgid = (int)L; { const int q = nwg / NXCD, r = nwg % NXCD, xcd = wgid % NXCD, off = wgid / NXCD; wgid = (xcd < r ? xcd * (q + 1) : r * (q + 1) + (xcd - r) * q) + off; }
        const int nig = WGM * nN, gid = wgid / nig, fm = gid * WGM, gsz = (nM - fm) < WGM ? (nM - fm) : WGM;
        u.pm = fm + ((wgid % nig) % gsz); u.pn = (wgid % nig) / gsz; return true;
    }
};

template <class Epi, int LDA, int LDB, int K, int A0 = 0, int A1 = 0, int A2 = 0, int BS = 0>
__device__ __forceinline__ void gemm_phase(LAS unsigned char* lds, const Gemm g, const Order& S, const Epi& E, int wid) {
    const int lane = lane_id_asm(), tid = wid * 64 + lane, wr = wid >> 2, wc = wid & 3, fr = lane & 15, fq = lane >> 4;
    constexpr int nt = K / BK;
    unsigned voffA[2], voffB[2];
#pragma unroll
    for (int i = 0; i < 2; ++i) { int R, C; stage_rc(tid * 16 + i * 8192, R, C); const int Rb = Epi::PERM ? ((R & ~31) + perm32(R & 31)) : R;
        voffA[i] = (unsigned)(R * LDA + C) * 2u; voffB[i] = (unsigned)(Rb * LDB + C) * 2u; }
    constexpr size_t kstep = (size_t)(BK * 2);
    constexpr size_t hstepA = (size_t)HALF * LDA * 2, hstepB = (size_t)HALF * LDB * 2;
    constexpr size_t tstepA = 2 * hstepA, tstepB = 2 * hstepB;
    const unsigned ldsw = (unsigned)wid * 1024u;
    const int aoff = lds_byte(wr * 64 + fr, fq * 8), boff = lds_byte(wc * 32 + fr, fq * 8);
#define PG8_SA(b, h) (((b) * 2 + (h)) * HTB)
#define PG8_SB(b, h) ((4 + (b) * 2 + (h)) * HTB)
#define PG8_STAGE(bufoff, gbase, voff) do { _Pragma("unroll") for (int _i = 0; _i < 2; ++_i) \
        __builtin_amdgcn_global_load_lds((const unsigned*)((const char*)(gbase) + (voff)[_i]), (LAS unsigned*)(lds + (bufoff) + ldsw + _i * 8192), 16, 0, 0); } while (0)
#define PG8_LDA(dst, b, h) do { _Pragma("unroll") for (int m = 0; m < 4; ++m) _Pragma("unroll") for (int k = 0; k < 2; ++k) dst[m][k] = *(const LAS bf16x8*)(lds + PG8_SA(b, h) + aoff + m * 2048 + k * 1024); } while (0)
#define PG8_LDB(dst, b, h) do { _Pragma("unroll") for (int n = 0; n < 2; ++n) _Pragma("unroll") for (int k = 0; k < 2; ++k) dst[n][k] = *(const LAS bf16x8*)(lds + PG8_SB(b, h) + boff + n * 2048 + k * 1024); } while (0)
#define PG8_MMA(ai, bj, At, Bt) do { __builtin_amdgcn_s_setprio(1); _Pragma("unroll") for (int m = 0; m < 4; ++m) _Pragma("unroll") for (int n = 0; n < 2; ++n) _Pragma("unroll") for (int k = 0; k < 2; ++k) \
        acc[ai][bj][m][n] = __builtin_amdgcn_mfma_f32_16x16x32_bf16(Bt[n][k], At[m][k], acc[ai][bj][m][n], 0, 0, 0); __builtin_amdgcn_s_setprio(0); } while (0)
#define PG8_WAIT_V(n) asm volatile("s_waitcnt vmcnt(" #n ")" ::: "memory")
#define PG8_WAIT_L(n) asm volatile("s_waitcnt lgkmcnt(" #n ")" ::: "memory")
#define PG8_BAR __builtin_amdgcn_s_barrier()
#define PG8_SCHED __builtin_amdgcn_sched_barrier(0)
    Unit cur, nxt; int ui = 0;
    if (!S.next(0, cur)) return;
    f32x4 acc[2][2][4][2];
#pragma unroll
    for (int a = 0; a < 2; ++a)
#pragma unroll
        for (int b = 0; b < 2; ++b)
#pragma unroll
            for (int m = 0; m < 4; ++m)
#pragma unroll
                for (int n = 0; n < 2; ++n) acc[a][b][m][n] = (f32x4){0.f, 0.f, 0.f, 0.f};
    bf16x8 At[4][2], B0[2][2], B1[2][2];
    const char* cA = (const char*)(g.A + (cur.sub == 0 ? A0 : (cur.sub == 1 ? A1 : A2))) + (size_t)cur.pm * tstepA; const char* cB = (const char*)(g.Bt + (cur.sub * BS)) + (size_t)cur.pn * tstepB;
    PG8_STAGE(PG8_SB(0, 0), cB, voffB); PG8_STAGE(PG8_SA(0, 0), cA, voffA); PG8_STAGE(PG8_SB(0, 1), cB + hstepB, voffB); PG8_STAGE(PG8_SA(0, 1), cA + hstepA, voffA);
    if (wr == 1) PG8_BAR;
    PG8_WAIT_V(4); PG8_BAR;
    PG8_STAGE(PG8_SB(1, 0), cB + kstep, voffB); PG8_STAGE(PG8_SA(1, 0), cA + kstep, voffA); PG8_STAGE(PG8_SB(1, 1), cB + hstepB + kstep, voffB);
    PG8_WAIT_V(6); PG8_BAR;
    for (;;) {
        const bool has_next = S.next(ui + 1, nxt);
        const char* nA = has_next ? (const char*)(g.A + (nxt.sub == 0 ? A0 : (nxt.sub == 1 ? A1 : A2))) + (size_t)nxt.pm * tstepA : cA; const char* nB = has_next ? (const char*)(g.Bt + (nxt.sub * BS)) + (size_t)nxt.pn * tstepB : cB;
        for (int t = 0; t < nt; t += 2) {
            const bool last = (t == nt - 2);
            const char* a1 = cA + (size_t)(t + 1) * kstep;
            const char* a2 = last ? nA : cA + (size_t)(t + 2) * kstep; const char* b2 = last ? nB : cB + (size_t)(t + 2) * kstep;
            const char* a3 = a2 + kstep; const char* b3 = b2 + kstep;
            PG8_LDB(B0, 0, 0); PG8_SCHED; PG8_LDA(At, 0, 0); PG8_STAGE(PG8_SA(1, 1), a1 + hstepA, voffA);
            PG8_WAIT_L(8); PG8_BAR; PG8_WAIT_L(0); PG8_MMA(0, 0, At, B0); PG8_BAR; PG8_SCHED;
            PG8_LDB(B1, 0, 1); PG8_STAGE(PG8_SB(0, 0), b2, voffB);
            PG8_BAR; PG8_WAIT_L(0); PG8_MMA(0, 1, At, B1); PG8_BAR;
            PG8_LDA(At, 0, 1); PG8_STAGE(PG8_SA(0, 0), a2, voffA);
            PG8_BAR; PG8_WAIT_L(0); PG8_MMA(1, 0, At, B0); PG8_BAR; PG8_SCHED;
            PG8_STAGE(PG8_SB(0, 1), b2 + hstepB, voffB);
            PG8_WAIT_V(6); PG8_BAR; PG8_MMA(1, 1, At, B1); PG8_BAR;
            PG8_LDB(B0, 1, 0); PG8_SCHED; PG8_LDA(At, 1, 0); PG8_STAGE(PG8_SA(0, 1), a2 + hstepA, voffA);
            PG8_WAIT_L(8); PG8_BAR; PG8_WAIT_L(0); PG8_MMA(0, 0, At, B0); PG8_BAR; PG8_SCHED;
            PG8_LDB(B1, 1, 1); PG8_STAGE(PG8_SB(1, 0), b3, voffB);
            PG8_BAR; PG8_WAIT_L(0); PG8_MMA(0, 1, At, B1); PG8_BAR;
            PG8_LDA(At, 1, 1); PG8_STAGE(PG8_SA(1, 0), a3, voffA);
            PG8_BAR; PG8_WAIT_L(0); PG8_MMA(1, 0, At, B0); PG8_BAR; PG8_SCHED;
            PG8_STAGE(PG8_SB(1, 1), b3 + hstepB, voffB);
            PG8_WAIT_V(6); PG8_BAR; PG8_MMA(1, 1, At, B1); PG8_BAR;
        }
        E(acc, cur, wr, wc, fr, fq);
        if (!has_next) break;
        if (!(Epi::KEEP && cur.sub + 1 < g.nsub)) {
#pragma unroll
            for (int a = 0; a < 2; ++a)
#pragma unroll
                for (int b = 0; b < 2; ++b)
#pragma unroll
                    for (int m = 0; m < 4; ++m)
#pragma unroll
                        for (int n = 0; n < 2; ++n) acc[a][b][m][n] = (f32x4){0.f, 0.f, 0.f, 0.f};
        }
        cur = nxt; cA = nA; cB = nB; ++ui;
    }
    PG8_WAIT_V(0);
    if (wr == 0) PG8_BAR;
    PG8_BAR;
#undef PG8_SA
#undef PG8_SB
#undef PG8_STAGE
#undef PG8_LDA
#undef PG8_LDB
#undef PG8_MMA
#undef PG8_WAIT_V
#undef PG8_WAIT_L
#undef PG8_BAR
#undef PG8_SCHED
}
}

typedef f32x4 AccT[2][2][4][2];
struct EpiIn {
    static constexpr bool PERM = true, KEEP = false;
    bf16_t* P; bf16_t* VTa; bf16_t* VTs;
    __device__ __forceinline__ void operator()(AccT& acc, const pg8::Unit& u, int wr, int wc, int fr, int fq) const {
        const int row0 = u.pm * 256 + wr * 64 + fr, trow = u.pm * 256;
        int b, tokbase; if (trow < ML) { b = trow >> 13; tokbase = trow & 8191; } else { b = (trow - ML) >> 8; tokbase = 8192; }
#pragma unroll
        for (int bj = 0; bj < 2; ++bj) {
            int pc = -1;
            if (u.pn < 10) pc = 256 * u.pn + 128 * bj; else if (u.pn == 10) { if (bj == 0) pc = 2560; } else if (u.pn >= 13) pc = 2688 + 256 * (u.pn - 13) + 128 * bj;
            if (pc >= 0) {
#pragma unroll
                for (int ai = 0; ai < 2; ++ai)
#pragma unroll
                    for (int m = 0; m < 4; ++m) { bf16_t* rowp = P + (size_t)(row0 + ai * 128 + m * 16) * PW + pc + wc * 32 + 8 * fq;
                        const f32x4 v0 = acc[ai][bj][m][0], v1 = acc[ai][bj][m][1];
                        u32x4 w; w.x = pk2(v0[0], v0[1]); w.y = pk2(v0[2], v0[3]); w.z = pk2(v1[0], v1[1]); w.w = pk2(v1[2], v1[3]);
                        *(u32x4*)rowp = w; }
            } else {
                const bool isS = (u.pn == 10); bf16_t* VT = isS ? VTs : VTa; const int nh = isS ? 2 : 8;
                const int cl = (isS ? 0 : 256 * (u.pn - 11) + 128 * bj) + 32 * wc + 8 * fq;
#pragma unroll
                for (int ai = 0; ai < 2; ++ai)
#pragma unroll
                    for (int m = 0; m < 4; ++m) { const int tok = tokbase + wr * 64 + fr + ai * 128 + m * 16;
#pragma unroll
                        for (int n = 0; n < 2; ++n) { const f32x4 v = acc[ai][bj][m][n]; const unsigned w0 = pk2(v[0], v[1]), w1 = pk2(v[2], v[3]);
                            const int c = cl + 4 * n; bf16_t* base = VT + ((size_t)(b * nh + (c >> 6)) * 64 + (c & 63)) * VTOK + tok;
                            base[0] = (bf16_t)(w0 & 0xffff); base[VTOK] = (bf16_t)(w0 >> 16); base[2 * VTOK] = (bf16_t)(w1 & 0xffff); base[3 * VTOK] = (bf16_t)(w1 >> 16); } }
            }
        }
    }
};
struct EpiMerge {
    static constexpr bool PERM = true, KEEP = true;
    const bf16_t* P; bf16_t* Mo;
    __device__ __forceinline__ void operator()(AccT& acc, const pg8::Unit& u, int wr, int wc, int fr, int fq) const {
        const int row0 = u.pm * 256 + wr * 64 + fr, col0 = u.pn * 256 + wc * 32 + 8 * fq;
        const int gc = (u.sub == 0) ? C_GA : (u.sub == 1 ? C_GR : C_GS), gn = (u.sub == 0) ? C_GR : C_GS;
        const bool lastsub = (u.sub == 2);
#pragma unroll
        for (int ai = 0; ai < 2; ++ai)
#pragma unroll
            for (int m = 0; m < 4; ++m) { const size_t row = (size_t)(row0 + ai * 128 + m * 16);
#pragma unroll
                for (int bj = 0; bj < 2; ++bj) { const int col = col0 + bj * 128;
                    const u32x4 wcur = *(const u32x4*)(P + row * PW + gc + col);
                    u32x4 wnx = wcur; if (!lastsub) wnx = *(const u32x4*)(P + row * PW + gn + col);
                    float f[8];
#pragma unroll
                    for (int q = 0; q < 4; ++q) {
                        const float c0 = bflo(wcur[q]), c1 = bfhi(wcur[q]), n0 = bflo(wnx[q]), n1 = bfhi(wnx[q]);
                        const float d0 = 1.f + fexp2(fminf(-c0 * LOG2E, 100.f)), d1 = 1.f + fexp2(fminf(-c1 * LOG2E, 100.f));
                        const float u0 = lastsub ? 1.f : 1.f + fexp2(fminf(-n0 * LOG2E, 100.f)), u1 = lastsub ? 1.f : 1.f + fexp2(fminf(-n1 * LOG2E, 100.f));
                        f[2 * q] = u0 * frcp(d0); f[2 * q + 1] = u1 * frcp(d1);
                    }
                    f32x4 v0 = acc[ai][bj][m][0], v1 = acc[ai][bj][m][1];
                    v0[0] *= f[0]; v0[1] *= f[1]; v0[2] *= f[2]; v0[3] *= f[3]; v1[0] *= f[4]; v1[1] *= f[5]; v1[2] *= f[6]; v1[3] *= f[7];
                    acc[ai][bj][m][0] = v0; acc[ai][bj][m][1] = v1;
                    if (lastsub) { u32x4 w; w.x = pk2(v0[0], v0[1]); w.y = pk2(v0[2], v0[3]); w.z = pk2(v1[0], v1[1]); w.w = pk2(v1[2], v1[3]);
                        *(u32x4*)(Mo + row * D + col) = w; }
                } }
    }
};
struct EpiRes {
    static constexpr bool PERM = false, KEEP = false;
    float* XL; float* XCp; const float* modl; int gidx; bool dry;
    __device__ __forceinline__ void operator()(AccT& acc, const pg8::Unit& u, int wr, int wc, int fr, int fq) const {
        const int trow = u.pm * 256, row0 = trow + wr * 64 + fr, col0 = u.pn * 256 + wc * 32 + 4 * fq;
        const int v = trow < ML ? (trow >> 13) : 4;
        float* Xb = trow < ML ? XL + (size_t)row0 * D : XCp + (size_t)(row0 - ML) * D;
        f32x4 gv[2][2];
#pragma unroll
        for (int bj = 0; bj < 2; ++bj)
#pragma unroll
            for (int n = 0; n < 2; ++n) gv[bj][n] = *(const f32x4*)(modl + v * 6144 + gidx * 1024 + col0 + bj * 128 + n * 16);
#pragma unroll
        for (int ai = 0; ai < 2; ++ai)
#pragma unroll
            for (int m = 0; m < 4; ++m) { float* rowp = Xb + (size_t)(ai * 128 + m * 16) * D + col0;
#pragma unroll
                for (int bj = 0; bj < 2; ++bj)
#pragma unroll
                    for (int n = 0; n < 2; ++n) { f32x4* p = (f32x4*)(rowp + bj * 128 + n * 16); f32x4 xv = *p; xv += gv[bj][n] * acc[ai][bj][m][n]; if (!dry) *p = xv; } }
    }
};
struct EpiFF1 {
    static constexpr bool PERM = true, KEEP = false;
    bf16_t* Hd;
    __device__ __forceinline__ void operator()(AccT& acc, const pg8::Unit& u, int wr, int wc, int fr, int fq) const {
        const int row0 = u.pm * 256 + wr * 64 + fr, col0 = u.pn * 256 + wc * 32 + 8 * fq;
#pragma unroll
        for (int ai = 0; ai < 2; ++ai)
#pragma unroll
            for (int m = 0; m < 4; ++m) { bf16_t* rowp = Hd + (size_t)(row0 + ai * 128 + m * 16) * DFF + col0;
#pragma unroll
                for (int bj = 0; bj < 2; ++bj) { f32x4 v0 = acc[ai][bj][m][0], v1 = acc[ai][bj][m][1];
#pragma unroll
                    for (int j = 0; j < 4; ++j) { const float a = fmaxf(v0[j], 0.f), b = fmaxf(v1[j], 0.f); v0[j] = a * a; v1[j] = b * b; }
                    u32x4 w; w.x = pk2(v0[0], v0[1]); w.y = pk2(v0[2], v0[3]); w.z = pk2(v1[0], v1[1]); w.w = pk2(v1[2], v1[3]);
                    *(u32x4*)(rowp + bj * 128) = w; } }
    }
};

__device__ __forceinline__ void transpose_item(const float* W, int ldn, int k0, int nsrc0, bf16_t* WT, int ldt, int ndst0, LAS float* scr, int lane) {
#pragma unroll 8
    for (int i = 0; i < 32; ++i) { const int kk = 2 * i + (lane >> 5); scr[kk * 33 + (lane & 31)] = W[(size_t)(k0 + kk) * ldn + nsrc0 + (lane & 31)]; }
    asm volatile("s_waitcnt lgkmcnt(0)" ::: "memory");
    const int c = lane & 7;
#pragma unroll
    for (int j = 0; j < 4; ++j) { const int n = (lane >> 3) + 8 * j; const LAS float* s = scr + (8 * c) * 33 + n;
        u32x4 o; o.x = pk2(s[0 * 33], s[1 * 33]); o.y = pk2(s[2 * 33], s[3 * 33]); o.z = pk2(s[4 * 33], s[5 * 33]); o.w = pk2(s[6 * 33], s[7 * 33]);
        *(u32x4*)(WT + (size_t)(ndst0 + n) * ldt + k0 + 8 * c) = o; }
    asm volatile("s_waitcnt lgkmcnt(0)" ::: "memory");
}
__device__ __forceinline__ void conv_seg(int& base, int gw, int NGW, const float* W, int K, int ldn, int nsrc0, int ncols, bf16_t* WT, int ldt, int ndst0, LAS float* scr, int lane) {
    const int nblk = ncols / 32, nitems = (K / 64) * nblk;
    int first = base + (((gw - base) % NGW) + NGW) % NGW;
    for (int it = first; it < base + nitems; it += NGW) { const int r = it - base, kb = r / nblk, nb = r - kb * nblk;
        transpose_item(W, ldn, 64 * kb, nsrc0 + 32 * nb, WT, ldt, ndst0 + 32 * nb, scr, lane); }
    base += nitems;
}
__device__ __forceinline__ void convert_stage_a(const KArgs& a, int l, int gw, int NGW, LAS float* scr, int) {
    const int lane = lane_id_asm();
    const float* W = a.w_in + (size_t)l * D * WIN; bf16_t* WT = (bf16_t*)(a.ws + WS_WB); int base = 0;
    conv_seg(base, gw, NGW, W, D, WIN, 0, 1024, WT, D, 0, scr, lane);
    conv_seg(base, gw, NGW, W, D, WIN, 1536, 1024, WT, D, 1024, scr, lane);
    conv_seg(base, gw, NGW, W, D, WIN, 2560, 512, WT, D, 2048, scr, lane);
    conv_seg(base, gw, NGW, W, D, WIN, 3072, 256, WT, D, 2560, scr, lane);
    conv_seg(base, gw, NGW, W, D, WIN, 1024, 512, WT, D, 2816, scr, lane);
    conv_seg(base, gw, NGW, W, D, WIN, 3328, 3072, WT, D, 3328, scr, lane);
}
__device__ __forceinline__ void convert_stage_b(const KArgs& a, int l, int gw, int NGW, LAS float* scr, int) {
    const int lane = lane_id_asm();
    bf16_t* WB = (bf16_t*)(a.ws + WS_WB); int base = 0;
    const float* wbr = a.w_branch + (size_t)l * 1536 * D;
    for (int i = 0; i < 3; ++i) conv_seg(base, gw, NGW, wbr + (size_t)i * 512 * D, 512, D, 0, D, WB + WB_BR + i * 524288, 512, 0, scr, lane);
    conv_seg(base, gw, NGW, a.w_out + (size_t)l * D * D, D, D, 0, D, WB + WB_OUT, D, 0, scr, lane);
    conv_seg(base, gw, NGW, a.w_ff1 + (size_t)l * D * DFF, D, DFF, 0, DFF, WB + WB_FF1, D, 0, scr, lane);
    conv_seg(base, gw, NGW, a.w_ff2 + (size_t)l * DFF * D, DFF, D, 0, D, WB + WB_FF2, DFF, 0, scr, lane);
}

__device__ __forceinline__ void phase0(const KArgs& a, LAS unsigned char* lds, int gw, int NGW, int wave, int lane) {
    LAS float* cond = (LAS float*)lds;
    LAS float* red = (LAS float*)(lds + 20480);
    const int tid = wave * 64 + lane;
    for (int i = tid; i < 5 * D; i += 512) { const int v = i >> 10, k = i & 1023; const float cv = v < 4 ? a.c[v * D + k] : a.c_ctx[k]; cond[i] = cv / (1.f + __expf(-cv)); }
    __syncthreads();
    float* mods = (float*)(a.ws + WS_MOD);
    const int col = tid & 127, kq = tid >> 7;
    for (int task = blockIdx.x; task < NL * 48; task += gridDim.x) {
        const int l = task / 48, cc = (task % 48) * 128 + col;
        const float* W = a.w_mod + (size_t)l * D * 6144 + cc;
        float s0 = 0.f, s1 = 0.f, s2 = 0.f, s3 = 0.f, s4 = 0.f;
#pragma unroll 8
        for (int k = kq * 256; k < kq * 256 + 256; ++k) { const float w = W[(size_t)k * 6144];
            s0 += w * cond[k]; s1 += w * cond[1024 + k]; s2 += w * cond[2048 + k]; s3 += w * cond[3072 + k]; s4 += w * cond[4096 + k]; }
        red[(kq * 5 + 0) * 128 + col] = s0; red[(kq * 5 + 1) * 128 + col] = s1; red[(kq * 5 + 2) * 128 + col] = s2; red[(kq * 5 + 3) * 128 + col] = s3; red[(kq * 5 + 4) * 128 + col] = s4;
        __syncthreads();
        for (int o = tid; o < 5 * 128; o += 512) { const int v = o >> 7, c2 = o & 127, ccol = (task % 48) * 128 + c2;
            const float r = red[(0 * 5 + v) * 128 + c2] + red[(1 * 5 + v) * 128 + c2] + red[(2 * 5 + v) * 128 + c2] + red[(3 * 5 + v) * 128 + c2];
            mods[((size_t)l * 5 + v) * 6144 + ccol] = r + a.b_mod[l * 6144 + ccol]; }
        __syncthreads();
    }
    __syncthreads();
    LAS float* scr = (LAS float*)(lds + 32768 + wave * 8448);
    bf16_t* LW = (bf16_t*)(a.ws + WS_LW);
    for (int it = gw; it < NL * 2 * 2 * 8 * 2; it += NGW) { const int half = it & 1, mi = it >> 1, n = mi & 7, mat = (mi >> 3) & 1, ld = mi >> 4;
        const float* W = (mat ? a.lru_wx : a.lru_wa) + ((size_t)ld * 8 + n) * 4096;
        transpose_item(W, 64, 0, 32 * half, LW + ((size_t)(ld * 2 + mat) * 8 + n) * 4096, 64, 32 * half, scr, lane); }
    convert_stage_a(a, 0, gw, NGW, scr, lane);
}

__device__ __forceinline__ void norm_phase(const KArgs& a, int l, bool second, int nrows, int gw, int NGW, int lane) {
    const bool first_read = (l == 0 && !second);
    const float* srcL = first_read ? a.x : a.out; const float* srcC = first_read ? a.ctx : (const float*)(a.ws + WS_XC);
    float* XC = (float*)(a.ws + WS_XC); bf16_t* H = (bf16_t*)(a.ws + WS_H);
    const float* g = (second ? a.norm2_g : a.norm1_g) + l * D; const float* modl = (const float*)(a.ws + WS_MOD) + (size_t)l * 5 * 6144; const int sidx = second ? 3 : 0;
    for (int row = gw; row < nrows; row += NGW) {
        const float* src = row < ML ? srcL + (size_t)row * D : srcC + (size_t)(row - ML) * D; const int v = row < ML ? (row >> 13) : 4;
        const f32x4* xr = (const f32x4*)src + lane; f32x4 xv[4]; float s = 0.f;
#pragma unroll
        for (int j = 0; j < 4; ++j) { xv[j] = xr[64 * j]; s += (xv[j][0] * xv[j][0] + xv[j][1] * xv[j][1]) + (xv[j][2] * xv[j][2] + xv[j][3] * xv[j][3]); }
        const float rstd = 1.0f / sqrtf(wave_sum(s) * (1.f / D) + 1e-6f);
        if (first_read) { f32x4* cp = (f32x4*)(row < ML ? a.out + (size_t)row * D : XC + (size_t)(row - ML) * D) + lane;
#pragma unroll
            for (int j = 0; j < 4; ++j) cp[64 * j] = xv[j]; }
        u32x2* o8 = (u32x2*)(H + (size_t)row * D) + lane;
#pragma unroll
        for (int j = 0; j < 4; ++j) { const int c = 4 * lane + 256 * j; const f32x4 gg = *(const f32x4*)(g + c), sh = *(const f32x4*)(modl + v * 6144 + sidx * 1024 + c), sc = *(const f32x4*)(modl + v * 6144 + (sidx + 1) * 1024 + c);
            f32x4 h = xv[j] * rstd * gg * (sc + 1.0f) + sh; u32x2 w; w.x = pk2(h[0], h[1]); w.y = pk2(h[2], h[3]); o8[64 * j] = w; }
    }
}
__device__ __forceinline__ void final_norm(const KArgs& a, int gw, int NGW, int lane) {
    for (int row = gw; row < ML; row += NGW) {
        f32x4* xr = (f32x4*)(a.out + (size_t)row * D) + lane; f32x4 xv[4]; float s = 0.f;
#pragma unroll
        for (int j = 0; j < 4; ++j) { xv[j] = xr[64 * j]; s += (xv[j][0] * xv[j][0] + xv[j][1] * xv[j][1]) + (xv[j][2] * xv[j][2] + xv[j][3] * xv[j][3]); }
        const float rstd = 1.0f / sqrtf(wave_sum(s) * (1.f / D) + 1e-6f);
#pragma unroll
        for (int j = 0; j < 4; ++j) { const f32x4 gg = *(const f32x4*)(a.final_g + 4 * lane + 256 * j); xr[64 * j] = xv[j] * rstd * gg; }
    }
}

struct AttnSt { f32x4 o[4]; float m, l; };
struct KVF { bf16x8 k[4]; bf16x8 v[4]; };
__device__ __forceinline__ void kv_load(KVF& f, const bf16_t* k0p, const bf16_t* k1p, const bf16_t* vp) {
    f.k[0] = *(const bf16x8*)k0p; f.k[1] = *(const bf16x8*)(k0p + 32); f.k[2] = *(const bf16x8*)k1p; f.k[3] = *(const bf16x8*)(k1p + 32);
#pragma unroll
    for (int dt = 0; dt < 4; ++dt) f.v[dt] = *(const bf16x8*)(vp + (size_t)dt * 16 * VTOK);
}
template <class BiasF>
__device__ __forceinline__ void attn_compute(AttnSt& st, const KVF& f, const bf16x8 (&qf)[2], BiasF bias) {
    f32x4 s0 = {0.f, 0.f, 0.f, 0.f}, s1 = {0.f, 0.f, 0.f, 0.f};
    s0 = MFMA16(f.k[0], qf[0], s0); s0 = MFMA16(f.k[1], qf[1], s0); s1 = MFMA16(f.k[2], qf[0], s1); s1 = MFMA16(f.k[3], qf[1], s1);
    float t[8]; const float SC = 0.125f * LOG2E;
#pragma unroll
    for (int j = 0; j < 4; ++j) { t[j] = bias(j, s0[j] * SC); t[4 + j] = bias(4 + j, s1[j] * SC); }
    float bm = fmaxf(fmaxf(fmaxf(t[0], t[1]), fmaxf(t[2], t[3])), fmaxf(fmaxf(t[4], t[5]), fmaxf(t[6], t[7])));
    bm = fmaxf(bm, __shfl_xor(bm, 16)); bm = fmaxf(bm, __shfl_xor(bm, 32));
    const float mn = fmaxf(st.m, bm), alpha = fexp2(st.m - mn); st.m = mn;
    float ls = 0.f;
#pragma unroll
    for (int j = 0; j < 8; ++j) { t[j] = fexp2(t[j] - mn); ls += t[j]; }
    st.l = st.l * alpha + ls;
    u32x4 pw; pw.x = pk2(t[0], t[1]); pw.y = pk2(t[2], t[3]); pw.z = pk2(t[4], t[5]); pw.w = pk2(t[6], t[7]);
    const bf16x8 pf = __builtin_bit_cast(bf16x8, pw);
#pragma unroll
    for (int dt = 0; dt < 4; ++dt) { st.o[dt] *= alpha; st.o[dt] = MFMA16(f.v[dt], pf, st.o[dt]); }
}
__device__ __forceinline__ void attn_init(AttnSt& st) {
#pragma unroll
    for (int dt = 0; dt < 4; ++dt) st.o[dt] = (f32x4){0.f, 0.f, 0.f, 0.f};
    st.m = -1.0e30f; st.l = 0.f;
}
__device__ __forceinline__ void attn_store(const AttnSt& st, float lextra, bf16_t* orow, int lane, bool dry) {
    float l = st.l; l += __shfl_xor(l, 16); l += __shfl_xor(l, 32); l += lextra;
    const float inv = 1.0f / l; const int g = lane >> 4;
#pragma unroll
    for (int dt = 0; dt < 4; ++dt) { const f32x4 o = st.o[dt] * inv; u32x2 w; w.x = pk2(o[0], o[1]); w.y = pk2(o[2], o[3]); if (!dry) *(u32x2*)(orow + 16 * dt + 4 * g) = w; }
}
__device__ __forceinline__ void na_item(const KArgs& a, int l, int item, int lane, bool dry) {
    bf16_t* P = (bf16_t*)(a.ws + WS_P); const bf16_t* VT = (const bf16_t*)(a.ws + WS_VTA);
    const int i = item & 3, h = (item >> 2) & 7, r = (item >> 5) & 127, b = item >> 12;
    const int c16 = lane & 15, g = lane >> 4, kk0 = 8 * (c16 >> 2) + (c16 & 3);
    const int cq = 16 * i + c16; const size_t qrow = (size_t)b * S + r * 64 + cq;
    bf16x8 qf[2]; qf[0] = *(const bf16x8*)(P + qrow * PW + C_QA + h * 64 + 8 * g); qf[1] = *(const bf16x8*)(P + qrow * PW + C_QA + h * 64 + 32 + 8 * g);
    const int c0 = (i == 0) ? 0 : (i == 1 ? 8 : (i == 2 ? 24 : 32));
    const int rs = min(max(r - 4, 0), 120), cs = min(max(cq - 8, 0), 48);
    unsigned okm = 0; int idx0 = c0 + 8 * g - cq + 15;
#pragma unroll
    for (int e = 0; e < 8; ++e) { const int kc = c0 + 8 * g + e; okm |= ((kc >= cs) && (kc < cs + 16)) ? (1u << e) : 0u; }
    const float* rpb = a.na_rpb + ((size_t)l * 8 + h) * 15 * 31;
    const bf16_t* kcol = P + C_KA + h * 64 + 8 * g; const bf16_t* vrow = VT + (size_t)((b * 8 + h) * 64 + c16) * VTOK + 8 * g;
    AttnSt st; attn_init(st);
    KVF cur, nxt; float bc[8], bn[8];
#pragma unroll
    for (int e = 0; e < 8; ++e) { bc[e] = 0.f; bn[e] = 0.f; }
    auto loadblk = [&](int blk, KVF& f, float (&bb)[8]) {
        if (blk < 8) { const int R = rs + blk; const size_t tok0 = (size_t)R * 64 + c0; const bf16_t* kp = kcol + ((size_t)b * S + tok0 + kk0) * PW;
            kv_load(f, kp, kp + (size_t)4 * PW, vrow + tok0);
            const float* rp = rpb + (R - r + 7) * 31;
#pragma unroll
            for (int e = 0; e < 8; ++e) bb[e] = rp[min(max(idx0 + e, 0), 30)];
        } else { const int cb = blk - 8; const bf16_t* kp = kcol + ((size_t)ML + b * CTX + 32 * cb + kk0) * PW; kv_load(f, kp, kp + (size_t)4 * PW, vrow + 8192 + 32 * cb); }
    };
    loadblk(0, cur, bc);
    for (int blk = 0; blk < 16; ++blk) {
        loadblk(blk < 15 ? blk + 1 : 15, nxt, bn);
        if (blk < 8) attn_compute(st, cur, qf, [&](int e, float s) { return ((okm >> e) & 1u) ? s + bc[e] * LOG2E : NEGBIG; });
        else attn_compute(st, cur, qf, [](int, float s) { return s; });
        cur = nxt;
#pragma unroll
        for (int e = 0; e < 8; ++e) bc[e] = bn[e];
    }
    attn_store(st, 0.f, P + qrow * PW + C_QA + h * 64, lane, dry);
}
__device__ __forceinline__ void ctx_item(const KArgs& a, int l, int item, bool swa, int lane, bool dry) {
    bf16_t* P = (bf16_t*)(a.ws + WS_P);
    const int i = item & 15, h = (item >> 4) & 7, b = item >> 7;
    const int c16 = lane & 15, g = lane >> 4, kk0 = 8 * (c16 >> 2) + (c16 & 3);
    const size_t qrow = (size_t)ML + b * CTX + 16 * i + c16; const int qc = (swa ? C_QS : C_QA) + h * 64;
    bf16x8 qf[2]; qf[0] = *(const bf16x8*)(P + qrow * PW + qc + 8 * g); qf[1] = *(const bf16x8*)(P + qrow * PW + qc + 32 + 8 * g);
    const bf16_t* kcol = P + (swa ? C_KS + (h >> 2) * 64 : C_KA + h * 64) + 8 * g;
    const bf16_t* vrow = (swa ? (const bf16_t*)(a.ws + WS_VTS) + (size_t)((b * 2 + (h >> 2)) * 64 + c16) * VTOK : (const bf16_t*)(a.ws + WS_VTA) + (size_t)((b * 8 + h) * 64 + c16) * VTOK) + 8 * g;
    AttnSt st; attn_init(st);
    for (int cb = 0; cb < 8; ++cb) { KVF f; const bf16_t* kp = kcol + ((size_t)ML + b * CTX + 32 * cb + kk0) * PW; kv_load(f, kp, kp + (size_t)4 * PW, vrow + 8192 + 32 * cb);
        attn_compute(st, f, qf, [](int, float s) { return s; }); }
    const float lex = swa ? fexp2(a.swa_sink[l * 8 + h] * LOG2E - st.m) : 0.f;
    attn_store(st, lex, P + qrow * PW + qc, lane, dry);
}
__device__ __forceinline__ float inv_freq(int f) { return exp2f(-(float)f * (13.287712379549449f / 16.0f)); }
__device__ __forceinline__ void rope_cs(int pos, int f, float& c, float& s) {
    const float ang = (float)pos * inv_freq(f); float rev = ang * 0.15915494309189535f; rev -= rintf(rev);
    c = __builtin_amdgcn_cosf(rev); s = __builtin_amdgcn_sinf(rev);
}
__device__ __forceinline__ void rope_q(bf16x8 (&qf)[2], int tq, int g) {
    const int pos = (g < 2) ? (tq >> 6) : (tq & 63);
    u32x4 w0 = __builtin_bit_cast(u32x4, qf[0]), w1 = __builtin_bit_cast(u32x4, qf[1]);
#pragma unroll
    for (int q = 0; q < 4; ++q) {
        float c0, s0, c1, s1; rope_cs(pos, 8 * (g & 1) + 2 * q, c0, s0); rope_cs(pos, 8 * (g & 1) + 2 * q + 1, c1, s1);
        const float a0 = bflo(w0[q]), a1 = bfhi(w0[q]), b0 = bflo(w1[q]), b1 = bfhi(w1[q]);
        w0[q] = pk2(a0 * c0 - b0 * s0, a1 * c1 - b1 * s1); w1[q] = pk2(b0 * c0 + a0 * s0, b1 * c1 + a1 * s1);
    }
    qf[0] = __builtin_bit_cast(bf16x8, w0); qf[1] = __builtin_bit_cast(bf16x8, w1);
}
__device__ __forceinline__ void swa_item(const KArgs& a, int l, int item, int, bool dry) {
    const int lane = lane_id_asm();
    bf16_t* P = (bf16_t*)(a.ws + WS_P); const bf16_t* VT = (const bf16_t*)(a.ws + WS_VTS);
    const int qt = item & 511, hp = (item >> 9) & 1, kvh = (item >> 10) & 1, b = item >> 11, h0 = 4 * kvh + 2 * hp;
    const int c16 = lane & 15, g = lane >> 4, kk0 = 8 * (c16 >> 2) + (c16 & 3);
    const int tq = 16 * qt + c16; const size_t qrow = (size_t)b * S + tq;
    bf16x8 qa[2], qb[2];
    qa[0] = *(const bf16x8*)(P + qrow * PW + C_QS + h0 * 64 + 8 * g); qa[1] = *(const bf16x8*)(P + qrow * PW + C_QS + h0 * 64 + 32 + 8 * g);
    qb[0] = *(const bf16x8*)(P + qrow * PW + C_QS + h0 * 64 + 64 + 8 * g); qb[1] = *(const bf16x8*)(P + qrow * PW + C_QS + h0 * 64 + 96 + 8 * g);
    rope_q(qa, tq, g); rope_q(qb, tq, g);
    const bf16_t* kcol = P + C_KS + kvh * 64 + 8 * g; const bf16_t* vrow = VT + (size_t)((b * 2 + kvh) * 64 + c16) * VTOK + 8 * g;
    AttnSt sa, sb; attn_init(sa); attn_init(sb);
    const int kstart = 16 * qt - 128;
    int bfirst = 0, blast = 8; while (kstart + 32 * bfirst + 31 < 0) ++bfirst; while (kstart + 32 * blast >= S) --blast;
    const int nblk = (blast - bfirst + 1) + 8;
    KVF cur, nxt;
    auto loadblk = [&](int q, KVF& f) {
        const int lb = bfirst + q;
        if (lb <= blast) { const int k0 = kstart + 32 * lb; const int ka = min(max(k0 + kk0, 0), S - 1), kb = min(max(k0 + kk0 + 4, 0), S - 1), vt = min(max(k0 + 8 * g, 0), S - 8);
            kv_load(f, kcol + ((size_t)b * S + ka) * PW, kcol + ((size_t)b * S + kb) * PW, VT + (size_t)((b * 2 + kvh) * 64 + c16) * VTOK + vt);
        } else { const int cb = lb - blast - 1; const bf16_t* kp = kcol + ((size_t)ML + b * CTX + 32 * cb + kk0) * PW; kv_load(f, kp, kp + (size_t)4 * PW, vrow + 8192 + 32 * cb); }
    };
    loadblk(0, cur);
    for (int q = 0; q < nblk; ++q) {
        loadblk(q + 1 < nblk ? q + 1 : q, nxt);
        const int lb = bfirst + q;
        if (lb <= blast) { const int kbase = kstart + 32 * lb + 8 * g;
            auto msk = [&](int e, float s) { const int k = kbase + e, dlt = k - tq; return ((k >= 0) && (k < S) && (dlt <= 128) && (dlt >= -128)) ? s : NEGBIG; };
            attn_compute(sa, cur, qa, msk); attn_compute(sb, cur, qb, msk);
        } else { attn_compute(sa, cur, qa, [](int, float s) { return s; }); attn_compute(sb, cur, qb, [](int, float s) { return s; }); }
        cur = nxt;
    }
    attn_store(sa, fexp2(a.swa_sink[l * 8 + h0] * LOG2E - sa.m), P + qrow * PW + C_QS + h0 * 64, lane, dry);
    attn_store(sb, fexp2(a.swa_sink[l * 8 + h0 + 1] * LOG2E - sb.m), P + qrow * PW + C_QS + h0 * 64 + 64, lane, dry);
}
__device__ __forceinline__ void rope_k_phase(const KArgs& a, int gw, int NGW, int lane, bool dry) {
    bf16_t* P = (bf16_t*)(a.ws + WS_P);
    const int hd = lane >> 5, i = lane & 31;
    for (int row = gw; row < ML; row += NGW) {
        const int t = row & (S - 1); const int pos = (i < 16) ? (t >> 6) : (t & 63);
        float c, s; rope_cs(pos, i & 15, c, s);
        bf16_t* p = P + (size_t)row * PW + C_KS + hd * 64;
        const float t1 = bf2f(p[i]), t2 = bf2f(p[i + 32]);
        const unsigned w = pk2(t1 * c - t2 * s, t2 * c + t1 * s);
        if (!dry) { p[i] = (bf16_t)(w & 0xffff); p[i + 32] = (bf16_t)(w >> 16); }
    }
}

__device__ __forceinline__ float neg_expm1(float x) {
    const float ser = -x * (1.f + x * (0.5f + x * (0.16666667f + x * (0.041666668f + x * (0.0083333338f + x * 0.0013888889f)))));
    return x > -0.25f ? ser : 1.f - __expf(x);
}
template <int DIR, bool WRITE>
__device__ __forceinline__ void lru_sweep(const KArgs& a, int l, int b, int n, int sp, float (&carry)[4], float (&arun)[4], int lane, bool dry = false) {
    bf16_t* P = (bf16_t*)(a.ws + WS_P); float* HT = (float*)(a.ws + WS_H); const bf16_t* LW = (const bf16_t*)(a.ws + WS_LW);
    const int c16 = lane & 15, g = lane >> 4; const int gg = DIR ? 3 - g : g;
    const bool lat = sp < 64; const int rowbase = lat ? b * S : ML + b * CTX, seglen = lat ? S : CTX, t0 = (lat ? sp : sp - 64) * 128;
    float ba[4], bx[4], spc[4];
#pragma unroll
    for (int nt = 0; nt < 4; ++nt) { const int ch = n * 64 + 16 * nt + c16, o = (l * 2 + DIR) * 512 + ch;
        ba[nt] = a.lru_ba[o]; bx[nt] = a.lru_bx[o]; const float lam = a.lru_lambda[o]; spc[nt] = (lam < -15.f) ? -lam : log1pf(__expf(-lam)); }
    const bf16_t* lwa = LW + ((size_t)((l * 2 + DIR) * 2 + 0) * 8 + n) * 4096 + c16 * 64 + 8 * g;
    const bf16_t* lwx = LW + ((size_t)((l * 2 + DIR) * 2 + 1) * 8 + n) * 4096 + c16 * 64 + 8 * g;
    const float* cw = a.conv_w + (size_t)l * 4 * 512; const float* cbias = a.conv_b + (size_t)l * 512;
    const int srcm = DIR ? lane + 16 : lane - 16, srcm2 = DIR ? lane + 32 : lane - 32, srct = DIR ? c16 : 48 + c16;
    for (int ti = 0; ti < 8; ++ti) {
        asm volatile("" ::: "memory");
        const int tile = DIR ? 7 - ti : ti; const int tt = t0 + 16 * tile; const int t = tt + c16;
        int lv = lane; asm volatile("" : "+v"(lv)); const int idt = (lv & 15) - 8 * (lv >> 4);
        bf16x8 uf[2];
#pragma unroll
        for (int ks = 0; ks < 2; ++ks) { const int chb = n * 64 + 32 * ks + 8 * g;
            f32x4 u0 = *(const f32x4*)(cbias + chb), u1 = *(const f32x4*)(cbias + chb + 4);
#pragma unroll
            for (int i = 0; i < 4; ++i) { const int tp = t + i - 2; const bool ok = (tp >= 0) && (tp < seglen); const int tc = min(max(tp, 0), seglen - 1);
                const u32x4 xw = *(const u32x4*)(P + (size_t)(rowbase + tc) * PW + C_XB + chb);
                f32x4 w0 = *(const f32x4*)(cw + i * 512 + chb), w1 = *(const f32x4*)(cw + i * 512 + chb + 4);
                if (!ok) { w0 = (f32x4){0.f, 0.f, 0.f, 0.f}; w1 = w0; }
                u0[0] += w0[0] * bflo(xw[0]); u0[1] += w0[1] * bfhi(xw[0]); u0[2] += w0[2] * bflo(xw[1]); u0[3] += w0[3] * bfhi(xw[1]);
                u1[0] += w1[0] * bflo(xw[2]); u1[1] += w1[1] * bfhi(xw[2]); u1[2] += w1[2] * bflo(xw[3]); u1[3] += w1[3] * bfhi(xw[3]); }
            u32x4 pw; pw.x = pk2(u0[0], u0[1]); pw.y = pk2(u0[2], u0[3]); pw.z = pk2(u1[0], u1[1]); pw.w = pk2(u1[2], u1[3]);
            uf[ks] = __builtin_bit_cast(bf16x8, pw); }
#pragma unroll
        for (int nt = 0; nt < 4; ++nt) {
            f32x4 ga = {0.f, 0.f, 0.f, 0.f}, gx = ga, ud = ga;
#pragma unroll
            for (int ks = 0; ks < 2; ++ks) {
                const bf16x8 wa = *(const bf16x8*)(lwa + nt * 1024 + 32 * ks), wx = *(const bf16x8*)(lwx + nt * 1024 + 32 * ks);
                bf16x8 idf;
#pragma unroll
                for (int j = 0; j < 8; ++j) idf[j] = (32 * ks + j == 16 * nt + idt) ? (short)0x3F80 : (short)0;
                ga = MFMA16(uf[ks], wa, ga); gx = MFMA16(uf[ks], wx, gx); ud = MFMA16(uf[ks], idf, ud);
            }
            float av[4], bv[4];
#pragma unroll
            for (int j = 0; j < 4; ++j) {
                const float r = frcp(1.f + __expf(-(ga[j] + ba[nt]))), ii = frcp(1.f + __expf(-(gx[j] + bx[nt])));
                const float la = -8.0f * r * spc[nt];
                av[j] = __expf(la); bv[j] = sqrtf(neg_expm1(2.0f * la)) * ii * ud[j];
            }
            float Pj[4], Hj[4];
#pragma unroll
            for (int jj = 0; jj < 4; ++jj) { const int j = DIR ? 3 - jj : jj;
                if (jj == 0) { Pj[0] = av[j]; Hj[0] = bv[j]; } else { Pj[jj] = Pj[jj - 1] * av[j]; Hj[jj] = av[j] * Hj[jj - 1] + bv[j]; } }
            float Ai = Pj[3], Hi = Hj[3];
            { const float A1 = __shfl(Ai, srcm), H1 = __shfl(Hi, srcm); if (gg >= 1) { Hi = Ai * H1 + Hi; Ai = Ai * A1; } }
            { const float A2 = __shfl(Ai, srcm2), H2 = __shfl(Hi, srcm2); if (gg >= 2) { Hi = Ai * H2 + Hi; Ai = Ai * A2; } }
            float Ae = __shfl(Ai, srcm), He = __shfl(Hi, srcm); if (gg == 0) { Ae = 1.f; He = 0.f; }
            const float At = __shfl(Ai, srct), Ht = __shfl(Hi, srct);
            const float cin = Ae * carry[nt] + He;
            if (WRITE) {
#pragma unroll
                for (int jj = 0; jj < 4; ++jj) { const int j = DIR ? 3 - jj : jj; const float hv = Hj[jj] + Pj[jj] * cin;
                    const size_t row = (size_t)(rowbase + tt + 4 * g + j); const int ch = n * 64 + 16 * nt + c16;
                    if (DIR == 0) HT[row * 512 + ch] = hv;
                    else { bf16_t* gp = P + row * PW + C_GB + ch; const float gbv = bf2f(*gp); const float y = HT[row * 512 + ch] + hv;
                        const float z = 0.7978845608028654f * (gbv + 0.044715f * gbv * gbv * gbv); const float th = 1.f - 2.f * frcp(1.f + __expf(2.f * z));
                        const float ge = 0.5f * gbv * (1.f + th); if (!dry) *gp = (bf16_t)(pk2(y * ge, 0.f) & 0xffff); } }
            }
            carry[nt] = At * carry[nt] + Ht; arun[nt] *= At;
        }
    }
}
__device__ __forceinline__ void lru_pass1_item(const KArgs& a, int l, int item, int lane) {
    const int dir = item & 1, n = (item >> 1) & 7, rest = item >> 4, sp = rest % 66, b = rest / 66;
    float carry[4] = {0.f, 0.f, 0.f, 0.f}, arun[4] = {1.f, 1.f, 1.f, 1.f};
    if (dir) lru_sweep<1, false>(a, l, b, n, sp, carry, arun, lane); else lru_sweep<0, false>(a, l, b, n, sp, carry, arun, lane);
    float* SUM = (float*)(a.ws + WS_SUM);
    if (lane < 16) {
#pragma unroll
        for (int nt = 0; nt < 4; ++nt) { float* p = SUM + ((size_t)((b * 66 + sp) * 2 + dir) * 512 + n * 64 + 16 * nt + lane) * 2; p[0] = arun[nt]; p[1] = carry[nt]; }
    }
}
__device__ __forceinline__ void lru_fold(const float* SUM, int b, int p, int dir, int n, int c16, float (&carry)[4]) {
#pragma unroll
    for (int nt = 0; nt < 4; ++nt) { const float* q = SUM + ((size_t)((b * 66 + p) * 2 + dir) * 512 + n * 64 + 16 * nt + c16) * 2; carry[nt] = q[0] * carry[nt] + q[1]; }
}
__device__ __forceinline__ void lru_pass2_item(const KArgs& a, int l, int item, int lane, bool dry) {
    const int n = item & 7, rest = item >> 3, sp = rest % 66, b = rest / 66; const int c16 = lane & 15;
    const float* SUM = (const float*)(a.ws + WS_SUM);
    float carry[4] = {0.f, 0.f, 0.f, 0.f}, arun[4] = {1.f, 1.f, 1.f, 1.f};
    if (sp < 64) { lru_fold(SUM, b, 64, 0, n, c16, carry); lru_fold(SUM, b, 65, 0, n, c16, carry); for (int p = 0; p < sp; ++p) lru_fold(SUM, b, p, 0, n, c16, carry); }
    else if (sp == 65) lru_fold(SUM, b, 64, 0, n, c16, carry);
    lru_sweep<0, true>(a, l, b, n, sp, carry, arun, lane);
#pragma unroll
    for (int nt = 0; nt < 4; ++nt) carry[nt] = 0.f;
    if (sp < 64) { lru_fold(SUM, b, 65, 1, n, c16, carry); lru_fold(SUM, b, 64, 1, n, c16, carry); for (int p = 63; p > sp; --p) lru_fold(SUM, b, p, 1, n, c16, carry); }
    else if (sp == 64) lru_fold(SUM, b, 65, 1, n, c16, carry);
    lru_sweep<1, true>(a, l, b, n, sp, carry, arun, lane, dry);
}


#define XB_TMO      128
#define XB_XCNT(j)  (256  + 64 * (j))
#define XB_XSUB(j)  (1280 + 64 * (j))
#define XB_XGEN(j)  (2304 + 64 * (j))
#define XB_TOP      3328
#define XB_TOPGEN   3392
#define XCD_BAR_WORDS 3456
#define XB_SPIN_CAP (1u << 18)
__device__ __forceinline__ unsigned xb_ld(unsigned* p)              { return __hip_atomic_load(p, __ATOMIC_RELAXED, __HIP_MEMORY_SCOPE_AGENT); }
__device__ __forceinline__ unsigned xb_add(unsigned* p, unsigned v) { return __hip_atomic_fetch_add(p, v, __ATOMIC_RELAXED, __HIP_MEMORY_SCOPE_AGENT); }
__device__ __forceinline__ unsigned xb_xcc_id() { return (unsigned)__builtin_amdgcn_s_getreg((3 << 11) | 20) & 0xFu; }
#define XB_SPIN(cond, bar) do { unsigned _sp = 0; while (cond) { __builtin_amdgcn_s_sleep(1); \
    if ((++_sp & 255u) == 0u) { if (xb_ld(&(bar)[XB_TMO])) break; if (_sp > XB_SPIN_CAP) { atomicAdd(&(bar)[XB_TMO], 1u); break; } } } } while (0)
struct XcdBarrier { unsigned* bar; unsigned x; volatile LAS unsigned* st; };
__device__ __forceinline__ XcdBarrier xcd_barrier_post(unsigned* bar, volatile LAS unsigned* st) {
    XcdBarrier b; b.bar = bar; b.x = xb_xcc_id(); b.st = st;
    if (threadIdx.x == 0) (void)xb_add(&bar[XB_XCNT(b.x)], 1u);
    return b;
}
__device__ __forceinline__ void xcd_barrier_complete(unsigned* bar, unsigned x, unsigned& nloc, unsigned& nx) {
    const unsigned G = gridDim.x * gridDim.y * gridDim.z;
    unsigned sum, cnt, mine, sp = 0u;
    for (;;) {
        sum = 0u; cnt = 0u; mine = 0u;
#pragma unroll
        for (unsigned j = 0; j < 16; ++j) { const unsigned c = xb_ld(&bar[XB_XCNT(j)]); sum += c; cnt += (c > 0u) ? 1u : 0u; mine = (j == x) ? c : mine; }
        if (sum == G) break;
        __builtin_amdgcn_s_sleep(1);
        if ((++sp & 255u) == 0u) { if (xb_ld(&bar[XB_TMO])) break; if (sp > XB_SPIN_CAP) { atomicAdd(&bar[XB_TMO], 1u); break; } }
    }
    nloc = mine > 0u ? mine : 1u; nx = cnt > 0u ? cnt : 1u;
}
__device__ __forceinline__ void xcd_barrier(const XcdBarrier& b) {
    asm volatile("s_waitcnt vmcnt(0)" ::: "memory");
    __syncthreads();
    if (threadIdx.x == 0) {
        unsigned* bar = b.bar;
        __builtin_amdgcn_s_waitcnt(0);
        unsigned nloc = b.st[0], nx = b.st[1];
        if (nloc == 0u) { xcd_barrier_complete(bar, b.x, nloc, nx); b.st[0] = nloc; b.st[1] = nx; }
        const unsigned old = xb_add(&bar[XB_XSUB(b.x)], 1u);
        const unsigned gen = old / nloc;
        if (old + 1u == (gen + 1u) * nloc) {
            __builtin_amdgcn_fence(__ATOMIC_RELEASE, "agent");
            asm volatile("s_waitcnt vmcnt(0)" ::: "memory");
            const unsigned og = xb_add(&bar[XB_TOP], 1u);
            const unsigned tg = og / nx;
            if (og + 1u == (tg + 1u) * nx) xb_add(&bar[XB_TOPGEN], 1u);
            else XB_SPIN(xb_ld(&bar[XB_TOPGEN]) == tg, bar);
            __builtin_amdgcn_fence(__ATOMIC_ACQUIRE, "agent");
            xb_add(&bar[XB_XGEN(b.x)], 1u);
            asm volatile("s_waitcnt vmcnt(0)" ::: "memory");
        } else {
            XB_SPIN(xb_ld(&bar[XB_XGEN(b.x)]) == gen, bar);
            __builtin_amdgcn_fence(__ATOMIC_ACQUIRE, "agent");
            asm volatile("s_waitcnt vmcnt(0)" ::: "memory");
        }
    }
    __syncthreads();
}

__global__ void __launch_bounds__(512, 2) fwd_kernel(KArgs a) {
    extern __shared__ __attribute__((aligned(16))) unsigned char smem[];
    LAS unsigned char* lds = (LAS unsigned char*)smem;
    cg::grid_group grid = cg::this_grid();
    const int G = gridDim.x, NGW = G * 8;
    const int wave = __builtin_amdgcn_readfirstlane(threadIdx.x >> 6);
    volatile LAS unsigned* bst = (volatile LAS unsigned*)(lds + 131072);
    if (threadIdx.x < 2) bst[threadIdx.x] = 0u;
    __syncthreads();
    XcdBarrier xbar; xbar.bar = (unsigned*)(a.ws + WS_BAR); xbar.x = 0; xbar.st = bst;
    if (a.ph_hi - a.ph_lo > 1) xbar = xcd_barrier_post((unsigned*)(a.ws + WS_BAR), bst);
    for (int ph = a.ph_lo; ph < a.ph_hi; ++ph) {
        bf16_t* P = (bf16_t*)(a.ws + WS_P); bf16_t* H = (bf16_t*)(a.ws + WS_H); bf16_t* WB = (bf16_t*)(a.ws + WS_WB);
        float* XC = (float*)(a.ws + WS_XC);
        int lane = lane_id_asm(); const int gw = blockIdx.x * 8 + wave;
        if (ph == 0) phase0(a, lds, gw, NGW, wave, lane);
        else if (ph == 37) final_norm(a, gw, NGW, lane);
        else {
            const int l = (ph - 1) / 9, k = (ph - 1) % 9; const bool lastl = (l == NL - 1); const int Mrows = lastl ? ML : MT;
            const float* modl = (const float*)(a.ws + WS_MOD) + (size_t)l * 5 * 6144;
            const int reps = ((PROBE_MASK >> k) & 1) ? 2 : 1;
            for (int rep = 0; rep < reps; ++rep) { const bool dry = (rep + 1 < reps);
            if (rep) { xcd_barrier(xbar); lane = lane_id_asm(); }
            if (k == 0) {
                norm_phase(a, l, false, MT, gw, NGW, lane);
                if (l > 0) convert_stage_a(a, l, gw, NGW, (LAS float*)(lds + wave * 8448), lane);
            } else if (k == 1) {
                pg8::Gemm g{H, WB, 1}; pg8::Order So; So.init(MT, WIN, G, blockIdx.x, 1);
                EpiIn E{P, (bf16_t*)(a.ws + WS_VTA), (bf16_t*)(a.ws + WS_VTS)};
                #ifndef NO_EPIIN
                pg8::gemm_phase<EpiIn, D, D, D>(lds, g, So, E, wave);
#endif
            } else if (k == 2) {
                if ((PROBE_MASK >> 10) & 1) convert_stage_b(a, l, gw, NGW, (LAS float*)(lds + wave * 8448), lane);
                convert_stage_b(a, l, gw, NGW, (LAS float*)(lds + wave * 8448), lane);
                if ((PROBE_MASK >> 11) & 1) rope_k_phase(a, gw, NGW, lane, true);
                rope_k_phase(a, gw, NGW, lane, dry);
                if ((PROBE_MASK >> 12) & 1) for (int it = gw; it < NB * 66 * 8 * 2; it += NGW) lru_pass1_item(a, l, it, lane);
                if ((PROBE_MASK >> 13) & 1) for (int it = gw; it < NB * 128 * 8 * 4; it += NGW) na_item(a, l, it, lane, true);
                #ifndef NO_LRU
                for (int it = gw; it < NB * 66 * 8 * 2; it += NGW) lru_pass1_item(a, l, it, lane);
#endif
#ifndef NO_ATTN
                for (int it = gw; it < NB * 128 * 8 * 4; it += NGW) na_item(a, l, it, lane, dry);
                if (!lastl) for (int it = gw; it < NB * 8 * 16; it += NGW) ctx_item(a, l, it, false, lane, dry);
#endif
            } else if (k == 3) {
                if ((PROBE_MASK >> 14) & 1) for (int it = gw; it < NB * 66 * 8; it += NGW) lru_pass2_item(a, l, it, lane, true);
                if ((PROBE_MASK >> 15) & 1) for (int it = gw; it < NB * 4 * 512; it += NGW) swa_item(a, l, it, lane, true);
                #ifndef NO_LRU
                for (int it = gw; it < NB * 66 * 8; it += NGW) lru_pass2_item(a, l, it, lane, dry);
#endif
#ifndef NO_ATTN
                for (int it = gw; it < NB * 4 * 512; it += NGW) swa_item(a, l, it, lane, dry);
                if (!lastl) for (int it = gw; it < NB * 8 * 16; it += NGW) ctx_item(a, l, it, true, lane, dry);
#endif
            } else if (k == 4) {
                pg8::Gemm g{P, WB + WB_BR, 3}; pg8::Order So; So.init(Mrows, D, G, blockIdx.x, 3);
                EpiMerge E{P, H};
                #ifndef NO_EPIMERGE
                pg8::gemm_phase<EpiMerge, PW, 512, 512, C_QA, C_GB, C_QS, 524288>(lds, g, So, E, wave);
#endif
            } else if (k == 5) {
                pg8::Gemm g{H, WB + WB_OUT, 1}; pg8::Order So; So.init(Mrows, D, G, blockIdx.x, 1);
                EpiRes E{a.out, XC, modl, 2, dry};
#ifndef NO_EPIRES
                pg8::gemm_phase<EpiRes, D, D, D>(lds, g, So, E, wave);
#endif
            } else if (k == 8) {
                pg8::Gemm g{P, WB + WB_FF2, 1}; pg8::Order So; So.init(Mrows, D, G, blockIdx.x, 1);
                EpiRes E{a.out, XC, modl, 5, dry};
#ifndef NO_EPIRES
                pg8::gemm_phase<EpiRes, DFF, DFF, DFF>(lds, g, So, E, wave);
#endif
            } else if (k == 6) {
                norm_phase(a, l, true, Mrows, gw, NGW, lane);
            } else if (k == 7) {
                pg8::Gemm g{H, WB + WB_FF1, 1}; pg8::Order So; So.init(Mrows, DFF, G, blockIdx.x, 1);
                EpiFF1 E{P};
                #ifndef NO_EPIFF1
                pg8::gemm_phase<EpiFF1, D, D, D>(lds, g, So, E, wave);
#endif
            }
            }
        }
        if (ph + 1 < a.ph_hi) { if (ph == 0 || !USE_XCD_BAR) { __syncthreads(); grid.sync(); } else xcd_barrier(xbar); if ((PROBE_MASK >> 9) & 1) xcd_barrier(xbar); }
    }
}

extern "C" void kernel_launch(void* const* d_in, const int* in_sizes, int n_in, void* d_out, int out_size, void* d_ws, size_t ws_size, hipStream_t stream) {
    static int grid = 0;
    if (grid == 0) {
        if (n_in != 23 || ws_size < WS_END) { fprintf(stderr, "kernel_launch: unexpected n_in %d or ws_size %zu (< %zu)\n", n_in, ws_size, (size_t)WS_END); grid = -1; return; }
        int dev = 0, cus = 0, per_cu = 0;
        hipGetDevice(&dev); hipDeviceGetAttribute(&cus, hipDeviceAttributeMultiprocessorCount, dev);
        if (hipFuncSetAttribute((const void*)fwd_kernel, hipFuncAttributeMaxDynamicSharedMemorySize, LDS_BYTES) != hipSuccess) { fprintf(stderr, "hipFuncSetAttribute failed\n"); grid = -1; return; }
        if (hipOccupancyMaxActiveBlocksPerMultiprocessor(&per_cu, (const void*)fwd_kernel, 512, LDS_BYTES) != hipSuccess || per_cu < 1) { fprintf(stderr, "occupancy query: %d\n", per_cu); per_cu = 1; }
        (void)hipGetLastError();
        grid = cus;
    }
    if (grid < 0) return;
    KArgs a{};
    const float** f = (const float**)&a;
    for (int i = 0; i < 23; ++i) f[i] = (const float*)d_in[i];
    a.out = (float*)d_out; a.ws = (unsigned char*)d_ws;
#if N_LAUNCHES == 1
    a.ph_lo = 0; a.ph_hi = 38;
    if (hipMemsetAsync((unsigned char*)d_ws + WS_BAR, 0, XCD_BAR_WORDS * 4, stream) != hipSuccess) { fprintf(stderr, "memset failed\n"); return; }
    void* args[] = {&a};
    hipError_t e = hipLaunchCooperativeKernel((const void*)fwd_kernel, dim3(grid), dim3(512), args, LDS_BYTES, stream);
    if (e != hipSuccess) fprintf(stderr, "cooperative launch failed: %s (grid %d)\n", hipGetErrorString(e), grid);
#else
    for (int ph = 0; ph < 38; ++ph) { a.ph_lo = ph; a.ph_hi = ph + 1; hipLaunchKernelGGL(fwd_kernel, dim3(grid), dim3(512), LDS_BYTES, stream, a); }
#endif
}
```

```cpp
#include <hip/hip_runtime.h>
#include <hip/hip_cooperative_groups.h>
#include <cstdio>
#include <cstdint>
namespace cg = cooperative_groups;

#ifndef N_LAUNCHES
#define N_LAUNCHES 1
#endif

#ifndef USE_XCD_BAR
#define USE_XCD_BAR 1
#endif
#ifndef PROBE_MASK
#define PROBE_MASK 0
#endif
#define LAS __attribute__((address_space(3)))
typedef unsigned short bf16_t;
typedef short bf16x8 __attribute__((ext_vector_type(8)));
typedef short s16x4 __attribute__((ext_vector_type(4)));
typedef float f32x4 __attribute__((ext_vector_type(4)));
typedef unsigned u32x4 __attribute__((ext_vector_type(4)));
typedef unsigned u32x2 __attribute__((ext_vector_type(2)));

constexpr int D = 1024, NB = 4, S = 8192, CTX = 256, ML = NB * S, MC = NB * CTX, MT = ML + MC, NL = 4, DFF = 4096;
constexpr int PW = 5760;
constexpr int C_QA = 0, C_KA = 512, C_XB = 1024, C_GB = 1536, C_QS = 2048, C_KS = 2560, C_GA = 2688, C_GR = 3712, C_GS = 4736;
constexpr int VTOK = 8448;
constexpr int WIN = 6400;
constexpr size_t MiB = 1u << 20;
constexpr size_t WS_XC = 0, WS_H = 4 * MiB, WS_P = 70 * MiB, WS_VTA = WS_P + (size_t)MT * PW * 2, WS_VTS = WS_VTA + (size_t)NB * 8 * 64 * VTOK * 2,
                 WS_WB = WS_VTS + (size_t)NB * 2 * 64 * VTOK * 2, WS_MOD = WS_WB + 21 * MiB, WS_SUM = WS_MOD + MiB / 2, WS_LW = WS_SUM + 5 * MiB / 2, WS_BAR = WS_LW + MiB, WS_END = WS_BAR + 16384;
constexpr int WB_BR = 0, WB_OUT = 3 * 524288, WB_FF1 = WB_OUT + 1048576, WB_FF2 = WB_FF1 + 4194304;
constexpr int LDS_BYTES = 131072 + 64;
constexpr float LOG2E = 1.4426950408889634f;
constexpr float NEGBIG = -3.0e38f;

struct KArgs {
    const float *x, *c, *ctx, *c_ctx, *w_mod, *b_mod, *norm1_g, *norm2_g, *w_in, *na_rpb, *conv_w, *conv_b, *lru_wa, *lru_ba, *lru_wx, *lru_bx, *lru_lambda,
        *swa_sink, *w_branch, *w_out, *w_ff1, *w_ff2, *final_g;
    float* out; unsigned char* ws; int ph_lo, ph_hi;
};

typedef __bf16 bf16x2_t __attribute__((ext_vector_type(2)));
typedef float f32x2_t __attribute__((ext_vector_type(2)));
__device__ __forceinline__ unsigned pk2(float lo, float hi) { f32x2_t v = {lo, hi}; bf16x2_t r = __builtin_convertvector(v, bf16x2_t); return __builtin_bit_cast(unsigned, r); }
__device__ __forceinline__ float bf2f(unsigned short b) { return __uint_as_float(((unsigned)b) << 16); }
__device__ __forceinline__ float bflo(unsigned w) { return __uint_as_float(w << 16); }
__device__ __forceinline__ float bfhi(unsigned w) { return __uint_as_float(w & 0xffff0000u); }
__device__ __forceinline__ float fexp2(float x) { return __builtin_amdgcn_exp2f(x); }
__device__ __forceinline__ float frcp(float x) { return __builtin_amdgcn_rcpf(x); }
__device__ __forceinline__ int lane_id_asm() { int l; asm volatile("v_mbcnt_lo_u32_b32 %0, -1, 0\n\tv_mbcnt_hi_u32_b32 %0, -1, %0" : "=v"(l)); return l; }
__device__ __forceinline__ float wave_sum(float v) {
#pragma unroll
    for (int o = 1; o < 64; o <<= 1) v += __shfl_xor(v, o);
    return v;
}
#define MFMA16(a, b, c) __builtin_amdgcn_mfma_f32_16x16x32_bf16((a), (b), (c), 0, 0, 0)

namespace pg8 {
constexpr int BM = 256, BK = 64, HALF = 128, HTB = HALF * BK * 2, STAGE_BYTES = 8 * HTB, NXCD = 8, WGM = 8;
__host__ __device__ __forceinline__ int lds_byte(int r, int c) { const int st = (r >> 4) * 2 + (c >> 5), rr = r & 15, cc = c & 31, ob = rr * 64 + cc * 2; return st * 1024 + (ob ^ (((ob >> 9) & 1) << 5)); }
__host__ __device__ __forceinline__ void stage_rc(int b, int& R, int& C) { const int st = b / 1024, sb = b % 1024, swz = sb ^ (((sb >> 9) & 1) << 5); R = (st >> 1) * 16 + swz / 64; C = (st & 1) * 32 + (swz % 64) / 2; }
__host__ __device__ __forceinline__ int perm32(int rho) { const int n = rho >> 4, i = rho & 15; return 8 * (i >> 2) + 4 * n + (i & 3); }

struct Unit { int pm, pn, sub; };
struct Gemm { const bf16_t* A; const bf16_t* Bt; int nsub; };
struct Order {
    int nM, nN, nwg, G, c, nsub;
    __device__ void init(int M, int N, int G_, int c_, int nsub_) { nM = M / BM; nN = N / BM; nwg = nM * nN; G = G_; c = c_; nsub = nsub_; }
    __device__ bool next(int i, Unit& u) const {
        const int ti = i / nsub; u.sub = i - ti * nsub;
        const long L = (long)ti * G + c; if (L >= nwg) return false;
        int wgid = (int)L; { const int q = nwg / NXCD, r = nwg % NXCD, xcd = wgid % NXCD, off = wgid / NXCD; wgid = (xcd < r ? xcd * (q + 1) : r * (q + 1) + (xcd - r) * q) + off; }
        const int nig = WGM * nN, gid = wgid / nig, fm = gid * WGM, gsz = (nM - fm) < WGM ? (nM - fm) : WGM;
        u.pm = fm + ((wgid % nig) % gsz); u.pn = (wgid % nig) / gsz; return true;
    }
};

template <class Epi, int LDA, int LDB, int K, int A0 = 0, int A1 = 0, int A2 = 0, int BS = 0>
__device__ __forceinline__ void gemm_phase(LAS unsigned char* lds, const Gemm g, const Order& S, const Epi& E, int wid) {
    const int lane = lane_id_asm(), tid = wid * 64 + lane, wr = wid >> 2, wc = wid & 3, fr = lane & 15, fq = lane >> 4;
    constexpr int nt = K / BK;
    unsigned voffA[2], voffB[2];
#pragma unroll
    for (int i = 0; i < 2; ++i) { int R, C; stage_rc(tid * 16 + i * 8192, R, C); const int Rb = Epi::PERM ? ((R & ~31) + perm32(R & 31)) : R;
        voffA[i] = (unsigned)(R * LDA + C) * 2u; voffB[i] = (unsigned)(Rb * LDB + C) * 2u; }
    constexpr size_t kstep = (size_t)(BK * 2);
    constexpr size_t hstepA = (size_t)HALF * LDA * 2, hstepB = (size_t)HALF * LDB * 2;
    constexpr size_t tstepA = 2 * hstepA, tstepB = 2 * hstepB;
    const unsigned ldsw = (unsigned)wid * 1024u;
    const int aoff = lds_byte(wr * 64 + fr, fq * 8), boff = lds_byte(wc * 32 + fr, fq * 8);
#define PG8_SA(b, h) (((b) * 2 + (h)) * HTB)
#define PG8_SB(b, h) ((4 + (b) * 2 + (h)) * HTB)
#define PG8_STAGE(bufoff, gbase, voff) do { _Pragma("unroll") for (int _i = 0; _i < 2; ++_i) \
        __builtin_amdgcn_global_load_lds((const unsigned*)((const char*)(gbase) + (voff)[_i]), (LAS unsigned*)(lds + (bufoff) + ldsw + _i * 8192), 16, 0, 0); } while (0)
#define PG8_LDA(dst, b, h) do { _Pragma("unroll") for (int m = 0; m < 4; ++m) _Pragma("unroll") for (int k = 0; k < 2; ++k) dst[m][k] = *(const LAS bf16x8*)(lds + PG8_SA(b, h) + aoff + m * 2048 + k * 1024); } while (0)
#define PG8_LDB(dst, b, h) do { _Pragma("unroll") for (int n = 0; n < 2; ++n) _Pragma("unroll") for (int k = 0; k < 2; ++k) dst[n][k] = *(const LAS bf16x8*)(lds + PG8_SB(b, h) + boff + n * 2048 + k * 1024); } while (0)
#define PG8_MMA(ai, bj, At, Bt) do { __builtin_amdgcn_s_setprio(1); _Pragma("unroll") for (int m = 0; m < 4; ++m) _Pragma("unroll") for (int n = 0; n < 2; ++n) _Pragma("unroll") for (int k = 0; k < 2; ++k) \
        acc[ai][bj][m][n] = __builtin_amdgcn_mfma_f32_16x16x32_bf16(Bt[n][k], At[m][k], acc[ai][bj][m][n], 0, 0, 0); __builtin_amdgcn_s_setprio(0); } while (0)
#define PG8_WAIT_V(n) asm volatile("s_waitcnt vmcnt(" #n ")" ::: "memory")
#define PG8_WAIT_L(n) asm volatile("s_waitcnt lgkmcnt(" #n ")" ::: "memory")
#define PG8_BAR __builtin_amdgcn_s_barrier()
#define PG8_SCHED __builtin_amdgcn_sched_barrier(0)
    Unit cur, nxt; int ui = 0;
    if (!S.next(0, cur)) return;
    f32x4 acc[2][2][4][2];
#pragma unroll
    for (int a = 0; a < 2; ++a)
#pragma unroll
        for (int b = 0; b < 2; ++b)
#pragma unroll
            for (int m = 0; m < 4; ++m)
#pragma unroll
                for (int n = 0; n < 2; ++n) acc[a][b][m][n] = (f32x4){0.f, 0.f, 0.f, 0.f};
    bf16x8 At[4][2], B0[2][2], B1[2][2];
    const char* cA = (const char*)(g.A + (cur.sub == 0 ? A0 : (cur.sub == 1 ? A1 : A2))) + (size_t)cur.pm * tstepA; const char* cB = (const char*)(g.Bt + (cur.sub * BS)) + (size_t)cur.pn * tstepB;
    PG8_STAGE(PG8_SB(0, 0), cB, voffB); PG8_STAGE(PG8_SA(0, 0), cA, voffA); PG8_STAGE(PG8_SB(0, 1), cB + hstepB, voffB); PG8_STAGE(PG8_SA(0, 1), cA + hstepA, voffA);
    if (wr == 1) PG8_BAR;
    PG8_WAIT_V(4); PG8_BAR;
    PG8_STAGE(PG8_SB(1, 0), cB + kstep, voffB); PG8_STAGE(PG8_SA(1, 0), cA + kstep, voffA); PG8_STAGE(PG8_SB(1, 1), cB + hstepB + kstep, voffB);
    PG8_WAIT_V(6); PG8_BAR;
    for (;;) {
        const bool has_next = S.next(ui + 1, nxt);
        const char* nA = has_next ? (const char*)(g.A + (nxt.sub == 0 ? A0 : (nxt.sub == 1 ? A1 : A2))) + (size_t)nxt.pm * tstepA : cA; const char* nB = has_next ? (const char*)(g.Bt + (nxt.sub * BS)) + (size_t)nxt.pn * tstepB : cB;
        for (int t = 0; t < nt; t += 2) {
            const bool last = (t == nt - 2);
            const char* a1 = cA + (size_t)(t + 1) * kstep;
            const char* a2 = last ? nA : cA + (size_t)(t + 2) * kstep; const char* b2 = last ? nB : cB + (size_t)(t + 2) * kstep;
            const char* a3 = a2 + kstep; const char* b3 = b2 + kstep;
            PG8_LDB(B0, 0, 0); PG8_SCHED; PG8_LDA(At, 0, 0); PG8_STAGE(PG8_SA(1, 1), a1 + hstepA, voffA);
            PG8_WAIT_L(8); PG8_BAR; PG8_WAIT_L(0); PG8_MMA(0, 0, At, B0); PG8_BAR; PG8_SCHED;
            PG8_LDB(B1, 0, 1); PG8_STAGE(PG8_SB(0, 0), b2, voffB);
            PG8_BAR; PG8_WAIT_L(0); PG8_MMA(0, 1, At, B1); PG8_BAR;
            PG8_LDA(At, 0, 1); PG8_STAGE(PG8_SA(0, 0), a2, voffA);
            PG8_BAR; PG8_WAIT_L(0); PG8_MMA(1, 0, At, B0); PG8_BAR; PG8_SCHED;
            PG8_STAGE(PG8_SB(0, 1), b2 + hstepB, voffB);
            PG8_WAIT_V(6); PG8_BAR; PG8_MMA(1, 1, At, B1); PG8_BAR;
            PG8_LDB(B0, 1, 0); PG8_SCHED; PG8_LDA(At, 1, 0); PG8_STAGE(PG8_SA(0, 1), a2 + hstepA, voffA);
            PG8_WAIT_L(8); PG8_BAR; PG8_WAIT_L(0); PG8_MMA(0, 0, At, B0); PG8_BAR; PG8_SCHED;
            PG8_LDB(B1, 1, 1); PG8_STAGE(PG8_SB(1, 0), b3, voffB);
            PG8_BAR; PG8_WAIT_L(0); PG8_MMA(0, 1, At, B1); PG8_BAR;
            PG8_LDA(At, 1, 1); PG8_STAGE(PG8_SA(1, 0), a3, voffA);
            PG8_BAR; PG8_WAIT_L(0); PG8_MMA(1, 0, At, B0); PG8_BAR; PG8_SCHED;
            PG8_STAGE(PG8_SB(1, 1), b3 + hstepB, voffB);
            PG8_WAIT_V(6); PG8_BAR; PG8_MMA(1, 1, At, B1); PG8_BAR;
        }
        E(acc, cur, wr, wc, fr, fq);
        if (!has_next) break;
        if (!(Epi::KEEP && cur.sub + 1 < g.nsub)) {
#pragma unroll
            for (int a = 0; a < 2; ++a)
#pragma unroll
                for (int b = 0; b < 2; ++b)
#pragma unroll
                    for (int m = 0; m < 4; ++m)
#pragma unroll
                        for (int n = 0; n < 2; ++n) acc[a][b][m][n] = (f32x4){0.f, 0.f, 0.f, 0.f};
        }
        cur = nxt; cA = nA; cB = nB; ++ui;
    }
    PG8_WAIT_V(0);
    if (wr == 0) PG8_BAR;
    PG8_BAR;
#undef PG8_SA
#undef PG8_SB
#undef PG8_STAGE
#undef PG8_LDA
#undef PG8_LDB
#undef PG8_MMA
#undef PG8_WAIT_V
#undef PG8_WAIT_L
#undef PG8_BAR
#undef PG8_SCHED
}
}

typedef f32x4 AccT[2][2][4][2];
struct EpiIn {
    static constexpr bool PERM = true, KEEP = false;
    bf16_t* P; bf16_t* VTa; bf16_t* VTs;
    __device__ __forceinline__ void operator()(AccT& acc, const pg8::Unit& u, int wr, int wc, int fr, int fq) const {
        const int row0 = u.pm * 256 + wr * 64 + fr, trow = u.pm * 256;
        int b, tokbase; if (trow < ML) { b = trow >> 13; tokbase = trow & 8191; } else { b = (trow - ML) >> 8; tokbase = 8192; }
#pragma unroll
        for (int bj = 0; bj < 2; ++bj) {
            int pc = -1;
            if (u.pn < 10) pc = 256 * u.pn + 128 * bj; else if (u.pn == 10) { if (bj == 0) pc = 2560; } else if (u.pn >= 13) pc = 2688 + 256 * (u.pn - 13) + 128 * bj;
            if (pc >= 0) {
#pragma unroll
                for (int ai = 0; ai < 2; ++ai)
#pragma unroll
                    for (int m = 0; m < 4; ++m) { bf16_t* rowp = P + (size_t)(row0 + ai * 128 + m * 16) * PW + pc + wc * 32 + 8 * fq;
                        const f32x4 v0 = acc[ai][bj][m][0], v1 = acc[ai][bj][m][1];
                        u32x4 w; w.x = pk2(v0[0], v0[1]); w.y = pk2(v0[2], v0[3]); w.z = pk2(v1[0], v1[1]); w.w = pk2(v1[2], v1[3]);
                        *(u32x4*)rowp = w; }
            } else {
                const bool isS = (u.pn == 10); bf16_t* VT = isS ? VTs : VTa; const int nh = isS ? 2 : 8;
                const int cl = (isS ? 0 : 256 * (u.pn - 11) + 128 * bj) + 32 * wc + 8 * fq;
#pragma unroll
                for (int ai = 0; ai < 2; ++ai)
#pragma unroll
                    for (int m = 0; m < 4; ++m) { const int tok = tokbase + wr * 64 + fr + ai * 128 + m * 16;
#pragma unroll
                        for (int n = 0; n < 2; ++n) { const f32x4 v = acc[ai][bj][m][n]; const unsigned w0 = pk2(v[0], v[1]), w1 = pk2(v[2], v[3]);
                            const int c = cl + 4 * n; bf16_t* base = VT + ((size_t)(b * nh + (c >> 6)) * 64 + (c & 63)) * VTOK + tok;
                            base[0] = (bf16_t)(w0 & 0xffff); base[VTOK] = (bf16_t)(w0 >> 16); base[2 * VTOK] = (bf16_t)(w1 & 0xffff); base[3 * VTOK] = (bf16_t)(w1 >> 16); } }
            }
        }
    }
};
struct EpiMerge {
    static constexpr bool PERM = true, KEEP = true;
    const bf16_t* P; bf16_t* Mo;
    __device__ __forceinline__ void operator()(AccT& acc, const pg8::Unit& u, int wr, int wc, int fr, int fq) const {
        const int row0 = u.pm * 256 + wr * 64 + fr, col0 = u.pn * 256 + wc * 32 + 8 * fq;
        const int gc = (u.sub == 0) ? C_GA : (u.sub == 1 ? C_GR : C_GS), gn = (u.sub == 0) ? C_GR : C_GS;
        const bool lastsub = (u.sub == 2);
#pragma unroll
        for (int ai = 0; ai < 2; ++ai)
#pragma unroll
            for (int m = 0; m < 4; ++m) { const size_t row = (size_t)(row0 + ai * 128 + m * 16);
#pragma unroll
                for (int bj = 0; bj < 2; ++bj) { const int col = col0 + bj * 128;
                    const u32x4 wcur = *(const u32x4*)(P + row * PW + gc + col);
                    u32x4 wnx = wcur; if (!lastsub) wnx = *(const u32x4*)(P + row * PW + gn + col);
                    float f[8];
#pragma unroll
                    for (int q = 0; q < 4; ++q) {
                        const float c0 = bflo(wcur[q]), c1 = bfhi(wcur[q]), n0 = bflo(wnx[q]), n1 = bfhi(wnx[q]);
                        const float d0 = 1.f + fexp2(fminf(-c0 * LOG2E, 100.f)), d1 = 1.f + fexp2(fminf(-c1 * LOG2E, 100.f));
                        const float u0 = lastsub ? 1.f : 1.f + fexp2(fminf(-n0 * LOG2E, 100.f)), u1 = lastsub ? 1.f : 1.f + fexp2(fminf(-n1 * LOG2E, 100.f));
                        f[2 * q] = u0 * frcp(d0); f[2 * q + 1] = u1 * frcp(d1);
                    }
                    f32x4 v0 = acc[ai][bj][m][0], v1 = acc[ai][bj][m][1];
                    v0[0] *= f[0]; v0[1] *= f[1]; v0[2] *= f[2]; v0[3] *= f[3]; v1[0] *= f[4]; v1[1] *= f[5]; v1[2] *= f[6]; v1[3] *= f[7];
                    acc[ai][bj][m][0] = v0; acc[ai][bj][m][1] = v1;
                    if (lastsub) { u32x4 w; w.x = pk2(v0[0], v0[1]); w.y = pk2(v0[2], v0[3]); w.z = pk2(v1[0], v1[1]); w.w = pk2(v1[2], v1[3]);
                        *(u32x4*)(Mo + row * D + col) = w; }
                } }
    }
};
struct EpiRes {
    static constexpr bool PERM = false, KEEP = false;
    float* XL; float* XCp; const float* modl; int gidx; bool dry;
    __device__ __forceinline__ void operator()(AccT& acc, const pg8::Unit& u, int wr, int wc, int fr, int fq) const {
        const int trow = u.pm * 256, row0 = trow + wr * 64 + fr, col0 = u.pn * 256 + wc * 32 + 4 * fq;
        const int v = trow < ML ? (trow >> 13) : 4;
        float* Xb = trow < ML ? XL + (size_t)row0 * D : XCp + (size_t)(row0 - ML) * D;
        f32x4 gv[2][2];
#pragma unroll
        for (int bj = 0; bj < 2; ++bj)
#pragma unroll
            for (int n = 0; n < 2; ++n) gv[bj][n] = *(const f32x4*)(modl + v * 6144 + gidx * 1024 + col0 + bj * 128 + n * 16);
#pragma unroll
        for (int ai = 0; ai < 2; ++ai)
#pragma unroll
            for (int m = 0; m < 4; ++m) { float* rowp = Xb + (size_t)(ai * 128 + m * 16) * D + col0;
#pragma unroll
                for (int bj = 0; bj < 2; ++bj)
#pragma unroll
                    for (int n = 0; n < 2; ++n) { f32x4* p = (f32x4*)(rowp + bj * 128 + n * 16); f32x4 xv = *p; xv += gv[bj][n] * acc[ai][bj][m][n]; if (!dry) *p = xv; } }
    }
};
struct EpiFF1 {
    static constexpr bool PERM = true, KEEP = false;
    bf16_t* Hd;
    __device__ __forceinline__ void operator()(AccT& acc, const pg8::Unit& u, int wr, int wc, int fr, int fq) const {
        const int row0 = u.pm * 256 + wr * 64 + fr, col0 = u.pn * 256 + wc * 32 + 8 * fq;
#pragma unroll
        for (int ai = 0; ai < 2; ++ai)
#pragma unroll
            for (int m = 0; m < 4; ++m) { bf16_t* rowp = Hd + (size_t)(row0 + ai * 128 + m * 16) * DFF + col0;
#pragma unroll
                for (int bj = 0; bj < 2; ++bj) { f32x4 v0 = acc[ai][bj][m][0], v1 = acc[ai][bj][m][1];
#pragma unroll
                    for (int j = 0; j < 4; ++j) { const float a = fmaxf(v0[j], 0.f), b = fmaxf(v1[j], 0.f); v0[j] = a * a; v1[j] = b * b; }
                    u32x4 w; w.x = pk2(v0[0], v0[1]); w.y = pk2(v0[2], v0[3]); w.z = pk2(v1[0], v1[1]); w.w = pk2(v1[2], v1[3]);
                    *(u32x4*)(rowp + bj * 128) = w; } }
    }
};

__device__ __forceinline__ void transpose_item(const float* W, int ldn, int k0, int nsrc0, bf16_t* WT, int ldt, int ndst0, LAS float* scr, int lane) {
#pragma unroll 8
    for (int i = 0; i < 32; ++i) { const int kk = 2 * i + (lane >> 5); scr[kk * 33 + (lane & 31)] = W[(size_t)(k0 + kk) * ldn + nsrc0 + (lane & 31)]; }
    asm volatile("s_waitcnt lgkmcnt(0)" ::: "memory");
    const int c = lane & 7;
#pragma unroll
    for (int j = 0; j < 4; ++j) { const int n = (lane >> 3) + 8 * j; const LAS float* s = scr + (8 * c) * 33 + n;
        u32x4 o; o.x = pk2(s[0 * 33], s[1 * 33]); o.y = pk2(s[2 * 33], s[3 * 33]); o.z = pk2(s[4 * 33], s[5 * 33]); o.w = pk2(s[6 * 33], s[7 * 33]);
        *(u32x4*)(WT + (size_t)(ndst0 + n) * ldt + k0 + 8 * c) = o; }
    asm volatile("s_waitcnt lgkmcnt(0)" ::: "memory");
}
__device__ __forceinline__ void conv_seg(int& base, int gw, int NGW, const float* W, int K, int ldn, int nsrc0, int ncols, bf16_t* WT, int ldt, int ndst0, LAS float* scr, int lane) {
    const int nblk = ncols / 32, nitems = (K / 64) * nblk;
    int first = base + (((gw - base) % NGW) + NGW) % NGW;
    for (int it = first; it < base + nitems; it += NGW) { const int r = it - base, kb = r / nblk, nb = r - kb * nblk;
        transpose_item(W, ldn, 64 * kb, nsrc0 + 32 * nb, WT, ldt, ndst0 + 32 * nb, scr, lane); }
    base += nitems;
}
__device__ __forceinline__ void convert_stage_a(const KArgs& a, int l, int gw, int NGW, LAS float* scr, int) {
    const int lane = lane_id_asm();
    const float* W = a.w_in + (size_t)l * D * WIN; bf16_t* WT = (bf16_t*)(a.ws + WS_WB); int base = 0;
    conv_seg(base, gw, NGW, W, D, WIN, 0, 1024, WT, D, 0, scr, lane);
    conv_seg(base, gw, NGW, W, D, WIN, 1536, 1024, WT, D, 1024, scr, lane);
    conv_seg(base, gw, NGW, W, D, WIN, 2560, 512, WT, D, 2048, scr, lane);
    conv_seg(base, gw, NGW, W, D, WIN, 3072, 256, WT, D, 2560, scr, lane);
    conv_seg(base, gw, NGW, W, D, WIN, 1024, 512, WT, D, 2816, scr, lane);
    conv_seg(base, gw, NGW, W, D, WIN, 3328, 3072, WT, D, 3328, scr, lane);
}
__device__ __forceinline__ void convert_stage_b(const KArgs& a, int l, int gw, int NGW, LAS float* scr, int) {
    const int lane = lane_id_asm();
    bf16_t* WB = (bf16_t*)(a.ws + WS_WB); int base = 0;
    const float* wbr = a.w_branch + (size_t)l * 1536 * D;
    for (int i = 0; i < 3; ++i) conv_seg(base, gw, NGW, wbr + (size_t)i * 512 * D, 512, D, 0, D, WB + WB_BR + i * 524288, 512, 0, scr, lane);
    conv_seg(base, gw, NGW, a.w_out + (size_t)l * D * D, D, D, 0, D, WB + WB_OUT, D, 0, scr, lane);
    conv_seg(base, gw, NGW, a.w_ff1 + (size_t)l * D * DFF, D, DFF, 0, DFF, WB + WB_FF1, D, 0, scr, lane);
    conv_seg(base, gw, NGW, a.w_ff2 + (size_t)l * DFF * D, DFF, D, 0, D, WB + WB_FF2, DFF, 0, scr, lane);
}

__device__ __forceinline__ void phase0(const KArgs& a, LAS unsigned char* lds, int gw, int NGW, int wave, int lane) {
    LAS float* cond = (LAS float*)lds;
    LAS float* red = (LAS float*)(lds + 20480);
    const int tid = wave * 64 + lane;
    for (int i = tid; i < 5 * D; i += 512) { const int v = i >> 10, k = i & 1023; const float cv = v < 4 ? a.c[v * D + k] : a.c_ctx[k]; cond[i] = cv / (1.f + __expf(-cv)); }
    __syncthreads();
    float* mods = (float*)(a.ws + WS_MOD);
    const int col = tid & 127, kq = tid >> 7;
    for (int task = blockIdx.x; task < NL * 48; task += gridDim.x) {
        const int l = task / 48, cc = (task % 48) * 128 + col;
        const float* W = a.w_mod + (size_t)l * D * 6144 + cc;
        float s0 = 0.f, s1 = 0.f, s2 = 0.f, s3 = 0.f, s4 = 0.f;
#pragma unroll 8
        for (int k = kq * 256; k < kq * 256 + 256; ++k) { const float w = W[(size_t)k * 6144];
            s0 += w * cond[k]; s1 += w * cond[1024 + k]; s2 += w * cond[2048 + k]; s3 += w * cond[3072 + k]; s4 += w * cond[4096 + k]; }
        red[(kq * 5 + 0) * 128 + col] = s0; red[(kq * 5 + 1) * 128 + col] = s1; red[(kq * 5 + 2) * 128 + col] = s2; red[(kq * 5 + 3) * 128 + col] = s3; red[(kq * 5 + 4) * 128 + col] = s4;
        __syncthreads();
        for (int o = tid; o < 5 * 128; o += 512) { const int v = o >> 7, c2 = o & 127, ccol = (task % 48) * 128 + c2;
            const float r = red[(0 * 5 + v) * 128 + c2] + red[(1 * 5 + v) * 128 + c2] + red[(2 * 5 + v) * 128 + c2] + red[(3 * 5 + v) * 128 + c2];
            mods[((size_t)l * 5 + v) * 6144 + ccol] = r + a.b_mod[l * 6144 + ccol]; }
        __syncthreads();
    }
    __syncthreads();
    LAS float* scr = (LAS float*)(lds + 32768 + wave * 8448);
    bf16_t* LW = (bf16_t*)(a.ws + WS_LW);
    for (int it = gw; it < NL * 2 * 2 * 8 * 2; it += NGW) { const int half = it & 1, mi = it >> 1, n = mi & 7, mat = (mi >> 3) & 1, ld = mi >> 4;
        const float* W = (mat ? a.lru_wx : a.lru_wa) + ((size_t)ld * 8 + n) * 4096;
        transpose_item(W, 64, 0, 32 * half, LW + ((size_t)(ld * 2 + mat) * 8 + n) * 4096, 64, 32 * half, scr, lane); }
    convert_stage_a(a, 0, gw, NGW, scr, lane);
}

__device__ __forceinline__ void norm_phase(const KArgs& a, int l, bool second, int nrows, int gw, int NGW, int lane) {
    const bool first_read = (l == 0 && !second);
    const float* srcL = first_read ? a.x : a.out; const float* srcC = first_read ? a.ctx : (const float*)(a.ws + WS_XC);
    float* XC = (float*)(a.ws + WS_XC); bf16_t* H = (bf16_t*)(a.ws + WS_H);
    const float* g = (second ? a.norm2_g : a.norm1_g) + l * D; const float* modl = (const float*)(a.ws + WS_MOD) + (size_t)l * 5 * 6144; const int sidx = second ? 3 : 0;
    for (int row = gw; row < nrows; row += NGW) {
        const float* src = row < ML ? srcL + (size_t)row * D : srcC + (size_t)(row - ML) * D; const int v = row < ML ? (row >> 13) : 4;
        const f32x4* xr = (const f32x4*)src + lane; f32x4 xv[4]; float s = 0.f;
#pragma unroll
        for (int j = 0; j < 4; ++j) { xv[j] = xr[64 * j]; s += (xv[j][0] * xv[j][0] + xv[j][1] * xv[j][1]) + (xv[j][2] * xv[j][2] + xv[j][3] * xv[j][3]); }
        const float rstd = 1.0f / sqrtf(wave_sum(s) * (1.f / D) + 1e-6f);
        if (first_read) { f32x4* cp = (f32x4*)(row < ML ? a.out + (size_t)row * D : XC + (size_t)(row - ML) * D) + lane;
#pragma unroll
            for (int j = 0; j < 4; ++j) cp[64 * j] = xv[j]; }
        u32x2* o8 = (u32x2*)(H + (size_t)row * D) + lane;
#pragma unroll
        for (int j = 0; j < 4; ++j) { const int c = 4 * lane + 256 * j; const f32x4 gg = *(const f32x4*)(g + c), sh = *(const f32x4*)(modl + v * 6144 + sidx * 1024 + c), sc = *(const f32x4*)(modl + v * 6144 + (sidx + 1) * 1024 + c);
            f32x4 h = xv[j] * rstd * gg * (sc + 1.0f) + sh; u32x2 w; w.x = pk2(h[0], h[1]); w.y = pk2(h[2], h[3]); o8[64 * j] = w; }
    }
}
__device__ __forceinline__ void final_norm(const KArgs& a, int gw, int NGW, int lane) {
    for (int row = gw; row < ML; row += NGW) {
        f32x4* xr = (f32x4*)(a.out + (size_t)row * D) + lane; f32x4 xv[4]; float s = 0.f;
#pragma unroll
        for (int j = 0; j < 4; ++j) { xv[j] = xr[64 * j]; s += (xv[j][0] * xv[j][0] + xv[j][1] * xv[j][1]) + (xv[j][2] * xv[j][2] + xv[j][3] * xv[j][3]); }
        const float rstd = 1.0f / sqrtf(wave_sum(s) * (1.f / D) + 1e-6f);
#pragma unroll
        for (int j = 0; j < 4; ++j) { const f32x4 gg = *(const f32x4*)(a.final_g + 4 * lane + 256 * j); xr[64 * j] = xv[j] * rstd * gg; }
    }
}

struct AttnSt { f32x4 o[4]; float m, l; };
struct KVF { bf16x8 k[4]; bf16x8 v[4]; };
__device__ __forceinline__ void kv_load(KVF& f, const bf16_t* k0p, const bf16_t* k1p, const bf16_t* vp) {
    f.k[0] = *(const bf16x8*)k0p; f.k[1] = *(const bf16x8*)(k0p + 32); f.k[2] = *(const bf16x8*)k1p; f.k[3] = *(const bf16x8*)(k1p + 32);
#pragma unroll
    for (int dt = 0; dt < 4; ++dt) f.v[dt] = *(const bf16x8*)(vp + (size_t)dt * 16 * VTOK);
}
template <class BiasF>
__device__ __forceinline__ void attn_compute(AttnSt& st, const KVF& f, const bf16x8 (&qf)[2], BiasF bias) {
    f32x4 s0 = {0.f, 0.f, 0.f, 0.f}, s1 = {0.f, 0.f, 0.f, 0.f};
    s0 = MFMA16(f.k[0], qf[0], s0); s0 = MFMA16(f.k[1], qf[1], s0); s1 = MFMA16(f.k[2], qf[0], s1); s1 = MFMA16(f.k[3], qf[1], s1);
    float t[8]; const float SC = 0.125f * LOG2E;
#pragma unroll
    for (int j = 0; j < 4; ++j) { t[j] = bias(j, s0[j] * SC); t[4 + j] = bias(4 + j, s1[j] * SC); }
    float bm = fmaxf(fmaxf(fmaxf(t[0], t[1]), fmaxf(t[2], t[3])), fmaxf(fmaxf(t[4], t[5]), fmaxf(t[6], t[7])));
    bm = fmaxf(bm, __shfl_xor(bm, 16)); bm = fmaxf(bm, __shfl_xor(bm, 32));
    const float mn = fmaxf(st.m, bm), alpha = fexp2(st.m - mn); st.m = mn;
    float ls = 0.f;
#pragma unroll
    for (int j = 0; j < 8; ++j) { t[j] = fexp2(t[j] - mn); ls += t[j]; }
    st.l = st.l * alpha + ls;
    u32x4 pw; pw.x = pk2(t[0], t[1]); pw.y = pk2(t[2], t[3]); pw.z = pk2(t[4], t[5]); pw.w = pk2(t[6], t[7]);
    const bf16x8 pf = __builtin_bit_cast(bf16x8, pw);
#pragma unroll
    for (int dt = 0; dt < 4; ++dt) { st.o[dt] *= alpha; st.o[dt] = MFMA16(f.v[dt], pf, st.o[dt]); }
}
__device__ __forceinline__ void attn_init(AttnSt& st) {
#pragma unroll
    for (int dt = 0; dt < 4; ++dt) st.o[dt] = (f32x4){0.f, 0.f, 0.f, 0.f};
    st.m = -1.0e30f; st.l = 0.f;
}
__device__ __forceinline__ void attn_store(const AttnSt& st, float lextra, bf16_t* orow, int lane, bool dry) {
    float l = st.l; l += __shfl_xor(l, 16); l += __shfl_xor(l, 32); l += lextra;
    const float inv = 1.0f / l; const int g = lane >> 4;
#pragma unroll
    for (int dt = 0; dt < 4; ++dt) { const f32x4 o = st.o[dt] * inv; u32x2 w; w.x = pk2(o[0], o[1]); w.y = pk2(o[2], o[3]); if (!dry) *(u32x2*)(orow + 16 * dt + 4 * g) = w; }
}
__device__ __forceinline__ void na_item(const KArgs& a, int l, int item, int lane, bool dry) {
    bf16_t* P = (bf16_t*)(a.ws + WS_P); const bf16_t* VT = (const bf16_t*)(a.ws + WS_VTA);
    const int i = item & 3, h = (item >> 2) & 7, r = (item >> 5) & 127, b = item >> 12;
    const int c16 = lane & 15, g = lane >> 4, kk0 = 8 * (c16 >> 2) + (c16 & 3);
    const int cq = 16 * i + c16; const size_t qrow = (size_t)b * S + r * 64 + cq;
    bf16x8 qf[2]; qf[0] = *(const bf16x8*)(P + qrow * PW + C_QA + h * 64 + 8 * g); qf[1] = *(const bf16x8*)(P + qrow * PW + C_QA + h * 64 + 32 + 8 * g);
    const int c0 = (i == 0) ? 0 : (i == 1 ? 8 : (i == 2 ? 24 : 32));
    const int rs = min(max(r - 4, 0), 120), cs = min(max(cq - 8, 0), 48);
    unsigned okm = 0; int idx0 = c0 + 8 * g - cq + 15;
#pragma unroll
    for (int e = 0; e < 8; ++e) { const int kc = c0 + 8 * g + e; okm |= ((kc >= cs) && (kc < cs + 16)) ? (1u << e) : 0u; }
    const float* rpb = a.na_rpb + ((size_t)l * 8 + h) * 15 * 31;
    const bf16_t* kcol = P + C_KA + h * 64 + 8 * g; const bf16_t* vrow = VT + (size_t)((b * 8 + h) * 64 + c16) * VTOK + 8 * g;
    AttnSt st; attn_init(st);
    KVF cur, nxt; float bc[8], bn[8];
#pragma unroll
    for (int e = 0; e < 8; ++e) { bc[e] = 0.f; bn[e] = 0.f; }
    auto loadblk = [&](int blk, KVF& f, float (&bb)[8]) {
        if (blk < 8) { const int R = rs + blk; const size_t tok0 = (size_t)R * 64 + c0; const bf16_t* kp = kcol + ((size_t)b * S + tok0 + kk0) * PW;
            kv_load(f, kp, kp + (size_t)4 * PW, vrow + tok0);
            const float* rp = rpb + (R - r + 7) * 31;
#pragma unroll
            for (int e = 0; e < 8; ++e) bb[e] = rp[min(max(idx0 + e, 0), 30)];
        } else { const int cb = blk - 8; const bf16_t* kp = kcol + ((size_t)ML + b * CTX + 32 * cb + kk0) * PW; kv_load(f, kp, kp + (size_t)4 * PW, vrow + 8192 + 32 * cb); }
    };
    loadblk(0, cur, bc);
    for (int blk = 0; blk < 16; ++blk) {
        loadblk(blk < 15 ? blk + 1 : 15, nxt, bn);
        if (blk < 8) attn_compute(st, cur, qf, [&](int e, float s) { return ((okm >> e) & 1u) ? s + bc[e] * LOG2E : NEGBIG; });
        else attn_compute(st, cur, qf, [](int, float s) { return s; });
        cur = nxt;
#pragma unroll
        for (int e = 0; e < 8; ++e) bc[e] = bn[e];
    }
    attn_store(st, 0.f, P + qrow * PW + C_QA + h * 64, lane, dry);
}
__device__ __forceinline__ void ctx_item(const KArgs& a, int l, int item, bool swa, int lane, bool dry) {
    bf16_t* P = (bf16_t*)(a.ws + WS_P);
    const int i = item & 15, h = (item >> 4) & 7, b = item >> 7;
    const int c16 = lane & 15, g = lane >> 4, kk0 = 8 * (c16 >> 2) + (c16 & 3);
    const size_t qrow = (size_t)ML + b * CTX + 16 * i + c16; const int qc = (swa ? C_QS : C_QA) + h * 64;
    bf16x8 qf[2]; qf[0] = *(const bf16x8*)(P + qrow * PW + qc + 8 * g); qf[1] = *(const bf16x8*)(P + qrow * PW + qc + 32 + 8 * g);
    const bf16_t* kcol = P + (swa ? C_KS + (h >> 2) * 64 : C_KA + h * 64) + 8 * g;
    const bf16_t* vrow = (swa ? (const bf16_t*)(a.ws + WS_VTS) + (size_t)((b * 2 + (h >> 2)) * 64 + c16) * VTOK : (const bf16_t*)(a.ws + WS_VTA) + (size_t)((b * 8 + h) * 64 + c16) * VTOK) + 8 * g;
    AttnSt st; attn_init(st);
    for (int cb = 0; cb < 8; ++cb) { KVF f; const bf16_t* kp = kcol + ((size_t)ML + b * CTX + 32 * cb + kk0) * PW; kv_load(f, kp, kp + (size_t)4 * PW, vrow + 8192 + 32 * cb);
        attn_compute(st, f, qf, [](int, float s) { return s; }); }
    const float lex = swa ? fexp2(a.swa_sink[l * 8 + h] * LOG2E - st.m) : 0.f;
    attn_store(st, lex, P + qrow * PW + qc, lane, dry);
}
__device__ __forceinline__ float inv_freq(int f) { return exp2f(-(float)f * (13.287712379549449f / 16.0f)); }
__device__ __forceinline__ void rope_cs(int pos, int f, float& c, float& s) {
    const float ang = (float)pos * inv_freq(f); float rev = ang * 0.15915494309189535f; rev -= rintf(rev);
    c = __builtin_amdgcn_cosf(rev); s = __builtin_amdgcn_sinf(rev);
}
__device__ __forceinline__ void rope_q(bf16x8 (&qf)[2], int tq, int g) {
    const int pos = (g < 2) ? (tq >> 6) : (tq & 63);
    u32x4 w0 = __builtin_bit_cast(u32x4, qf[0]), w1 = __builtin_bit_cast(u32x4, qf[1]);
#pragma unroll
    for (int q = 0; q < 4; ++q) {
        float c0, s0, c1, s1; rope_cs(pos, 8 * (g & 1) + 2 * q, c0, s0); rope_cs(pos, 8 * (g & 1) + 2 * q + 1, c1, s1);
        const float a0 = bflo(w0[q]), a1 = bfhi(w0[q]), b0 = bflo(w1[q]), b1 = bfhi(w1[q]);
        w0[q] = pk2(a0 * c0 - b0 * s0, a1 * c1 - b1 * s1); w1[q] = pk2(b0 * c0 + a0 * s0, b1 * c1 + a1 * s1);
    }
    qf[0] = __builtin_bit_cast(bf16x8, w0); qf[1] = __builtin_bit_cast(bf16x8, w1);
}
__device__ __forceinline__ void swa_item(const KArgs& a, int l, int item, int, bool dry) {
    const int lane = lane_id_asm();
    bf16_t* P = (bf16_t*)(a.ws + WS_P); const bf16_t* VT = (const bf16_t*)(a.ws + WS_VTS);
    const int qt = item & 511, hp = (item >> 9) & 1, kvh = (item >> 10) & 1, b = item >> 11, h0 = 4 * kvh + 2 * hp;
    const int c16 = lane & 15, g = lane >> 4, kk0 = 8 * (c16 >> 2) + (c16 & 3);
    const int tq = 16 * qt + c16; const size_t qrow = (size_t)b * S + tq;
    bf16x8 qa[2], qb[2];
    qa[0] = *(const bf16x8*)(P + qrow * PW + C_QS + h0 * 64 + 8 * g); qa[1] = *(const bf16x8*)(P + qrow * PW + C_QS + h0 * 64 + 32 + 8 * g);
    qb[0] = *(const bf16x8*)(P + qrow * PW + C_QS + h0 * 64 + 64 + 8 * g); qb[1] = *(const bf16x8*)(P + qrow * PW + C_QS + h0 * 64 + 96 + 8 * g);
    rope_q(qa, tq, g); rope_q(qb, tq, g);
    const bf16_t* kcol = P + C_KS + kvh * 64 + 8 * g; const bf16_t* vrow = VT + (size_t)((b * 2 + kvh) * 64 + c16) * VTOK + 8 * g;
    AttnSt sa, sb; attn_init(sa); attn_init(sb);
    const int kstart = 16 * qt - 128;
    int bfirst = 0, blast = 8; while (kstart + 32 * bfirst + 31 < 0) ++bfirst; while (kstart + 32 * blast >= S) --blast;
    const int nblk = (blast - bfirst + 1) + 8;
    KVF cur, nxt;
    auto loadblk = [&](int q, KVF& f) {
        const int lb = bfirst + q;
        if (lb <= blast) { const int k0 = kstart + 32 * lb; const int ka = min(max(k0 + kk0, 0), S - 1), kb = min(max(k0 + kk0 + 4, 0), S - 1), vt = min(max(k0 + 8 * g, 0), S - 8);
            kv_load(f, kcol + ((size_t)b * S + ka) * PW, kcol + ((size_t)b * S + kb) * PW, VT + (size_t)((b * 2 + kvh) * 64 + c16) * VTOK + vt);
        } else { const int cb = lb - blast - 1; const bf16_t* kp = kcol + ((size_t)ML + b * CTX + 32 * cb + kk0) * PW; kv_load(f, kp, kp + (size_t)4 * PW, vrow + 8192 + 32 * cb); }
    };
    loadblk(0, cur);
    for (int q = 0; q < nblk; ++q) {
        loadblk(q + 1 < nblk ? q + 1 : q, nxt);
        const int lb = bfirst + q;
        if (lb <= blast) { const int kbase = kstart + 32 * lb + 8 * g;
            auto msk = [&](int e, float s) { const int k = kbase + e, dlt = k - tq; return ((k >= 0) && (k < S) && (dlt <= 128) && (dlt >= -128)) ? s : NEGBIG; };
            attn_compute(sa, cur, qa, msk); attn_compute(sb, cur, qb, msk);
        } else { attn_compute(sa, cur, qa, [](int, float s) { return s; }); attn_compute(sb, cur, qb, [](int, float s) { return s; }); }
        cur = nxt;
    }
    attn_store(sa, fexp2(a.swa_sink[l * 8 + h0] * LOG2E - sa.m), P + qrow * PW + C_QS + h0 * 64, lane, dry);
    attn_store(sb, fexp2(a.swa_sink[l * 8 + h0 + 1] * LOG2E - sb.m), P + qrow * PW + C_QS + h0 * 64 + 64, lane, dry);
}
__device__ __forceinline__ void rope_k_phase(const KArgs& a, int gw, int NGW, int lane, bool dry) {
    bf16_t* P = (bf16_t*)(a.ws + WS_P);
    const int hd = lane >> 5, i = lane & 31;
    for (int row = gw; row < ML; row += NGW) {
        const int t = row & (S - 1); const int pos = (i < 16) ? (t >> 6) : (t & 63);
        float c, s; rope_cs(pos, i & 15, c, s);
        bf16_t* p = P + (size_t)row * PW + C_KS + hd * 64;
        const float t1 = bf2f(p[i]), t2 = bf2f(p[i + 32]);
        const unsigned w = pk2(t1 * c - t2 * s, t2 * c + t1 * s);
        if (!dry) { p[i] = (bf16_t)(w & 0xffff); p[i + 32] = (bf16_t)(w >> 16); }
    }
}

__device__ __forceinline__ float neg_expm1(float x) {
    const float ser = -x * (1.f + x * (0.5f + x * (0.16666667f + x * (0.041666668f + x * (0.0083333338f + x * 0.0013888889f)))));
    return x > -0.25f ? ser : 1.f - __expf(x);
}
template <int DIR, bool WRITE>
__device__ __forceinline__ void lru_sweep(const KArgs& a, int l, int b, int n, int sp, float (&carry)[4], float (&arun)[4], int lane, bool dry = false) {
    bf16_t* P = (bf16_t*)(a.ws + WS_P); float* HT = (float*)(a.ws + WS_H); const bf16_t* LW = (const bf16_t*)(a.ws + WS_LW);
    const int c16 = lane & 15, g = lane >> 4; const int gg = DIR ? 3 - g : g;
    const bool lat = sp < 64; const int rowbase = lat ? b * S : ML + b * CTX, seglen = lat ? S : CTX, t0 = (lat ? sp : sp - 64) * 128;
    float ba[4], bx[4], spc[4];
#pragma unroll
    for (int nt = 0; nt < 4; ++nt) { const int ch = n * 64 + 16 * nt + c16, o = (l * 2 + DIR) * 512 + ch;
        ba[nt] = a.lru_ba[o]; bx[nt] = a.lru_bx[o]; const float lam = a.lru_lambda[o]; spc[nt] = (lam < -15.f) ? -lam : log1pf(__expf(-lam)); }
    const bf16_t* lwa = LW + ((size_t)((l * 2 + DIR) * 2 + 0) * 8 + n) * 4096 + c16 * 64 + 8 * g;
    const bf16_t* lwx = LW + ((size_t)((l * 2 + DIR) * 2 + 1) * 8 + n) * 4096 + c16 * 64 + 8 * g;
    const float* cw = a.conv_w + (size_t)l * 4 * 512; const float* cbias = a.conv_b + (size_t)l * 512;
    const int srcm = DIR ? lane + 16 : lane - 16, srcm2 = DIR ? lane + 32 : lane - 32, srct = DIR ? c16 : 48 + c16;
    for (int ti = 0; ti < 8; ++ti) {
        asm volatile("" ::: "memory");
        const int tile = DIR ? 7 - ti : ti; const int tt = t0 + 16 * tile; const int t = tt + c16;
        int lv = lane; asm volatile("" : "+v"(lv)); const int idt = (lv & 15) - 8 * (lv >> 4);
        bf16x8 uf[2];
#pragma unroll
        for (int ks = 0; ks < 2; ++ks) { const int chb = n * 64 + 32 * ks + 8 * g;
            f32x4 u0 = *(const f32x4*)(cbias + chb), u1 = *(const f32x4*)(cbias + chb + 4);
#pragma unroll
            for (int i = 0; i < 4; ++i) { const int tp = t + i - 2; const bool ok = (tp >= 0) && (tp < seglen); const int tc = min(max(tp, 0), seglen - 1);
                const u32x4 xw = *(const u32x4*)(P + (size_t)(rowbase + tc) * PW + C_XB + chb);
                f32x4 w0 = *(const f32x4*)(cw + i * 512 + chb), w1 = *(const f32x4*)(cw + i * 512 + chb + 4);
                if (!ok) { w0 = (f32x4){0.f, 0.f, 0.f, 0.f}; w1 = w0; }
                u0[0] += w0[0] * bflo(xw[0]); u0[1] += w0[1] * bfhi(xw[0]); u0[2] += w0[2] * bflo(xw[1]); u0[3] += w0[3] * bfhi(xw[1]);
                u1[0] += w1[0] * bflo(xw[2]); u1[1] += w1[1] * bfhi(xw[2]); u1[2] += w1[2] * bflo(xw[3]); u1[3] += w1[3] * bfhi(xw[3]); }
            u32x4 pw; pw.x = pk2(u0[0], u0[1]); pw.y = pk2(u0[2], u0[3]); pw.z = pk2(u1[0], u1[1]); pw.w = pk2(u1[2], u1[3]);
            uf[ks] = __builtin_bit_cast(bf16x8, pw); }
#pragma unroll
        for (int nt = 0; nt < 4; ++nt) {
            f32x4 ga = {0.f, 0.f, 0.f, 0.f}, gx = ga, ud = ga;
#pragma unroll
            for (int ks = 0; ks < 2; ++ks) {
                const bf16x8 wa = *(const bf16x8*)(lwa + nt * 1024 + 32 * ks), wx = *(const bf16x8*)(lwx + nt * 1024 + 32 * ks);
                bf16x8 idf;
#pragma unroll
                for (int j = 0; j < 8; ++j) idf[j] = (32 * ks + j == 16 * nt + idt) ? (short)0x3F80 : (short)0;
                ga = MFMA16(uf[ks], wa, ga); gx = MFMA16(uf[ks], wx, gx); ud = MFMA16(uf[ks], idf, ud);
            }
            float av[4], bv[4];
#pragma unroll
            for (int j = 0; j < 4; ++j) {
                const float r = frcp(1.f + __expf(-(ga[j] + ba[nt]))), ii = frcp(1.f + __expf(-(gx[j] + bx[nt])));
                const float la = -8.0f * r * spc[nt];
                av[j] = __expf(la); bv[j] = sqrtf(neg_expm1(2.0f * la)) * ii * ud[j];
            }
            float Pj[4], Hj[4];
#pragma unroll
            for (int jj = 0; jj < 4; ++jj) { const int j = DIR ? 3 - jj : jj;
                if (jj == 0) { Pj[0] = av[j]; Hj[0] = bv[j]; } else { Pj[jj] = Pj[jj - 1] * av[j]; Hj[jj] = av[j] * Hj[jj - 1] + bv[j]; } }
            float Ai = Pj[3], Hi = Hj[3];
            { const float A1 = __shfl(Ai, srcm), H1 = __shfl(Hi, srcm); if (gg >= 1) { Hi = Ai * H1 + Hi; Ai = Ai * A1; } }
            { const float A2 = __shfl(Ai, srcm2), H2 = __shfl(Hi, srcm2); if (gg >= 2) { Hi = Ai * H2 + Hi; Ai = Ai * A2; } }
            float Ae = __shfl(Ai, srcm), He = __shfl(Hi, srcm); if (gg == 0) { Ae = 1.f; He = 0.f; }
            const float At = __shfl(Ai, srct), Ht = __shfl(Hi, srct);
            const float cin = Ae * carry[nt] + He;
            if (WRITE) {
#pragma unroll
                for (int jj = 0; jj < 4; ++jj) { const int j = DIR ? 3 - jj : jj; const float hv = Hj[jj] + Pj[jj] * cin;
                    const size_t row = (size_t)(rowbase + tt + 4 * g + j); const int ch = n * 64 + 16 * nt + c16;
                    if (DIR == 0) HT[row * 512 + ch] = hv;
                    else { bf16_t* gp = P + row * PW + C_GB + ch; const float gbv = bf2f(*gp); const float y = HT[row * 512 + ch] + hv;
                        const float z = 0.7978845608028654f * (gbv + 0.044715f * gbv * gbv * gbv); const float th = 1.f - 2.f * frcp(1.f + __expf(2.f * z));
                        const float ge = 0.5f * gbv * (1.f + th); if (!dry) *gp = (bf16_t)(pk2(y * ge, 0.f) & 0xffff); } }
            }
            carry[nt] = At * carry[nt] + Ht; arun[nt] *= At;
        }
    }
}
__device__ __forceinline__ void lru_pass1_item(const KArgs& a, int l, int item, int lane) {
    const int dir = item & 1, n = (item >> 1) & 7, rest = item >> 4, sp = rest % 66, b = rest / 66;
    float carry[4] = {0.f, 0.f, 0.f, 0.f}, arun[4] = {1.f, 1.f, 1.f, 1.f};
    if (dir) lru_sweep<1, false>(a, l, b, n, sp, carry, arun, lane); else lru_sweep<0, false>(a, l, b, n, sp, carry, arun, lane);
    float* SUM = (float*)(a.ws + WS_SUM);
    if (lane < 16) {
#pragma unroll
        for (int nt = 0; nt < 4; ++nt) { float* p = SUM + ((size_t)((b * 66 + sp) * 2 + dir) * 512 + n * 64 + 16 * nt + lane) * 2; p[0] = arun[nt]; p[1] = carry[nt]; }
    }
}
__device__ __forceinline__ void lru_fold(const float* SUM, int b, int p, int dir, int n, int c16, float (&carry)[4]) {
#pragma unroll
    for (int nt = 0; nt < 4; ++nt) { const float* q = SUM + ((size_t)((b * 66 + p) * 2 + dir) * 512 + n * 64 + 16 * nt + c16) * 2; carry[nt] = q[0] * carry[nt] + q[1]; }
}
__device__ __forceinline__ void lru_pass2_item(const KArgs& a, int l, int item, int lane, bool dry) {
    const int n = item & 7, rest = item >> 3, sp = rest % 66, b = rest / 66; const int c16 = lane & 15;
    const float* SUM = (const float*)(a.ws + WS_SUM);
    float carry[4] = {0.f, 0.f, 0.f, 0.f}, arun[4] = {1.f, 1.f, 1.f, 1.f};
    if (sp < 64) { lru_fold(SUM, b, 64, 0, n, c16, carry); lru_fold(SUM, b, 65, 0, n, c16, carry); for (int p = 0; p < sp; ++p) lru_fold(SUM, b, p, 0, n, c16, carry); }
    else if (sp == 65) lru_fold(SUM, b, 64, 0, n, c16, carry);
    lru_sweep<0, true>(a, l, b, n, sp, carry, arun, lane);
#pragma unroll
    for (int nt = 0; nt < 4; ++nt) carry[nt] = 0.f;
    if (sp < 64) { lru_fold(SUM, b, 65, 1, n, c16, carry); lru_fold(SUM, b, 64, 1, n, c16, carry); for (int p = 63; p > sp; --p) lru_fold(SUM, b, p, 1, n, c16, carry); }
    else if (sp == 64) lru_fold(SUM, b, 65, 1, n, c16, carry);
    lru_sweep<1, true>(a, l, b, n, sp, carry, arun, lane, dry);
}


#define XB_TMO      128
#define XB_XCNT(j)  (256  + 64 * (j))
#define XB_XSUB(j)  (1280 + 64 * (j))
#define XB_XGEN(j)  (2304 + 64 * (j))
#define XB_TOP      3328
#define XB_TOPGEN   3392
#define XCD_BAR_WORDS 3456
#define XB_SPIN_CAP (1u << 18)
__device__ __forceinline__ unsigned xb_ld(unsigned* p)              { return __hip_atomic_load(p, __ATOMIC_RELAXED, __HIP_MEMORY_SCOPE_AGENT); }
__device__ __forceinline__ unsigned xb_add(unsigned* p, unsigned v) { return __hip_atomic_fetch_add(p, v, __ATOMIC_RELAXED, __HIP_MEMORY_SCOPE_AGENT); }
__device__ __forceinline__ unsigned xb_xcc_id() { return (unsigned)__builtin_amdgcn_s_getreg((3 << 11) | 20) & 0xFu; }
#define XB_SPIN(cond, bar) do { unsigned _sp = 0; while (cond) { __builtin_amdgcn_s_sleep(1); \
    if ((++_sp & 255u) == 0u) { if (xb_ld(&(bar)[XB_TMO])) break; if (_sp > XB_SPIN_CAP) { atomicAdd(&(bar)[XB_TMO], 1u); break; } } } } while (0)
struct XcdBarrier { unsigned* bar; unsigned x; volatile LAS unsigned* st; };
__device__ __forceinline__ XcdBarrier xcd_barrier_post(unsigned* bar, volatile LAS unsigned* st) {
    XcdBarrier b; b.bar = bar; b.x = xb_xcc_id(); b.st = st;
    if (threadIdx.x == 0) (void)xb_add(&bar[XB_XCNT(b.x)], 1u);
    return b;
}
__device__ __forceinline__ void xcd_barrier_complete(unsigned* bar, unsigned x, unsigned& nloc, unsigned& nx) {
    const unsigned G = gridDim.x * gridDim.y * gridDim.z;
    unsigned sum, cnt, mine, sp = 0u;
    for (;;) {
        sum = 0u; cnt = 0u; mine = 0u;
#pragma unroll
        for (unsigned j = 0; j < 16; ++j) { const unsigned c = xb_ld(&bar[XB_XCNT(j)]); sum += c; cnt += (c > 0u) ? 1u : 0u; mine = (j == x) ? c : mine; }
        if (sum == G) break;
        __builtin_amdgcn_s_sleep(1);
        if ((++sp & 255u) == 0u) { if (xb_ld(&bar[XB_TMO])) break; if (sp > XB_SPIN_CAP) { atomicAdd(&bar[XB_TMO], 1u); break; } }
    }
    nloc = mine > 0u ? mine : 1u; nx = cnt > 0u ? cnt : 1u;
}
__device__ __forceinline__ void xcd_barrier(const XcdBarrier& b) {
    asm volatile("s_waitcnt vmcnt(0)" ::: "memory");
    __syncthreads();
    if (threadIdx.x == 0) {
        unsigned* bar = b.bar;
        __builtin_amdgcn_s_waitcnt(0);
        unsigned nloc = b.st[0], nx = b.st[1];
        if (nloc == 0u) { xcd_barrier_complete(bar, b.x, nloc, nx); b.st[0] = nloc; b.st[1] = nx; }
        const unsigned old = xb_add(&bar[XB_XSUB(b.x)], 1u);
        const unsigned gen = old / nloc;
        if (old + 1u == (gen + 1u) * nloc) {
            __builtin_amdgcn_fence(__ATOMIC_RELEASE, "agent");
            asm volatile("s_waitcnt vmcnt(0)" ::: "memory");
            const unsigned og = xb_add(&bar[XB_TOP], 1u);
            const unsigned tg = og / nx;
            if (og + 1u == (tg + 1u) * nx) xb_add(&bar[XB_TOPGEN], 1u);
            else XB_SPIN(xb_ld(&bar[XB_TOPGEN]) == tg, bar);
            __builtin_amdgcn_fence(__ATOMIC_ACQUIRE, "agent");
            xb_add(&bar[XB_XGEN(b.x)], 1u);
            asm volatile("s_waitcnt vmcnt(0)" ::: "memory");
        } else {
            XB_SPIN(xb_ld(&bar[XB_XGEN(b.x)]) == gen, bar);
            __builtin_amdgcn_fence(__ATOMIC_ACQUIRE, "agent");
            asm volatile("s_waitcnt vmcnt(0)" ::: "memory");
        }
    }
    __syncthreads();
}

__global__ void __launch_bounds__(512, 2) fwd_kernel(KArgs a) {
    extern __shared__ __attribute__((aligned(16))) unsigned char smem[];
    LAS unsigned char* lds = (LAS unsigned char*)smem;
    cg::grid_group grid = cg::this_grid();
    const int G = gridDim.x, NGW = G * 8;
    const int wave = __builtin_amdgcn_readfirstlane(threadIdx.x >> 6);
    volatile LAS unsigned* bst = (volatile LAS unsigned*)(lds + 131072);
    if (threadIdx.x < 2) bst[threadIdx.x] = 0u;
    __syncthreads();
    XcdBarrier xbar; xbar.bar = (unsigned*)(a.ws + WS_BAR); xbar.x = 0; xbar.st = bst;
    if (a.ph_hi - a.ph_lo > 1) xbar = xcd_barrier_post((unsigned*)(a.ws + WS_BAR), bst);
    for (int ph = a.ph_lo; ph < a.ph_hi; ++ph) {
        bf16_t* P = (bf16_t*)(a.ws + WS_P); bf16_t* H = (bf16_t*)(a.ws + WS_H); bf16_t* WB = (bf16_t*)(a.ws + WS_WB);
        float* XC = (float*)(a.ws + WS_XC);
        int lane = lane_id_asm(); const int gw = blockIdx.x * 8 + wave;
        if (ph == 0) phase0(a, lds, gw, NGW, wave, lane);
        else if (ph == 37) final_norm(a, gw, NGW, lane);
        else {
            const int l = (ph - 1) / 9, k = (ph - 1) % 9; const bool lastl = (l == NL - 1); const int Mrows = lastl ? ML : MT;
            const float* modl = (const float*)(a.ws + WS_MOD) + (size_t)l * 5 * 6144;
            const int reps = ((PROBE_MASK >> k) & 1) ? 2 : 1;
            for (int rep = 0; rep < reps; ++rep) { const bool dry = (rep + 1 < reps);
            if (rep) { xcd_barrier(xbar); lane = lane_id_asm(); }
            if (k == 0) {
                norm_phase(a, l, false, MT, gw, NGW, lane);
                if (l > 0) convert_stage_a(a, l, gw, NGW, (LAS float*)(lds + wave * 8448), lane);
            } else if (k == 1) {
                pg8::Gemm g{H, WB, 1}; pg8::Order So; So.init(MT, WIN, G, blockIdx.x, 1);
                EpiIn E{P, (bf16_t*)(a.ws + WS_VTA), (bf16_t*)(a.ws + WS_VTS)};
                #ifndef NO_EPIIN
                pg8::gemm_phase<EpiIn, D, D, D>(lds, g, So, E, wave);
#endif
            } else if (k == 2) {
                convert_stage_b(a, l, gw, NGW, (LAS float*)(lds + wave * 8448), lane);
                rope_k_phase(a, gw, NGW, lane, dry);
                constexpr int N1 = NB * 66 * 8 * 2, N2 = N1 + NB * 128 * 8 * 4 / 2, N3 = N2 + NB * 8 * 16;
                unsigned* ctr = (unsigned*)(a.ws + WS_BAR) + 8 * (2 * l + 0 + 2 * NL * rep);
                for (;;) {
                    int it = 0; if (lane == 0) it = (int)__hip_atomic_fetch_add(ctr, 1u, __ATOMIC_RELAXED, __HIP_MEMORY_SCOPE_AGENT);
                    it = __builtin_amdgcn_readfirstlane(it);
                    if (it >= (lastl ? N2 : N3)) break;
                    if (it < N1) lru_pass1_item(a, l, it, lane);
                    else if (it < N2) { na_item(a, l, 2 * (it - N1), lane, dry); na_item(a, l, 2 * (it - N1) + 1, lane, dry); }
                    else ctx_item(a, l, it - N2, false, lane, dry);
                }
            } else if (k == 3) {
                constexpr int N1 = NB * 66 * 8, N2 = N1 + NB * 4 * 512, N3 = N2 + NB * 8 * 16;
                unsigned* ctr = (unsigned*)(a.ws + WS_BAR) + 8 * (2 * l + 1 + 2 * NL * rep);
                for (;;) {
                    int it = 0; if (lane == 0) it = (int)__hip_atomic_fetch_add(ctr, 1u, __ATOMIC_RELAXED, __HIP_MEMORY_SCOPE_AGENT);
                    it = __builtin_amdgcn_readfirstlane(it);
                    if (it >= (lastl ? N2 : N3)) break;
                    if (it < N1) lru_pass2_item(a, l, it, lane, dry);
                    else if (it < N2) swa_item(a, l, it - N1, lane, dry);
                    else ctx_item(a, l, it - N2, true, lane, dry);
                }
            } else if (k == 4) {
                pg8::Gemm g{P, WB + WB_BR, 3}; pg8::Order So; So.init(Mrows, D, G, blockIdx.x, 3);
                EpiMerge E{P, H};
                #ifndef NO_EPIMERGE
                pg8::gemm_phase<EpiMerge, PW, 512, 512, C_QA, C_GB, C_QS, 524288>(lds, g, So, E, wave);
#endif
            } else if (k == 5) {
                pg8::Gemm g{H, WB + WB_OUT, 1}; pg8::Order So; So.init(Mrows, D, G, blockIdx.x, 1);
                EpiRes E{a.out, XC, modl, 2, dry};
#ifndef NO_EPIRES
                pg8::gemm_phase<EpiRes, D, D, D>(lds, g, So, E, wave);
#endif
            } else if (k == 8) {
                pg8::Gemm g{P, WB + WB_FF2, 1}; pg8::Order So; So.init(Mrows, D, G, blockIdx.x, 1);
                EpiRes E{a.out, XC, modl, 5, dry};
#ifndef NO_EPIRES
                pg8::gemm_phase<EpiRes, DFF, DFF, DFF>(lds, g, So, E, wave);
#endif
            } else if (k == 6) {
                norm_phase(a, l, true, Mrows, gw, NGW, lane);
            } else if (k == 7) {
                pg8::Gemm g{H, WB + WB_FF1, 1}; pg8::Order So; So.init(Mrows, DFF, G, blockIdx.x, 1);
                EpiFF1 E{P};
                #ifndef NO_EPIFF1
                pg8::gemm_phase<EpiFF1, D, D, D>(lds, g, So, E, wave);
#endif
            }
            }
        }
        if (ph + 1 < a.ph_hi) { if (ph == 0 || !USE_XCD_BAR) { __syncthreads(); grid.sync(); } else xcd_barrier(xbar); if ((PROBE_MASK >> 9) & 1) xcd_barrier(xbar); }
    }
}

extern "C" void kernel_launch(void* const* d_in, const int* in_sizes, int n_in, void* d_out, int out_size, void* d_ws, size_t ws_size, hipStream_t stream) {
    static int grid = 0;
    if (grid == 0) {
        if (n_in != 23 || ws_size < WS_END) { fprintf(stderr, "kernel_launch: unexpected n_in %d or ws_size %zu (< %zu)\n", n_in, ws_size, (size_t)WS_END); grid = -1; return; }
        int dev = 0, cus = 0, per_cu = 0;
        hipGetDevice(&dev); hipDeviceGetAttribute(&cus, hipDeviceAttributeMultiprocessorCount, dev);
        if (hipFuncSetAttribute((const void*)fwd_kernel, hipFuncAttributeMaxDynamicSharedMemorySize, LDS_BYTES) != hipSuccess) { fprintf(stderr, "hipFuncSetAttribute failed\n"); grid = -1; return; }
        if (hipOccupancyMaxActiveBlocksPerMultiprocessor(&per_cu, (const void*)fwd_kernel, 512, LDS_BYTES) != hipSuccess || per_cu < 1) { fprintf(stderr, "occupancy query: %d\n", per_cu); per_cu = 1; }
        (void)hipGetLastError();
        grid = cus;
    }
    if (grid < 0) return;
    KArgs a{};
    const float** f = (const float**)&a;
    for (int i = 0; i < 23; ++i) f[i] = (const float*)d_in[i];
    a.out = (float*)d_out; a.ws = (unsigned char*)d_ws;
#if N_LAUNCHES == 1
    a.ph_lo = 0; a.ph_hi = 38;
    if (hipMemsetAsync((unsigned char*)d_ws + WS_BAR, 0, XCD_BAR_WORDS * 4, stream) != hipSuccess) { fprintf(stderr, "memset failed\n"); return; }
    void* args[] = {&a};
    hipError_t e = hipLaunchCooperativeKernel((const void*)fwd_kernel, dim3(grid), dim3(512), args, LDS_BYTES, stream);
    if (e != hipSuccess) fprintf(stderr, "cooperative launch failed: %s (grid %d)\n", hipGetErrorString(e), grid);
#else
    for (int ph = 0; ph < 38; ++ph) { a.ph_lo = ph; a.ph_hi = ph + 1; hipLaunchKernelGGL(fwd_kernel, dim3(grid), dim3(512), LDS_BYTES, stream, a); }
#endif
}
```

```cpp
#include <hip/hip_runtime.h>
#include <hip/hip_cooperative_groups.h>
#include <cstdio>
#include <cstdint>
namespace cg = cooperative_groups;

#ifndef N_LAUNCHES
#define N_LAUNCHES 1
#endif

#ifndef USE_XCD_BAR
#define USE_XCD_BAR 1
#endif
#ifndef PROBE_MASK
#define PROBE_MASK 0
#endif
#define LAS __attribute__((address_space(3)))
typedef unsigned short bf16_t;
typedef short bf16x8 __attribute__((ext_vector_type(8)));
typedef short s16x4 __attribute__((ext_vector_type(4)));
typedef float f32x4 __attribute__((ext_vector_type(4)));
typedef unsigned u32x4 __attribute__((ext_vector_type(4)));
typedef unsigned u32x2 __attribute__((ext_vector_type(2)));

constexpr int D = 1024, NB = 4, S = 8192, CTX = 256, ML = NB * S, MC = NB * CTX, MT = ML + MC, NL = 4, DFF = 4096;
constexpr int PW = 5760;
constexpr int C_QA = 0, C_KA = 512, C_XB = 1024, C_GB = 1536, C_QS = 2048, C_KS = 2560, C_GA = 2688, C_GR = 3712, C_GS = 4736;
constexpr int VTOK = 8448;
constexpr int WIN = 6400;
constexpr size_t MiB = 1u << 20;
constexpr size_t WS_XC = 0, WS_H = 4 * MiB, WS_P = 70 * MiB, WS_VTA = WS_P + (size_t)MT * PW * 2, WS_VTS = WS_VTA + (size_t)NB * 8 * 64 * VTOK * 2,
                 WS_WB = WS_VTS + (size_t)NB * 2 * 64 * VTOK * 2, WS_MOD = WS_WB + 21 * MiB, WS_SUM = WS_MOD + MiB / 2, WS_LW = WS_SUM + 5 * MiB / 2, WS_BAR = WS_LW + MiB, WS_PART = WS_P + 264 * MiB, WS_END = WS_BAR + 16384;
constexpr int WB_BR = 0, WB_OUT = 3 * 524288, WB_FF1 = WB_OUT + 1048576, WB_FF2 = WB_FF1 + 4194304;
constexpr int LDS_BYTES = 131072 + 64;
constexpr float LOG2E = 1.4426950408889634f;
constexpr float NEGBIG = -3.0e38f;

struct KArgs {
    const float *x, *c, *ctx, *c_ctx, *w_mod, *b_mod, *norm1_g, *norm2_g, *w_in, *na_rpb, *conv_w, *conv_b, *lru_wa, *lru_ba, *lru_wx, *lru_bx, *lru_lambda,
        *swa_sink, *w_branch, *w_out, *w_ff1, *w_ff2, *final_g;
    float* out; unsigned char* ws; int ph_lo, ph_hi;
};

typedef __bf16 bf16x2_t __attribute__((ext_vector_type(2)));
typedef float f32x2_t __attribute__((ext_vector_type(2)));
__device__ __forceinline__ unsigned pk2(float lo, float hi) { f32x2_t v = {lo, hi}; bf16x2_t r = __builtin_convertvector(v, bf16x2_t); return __builtin_bit_cast(unsigned, r); }
__device__ __forceinline__ float bf2f(unsigned short b) { return __uint_as_float(((unsigned)b) << 16); }
__device__ __forceinline__ float bflo(unsigned w) { return __uint_as_float(w << 16); }
__device__ __forceinline__ float bfhi(unsigned w) { return __uint_as_float(w & 0xffff0000u); }
__device__ __forceinline__ float fexp2(float x) { return __builtin_amdgcn_exp2f(x); }
__device__ __forceinline__ float frcp(float x) { return __builtin_amdgcn_rcpf(x); }
__device__ __forceinline__ int lane_id_asm() { int l; asm volatile("v_mbcnt_lo_u32_b32 %0, -1, 0\n\tv_mbcnt_hi_u32_b32 %0, -1, %0" : "=v"(l)); return l; }
__device__ __forceinline__ float wave_sum(float v) {
#pragma unroll
    for (int o = 1; o < 64; o <<= 1) v += __shfl_xor(v, o);
    return v;
}
#define MFMA16(a, b, c) __builtin_amdgcn_mfma_f32_16x16x32_bf16((a), (b), (c), 0, 0, 0)

namespace pg8 {
constexpr int BM = 256, BK = 64, HALF = 128, HTB = HALF * BK * 2, STAGE_BYTES = 8 * HTB, NXCD = 8, WGM = 8;
__host__ __device__ __forceinline__ int lds_byte(int r, int c) { const int st = (r >> 4) * 2 + (c >> 5), rr = r & 15, cc = c & 31, ob = rr * 64 + cc * 2; return st * 1024 + (ob ^ (((ob >> 9) & 1) << 5)); }
__host__ __device__ __forceinline__ void stage_rc(int b, int& R, int& C) { const int st = b / 1024, sb = b % 1024, swz = sb ^ (((sb >> 9) & 1) << 5); R = (st >> 1) * 16 + swz / 64; C = (st & 1) * 32 + (swz % 64) / 2; }
__host__ __device__ __forceinline__ int perm32(int rho) { const int n = rho >> 4, i = rho & 15; return 8 * (i >> 2) + 4 * n + (i & 3); }

struct Unit { int pm, pn, sub, koff, nt, split, ks; };
struct Gemm { const bf16_t* A; const bf16_t* Bt; int nsub; };
struct Order {
    int nM, nN, nwg, G, c, nsub, ntK;
    int xM, KS;
    __device__ void init(int M, int N, int G_, int c_, int nsub_, int K, int xM_ = 0, int KS_ = 1) { nM = M / BM; nN = N / BM; nwg = nM * nN; G = G_; c = c_; nsub = nsub_; ntK = K / BK; xM = xM_; KS = KS_; }
    __device__ bool next(int i, Unit& u) const {
        const int ti = i / nsub; u.sub = i - ti * nsub; u.koff = 0; u.nt = ntK; u.split = 0; u.ks = 0;
        const long L = (long)ti * G + c;
        if (L >= nwg) {
            const int idx = (int)(L - nwg); if (idx >= xM * nN * KS) return false;
            const int t = idx / KS, ks = idx - t * KS; u.pm = nM + t / nN; u.pn = t % nN; u.nt = ntK / KS; u.koff = ks * u.nt * BK; u.split = 1; u.ks = ks; return true;
        }
        int wgid = (int)L; { const int q = nwg / NXCD, r = nwg % NXCD, xcd = wgid % NXCD, off = wgid / NXCD; wgid = (xcd < r ? xcd * (q + 1) : r * (q + 1) + (xcd - r) * q) + off; }
        const int nig = WGM * nN, gid = wgid / nig, fm = gid * WGM, gsz = (nM - fm) < WGM ? (nM - fm) : WGM;
        u.pm = fm + ((wgid % nig) % gsz); u.pn = (wgid % nig) / gsz; return true;
    }
};

template <class Epi, int LDA, int LDB, int K, int A0 = 0, int A1 = 0, int A2 = 0, int BS = 0>
__device__ __forceinline__ void gemm_phase(LAS unsigned char* lds, const Gemm g, const Order& S, const Epi& E, int wid) {
    const int lane = lane_id_asm(), tid = wid * 64 + lane, wr = wid >> 2, wc = wid & 3, fr = lane & 15, fq = lane >> 4;
    unsigned voffA[2], voffB[2];
#pragma unroll
    for (int i = 0; i < 2; ++i) { int R, C; stage_rc(tid * 16 + i * 8192, R, C); const int Rb = Epi::PERM ? ((R & ~31) + perm32(R & 31)) : R;
        voffA[i] = (unsigned)(R * LDA + C) * 2u; voffB[i] = (unsigned)(Rb * LDB + C) * 2u; }
    constexpr size_t kstep = (size_t)(BK * 2);
    constexpr size_t hstepA = (size_t)HALF * LDA * 2, hstepB = (size_t)HALF * LDB * 2;
    constexpr size_t tstepA = 2 * hstepA, tstepB = 2 * hstepB;
    const unsigned ldsw = (unsigned)wid * 1024u;
    const int aoff = lds_byte(wr * 64 + fr, fq * 8), boff = lds_byte(wc * 32 + fr, fq * 8);
#define PG8_SA(b, h) (((b) * 2 + (h)) * HTB)
#define PG8_SB(b, h) ((4 + (b) * 2 + (h)) * HTB)
#define PG8_STAGE(bufoff, gbase, voff) do { _Pragma("unroll") for (int _i = 0; _i < 2; ++_i) \
        __builtin_amdgcn_global_load_lds((const unsigned*)((const char*)(gbase) + (voff)[_i]), (LAS unsigned*)(lds + (bufoff) + ldsw + _i * 8192), 16, 0, 0); } while (0)
#define PG8_LDA(dst, b, h) do { _Pragma("unroll") for (int m = 0; m < 4; ++m) _Pragma("unroll") for (int k = 0; k < 2; ++k) dst[m][k] = *(const LAS bf16x8*)(lds + PG8_SA(b, h) + aoff + m * 2048 + k * 1024); } while (0)
#define PG8_LDB(dst, b, h) do { _Pragma("unroll") for (int n = 0; n < 2; ++n) _Pragma("unroll") for (int k = 0; k < 2; ++k) dst[n][k] = *(const LAS bf16x8*)(lds + PG8_SB(b, h) + boff + n * 2048 + k * 1024); } while (0)
#define PG8_MMA(ai, bj, At, Bt) do { __builtin_amdgcn_s_setprio(1); _Pragma("unroll") for (int m = 0; m < 4; ++m) _Pragma("unroll") for (int n = 0; n < 2; ++n) _Pragma("unroll") for (int k = 0; k < 2; ++k) \
        acc[ai][bj][m][n] = __builtin_amdgcn_mfma_f32_16x16x32_bf16(Bt[n][k], At[m][k], acc[ai][bj][m][n], 0, 0, 0); __builtin_amdgcn_s_setprio(0); } while (0)
#define PG8_WAIT_V(n) asm volatile("s_waitcnt vmcnt(" #n ")" ::: "memory")
#define PG8_WAIT_L(n) asm volatile("s_waitcnt lgkmcnt(" #n ")" ::: "memory")
#define PG8_BAR __builtin_amdgcn_s_barrier()
#define PG8_SCHED __builtin_amdgcn_sched_barrier(0)
    Unit cur, nxt; int ui = 0;
    if (!S.next(0, cur)) return;
    f32x4 acc[2][2][4][2];
#pragma unroll
    for (int a = 0; a < 2; ++a)
#pragma unroll
        for (int b = 0; b < 2; ++b)
#pragma unroll
            for (int m = 0; m < 4; ++m)
#pragma unroll
                for (int n = 0; n < 2; ++n) acc[a][b][m][n] = (f32x4){0.f, 0.f, 0.f, 0.f};
    bf16x8 At[4][2], B0[2][2], B1[2][2];
    const char* cA = (const char*)(g.A + (cur.sub == 0 ? A0 : (cur.sub == 1 ? A1 : A2)) + cur.koff) + (size_t)cur.pm * tstepA; const char* cB = (const char*)(g.Bt + (cur.sub * BS) + cur.koff) + (size_t)cur.pn * tstepB;
    PG8_STAGE(PG8_SB(0, 0), cB, voffB); PG8_STAGE(PG8_SA(0, 0), cA, voffA); PG8_STAGE(PG8_SB(0, 1), cB + hstepB, voffB); PG8_STAGE(PG8_SA(0, 1), cA + hstepA, voffA);
    if (wr == 1) PG8_BAR;
    PG8_WAIT_V(4); PG8_BAR;
    PG8_STAGE(PG8_SB(1, 0), cB + kstep, voffB); PG8_STAGE(PG8_SA(1, 0), cA + kstep, voffA); PG8_STAGE(PG8_SB(1, 1), cB + hstepB + kstep, voffB);
    PG8_WAIT_V(6); PG8_BAR;
    for (;;) {
        const bool has_next = S.next(ui + 1, nxt);
        const char* nA = has_next ? (const char*)(g.A + (nxt.sub == 0 ? A0 : (nxt.sub == 1 ? A1 : A2)) + nxt.koff) + (size_t)nxt.pm * tstepA : cA; const char* nB = has_next ? (const char*)(g.Bt + (nxt.sub * BS) + nxt.koff) + (size_t)nxt.pn * tstepB : cB;
        const int nt = cur.nt;
        for (int t = 0; t < nt; t += 2) {
            const bool last = (t == nt - 2);
            const char* a1 = cA + (size_t)(t + 1) * kstep;
            const char* a2 = last ? nA : cA + (size_t)(t + 2) * kstep; const char* b2 = last ? nB : cB + (size_t)(t + 2) * kstep;
            const char* a3 = a2 + kstep; const char* b3 = b2 + kstep;
            PG8_LDB(B0, 0, 0); PG8_SCHED; PG8_LDA(At, 0, 0); PG8_STAGE(PG8_SA(1, 1), a1 + hstepA, voffA);
            PG8_WAIT_L(8); PG8_BAR; PG8_WAIT_L(0); PG8_MMA(0, 0, At, B0); PG8_BAR; PG8_SCHED;
            PG8_LDB(B1, 0, 1); PG8_STAGE(PG8_SB(0, 0), b2, voffB);
            PG8_BAR; PG8_WAIT_L(0); PG8_MMA(0, 1, At, B1); PG8_BAR;
            PG8_LDA(At, 0, 1); PG8_STAGE(PG8_SA(0, 0), a2, voffA);
            PG8_BAR; PG8_WAIT_L(0); PG8_MMA(1, 0, At, B0); PG8_BAR; PG8_SCHED;
            PG8_STAGE(PG8_SB(0, 1), b2 + hstepB, voffB);
            PG8_WAIT_V(6); PG8_BAR; PG8_MMA(1, 1, At, B1); PG8_BAR;
            PG8_LDB(B0, 1, 0); PG8_SCHED; PG8_LDA(At, 1, 0); PG8_STAGE(PG8_SA(0, 1), a2 + hstepA, voffA);
            PG8_WAIT_L(8); PG8_BAR; PG8_WAIT_L(0); PG8_MMA(0, 0, At, B0); PG8_BAR; PG8_SCHED;
            PG8_LDB(B1, 1, 1); PG8_STAGE(PG8_SB(1, 0), b3, voffB);
            PG8_BAR; PG8_WAIT_L(0); PG8_MMA(0, 1, At, B1); PG8_BAR;
            PG8_LDA(At, 1, 1); PG8_STAGE(PG8_SA(1, 0), a3, voffA);
            PG8_BAR; PG8_WAIT_L(0); PG8_MMA(1, 0, At, B0); PG8_BAR; PG8_SCHED;
            PG8_STAGE(PG8_SB(1, 1), b3 + hstepB, voffB);
            PG8_WAIT_V(6); PG8_BAR; PG8_MMA(1, 1, At, B1); PG8_BAR;
        }
        E(acc, cur, wr, wc, fr, fq);
        if (!has_next) break;
        if (!(Epi::KEEP && cur.sub + 1 < g.nsub)) {
#pragma unroll
            for (int a = 0; a < 2; ++a)
#pragma unroll
                for (int b = 0; b < 2; ++b)
#pragma unroll
                    for (int m = 0; m < 4; ++m)
#pragma unroll
                        for (int n = 0; n < 2; ++n) acc[a][b][m][n] = (f32x4){0.f, 0.f, 0.f, 0.f};
        }
        cur = nxt; cA = nA; cB = nB; ++ui;
    }
    PG8_WAIT_V(0);
    if (wr == 0) PG8_BAR;
    PG8_BAR;
#undef PG8_SA
#undef PG8_SB
#undef PG8_STAGE
#undef PG8_LDA
#undef PG8_LDB
#undef PG8_MMA
#undef PG8_WAIT_V
#undef PG8_WAIT_L
#undef PG8_BAR
#undef PG8_SCHED
}
}

typedef f32x4 AccT[2][2][4][2];
struct EpiIn {
    static constexpr bool PERM = true, KEEP = false;
    bf16_t* P; bf16_t* VTa; bf16_t* VTs;
    __device__ __forceinline__ void operator()(AccT& acc, const pg8::Unit& u, int wr, int wc, int fr, int fq) const {
        const int row0 = u.pm * 256 + wr * 64 + fr, trow = u.pm * 256;
        int b, tokbase; if (trow < ML) { b = trow >> 13; tokbase = trow & 8191; } else { b = (trow - ML) >> 8; tokbase = 8192; }
#pragma unroll
        for (int bj = 0; bj < 2; ++bj) {
            int pc = -1;
            if (u.pn < 10) pc = 256 * u.pn + 128 * bj; else if (u.pn == 10) { if (bj == 0) pc = 2560; } else if (u.pn >= 13) pc = 2688 + 256 * (u.pn - 13) + 128 * bj;
            if (pc >= 0) {
#pragma unroll
                for (int ai = 0; ai < 2; ++ai)
#pragma unroll
                    for (int m = 0; m < 4; ++m) { bf16_t* rowp = P + (size_t)(row0 + ai * 128 + m * 16) * PW + pc + wc * 32 + 8 * fq;
                        const f32x4 v0 = acc[ai][bj][m][0], v1 = acc[ai][bj][m][1];
                        u32x4 w; w.x = pk2(v0[0], v0[1]); w.y = pk2(v0[2], v0[3]); w.z = pk2(v1[0], v1[1]); w.w = pk2(v1[2], v1[3]);
                        *(u32x4*)rowp = w; }
            } else {
                const bool isS = (u.pn == 10); bf16_t* VT = isS ? VTs : VTa; const int nh = isS ? 2 : 8;
                const int cl = (isS ? 0 : 256 * (u.pn - 11) + 128 * bj) + 32 * wc + 8 * fq;
#pragma unroll
                for (int ai = 0; ai < 2; ++ai)
#pragma unroll
                    for (int m = 0; m < 4; ++m) { const int tok = tokbase + wr * 64 + fr + ai * 128 + m * 16;
#pragma unroll
                        for (int n = 0; n < 2; ++n) { const f32x4 v = acc[ai][bj][m][n]; const unsigned w0 = pk2(v[0], v[1]), w1 = pk2(v[2], v[3]);
                            const int c = cl + 4 * n; bf16_t* base = VT + ((size_t)(b * nh + (c >> 6)) * 64 + (c & 63)) * VTOK + tok;
                            base[0] = (bf16_t)(w0 & 0xffff); base[VTOK] = (bf16_t)(w0 >> 16); base[2 * VTOK] = (bf16_t)(w1 & 0xffff); base[3 * VTOK] = (bf16_t)(w1 >> 16); } }
            }
        }
    }
};
struct EpiMerge {
    static constexpr bool PERM = true, KEEP = true;
    const bf16_t* P; bf16_t* Mo;
    __device__ __forceinline__ void operator()(AccT& acc, const pg8::Unit& u, int wr, int wc, int fr, int fq) const {
        const int row0 = u.pm * 256 + wr * 64 + fr, col0 = u.pn * 256 + wc * 32 + 8 * fq;
        const int gc = (u.sub == 0) ? C_GA : (u.sub == 1 ? C_GR : C_GS), gn = (u.sub == 0) ? C_GR : C_GS;
        const bool lastsub = (u.sub == 2);
#pragma unroll
        for (int ai = 0; ai < 2; ++ai)
#pragma unroll
            for (int m = 0; m < 4; ++m) { const size_t row = (size_t)(row0 + ai * 128 + m * 16);
#pragma unroll
                for (int bj = 0; bj < 2; ++bj) { const int col = col0 + bj * 128;
                    const u32x4 wcur = *(const u32x4*)(P + row * PW + gc + col);
                    u32x4 wnx = wcur; if (!lastsub) wnx = *(const u32x4*)(P + row * PW + gn + col);
                    float f[8];
#pragma unroll
                    for (int q = 0; q < 4; ++q) {
                        const float c0 = bflo(wcur[q]), c1 = bfhi(wcur[q]), n0 = bflo(wnx[q]), n1 = bfhi(wnx[q]);
                        const float d0 = 1.f + fexp2(fminf(-c0 * LOG2E, 100.f)), d1 = 1.f + fexp2(fminf(-c1 * LOG2E, 100.f));
                        const float u0 = lastsub ? 1.f : 1.f + fexp2(fminf(-n0 * LOG2E, 100.f)), u1 = lastsub ? 1.f : 1.f + fexp2(fminf(-n1 * LOG2E, 100.f));
                        f[2 * q] = u0 * frcp(d0); f[2 * q + 1] = u1 * frcp(d1);
                    }
                    f32x4 v0 = acc[ai][bj][m][0], v1 = acc[ai][bj][m][1];
                    v0[0] *= f[0]; v0[1] *= f[1]; v0[2] *= f[2]; v0[3] *= f[3]; v1[0] *= f[4]; v1[1] *= f[5]; v1[2] *= f[6]; v1[3] *= f[7];
                    acc[ai][bj][m][0] = v0; acc[ai][bj][m][1] = v1;
                    if (lastsub) { u32x4 w; w.x = pk2(v0[0], v0[1]); w.y = pk2(v0[2], v0[3]); w.z = pk2(v1[0], v1[1]); w.w = pk2(v1[2], v1[3]);
                        *(u32x4*)(Mo + row * D + col) = w; }
                } }
    }
};
struct EpiRes {
    static constexpr bool PERM = false, KEEP = false;
    float* XL; float* XCp; const float* modl; int gidx; bool dry; float* PART;
    __device__ __forceinline__ void operator()(AccT& acc, const pg8::Unit& u, int wr, int wc, int fr, int fq) const {
        const int trow = u.pm * 256, row0 = trow + wr * 64 + fr, col0 = u.pn * 256 + wc * 32 + 4 * fq;
        const int v = trow < ML ? (trow >> 13) : 4;
        float* Xb = trow < ML ? XL + (size_t)row0 * D : XCp + (size_t)(row0 - ML) * D;
        f32x4 gv[2][2];
#pragma unroll
        for (int bj = 0; bj < 2; ++bj)
#pragma unroll
            for (int n = 0; n < 2; ++n) gv[bj][n] = *(const f32x4*)(modl + v * 6144 + gidx * 1024 + col0 + bj * 128 + n * 16);
#pragma unroll
        for (int ai = 0; ai < 2; ++ai)
#pragma unroll
            for (int m = 0; m < 4; ++m) { float* rowp = Xb + (size_t)(ai * 128 + m * 16) * D + col0;
#pragma unroll
                for (int bj = 0; bj < 2; ++bj)
#pragma unroll
                    for (int n = 0; n < 2; ++n) { f32x4* p = (f32x4*)(rowp + bj * 128 + n * 16);
                        if (u.split) { const f32x4 dv = gv[bj][n] * acc[ai][bj][m][n]; if (!dry) *(f32x4*)(PART + ((size_t)u.ks * MC + (row0 - ML) + ai * 128 + m * 16) * D + col0 + bj * 128 + n * 16) = dv; }
                        else { f32x4 xv = *p; xv += gv[bj][n] * acc[ai][bj][m][n]; if (!dry) *p = xv; } } }
    }
};
struct EpiFF1 {
    static constexpr bool PERM = true, KEEP = false;
    bf16_t* Hd;
    __device__ __forceinline__ void operator()(AccT& acc, const pg8::Unit& u, int wr, int wc, int fr, int fq) const {
        const int row0 = u.pm * 256 + wr * 64 + fr, col0 = u.pn * 256 + wc * 32 + 8 * fq;
#pragma unroll
        for (int ai = 0; ai < 2; ++ai)
#pragma unroll
            for (int m = 0; m < 4; ++m) { bf16_t* rowp = Hd + (size_t)(row0 + ai * 128 + m * 16) * DFF + col0;
#pragma unroll
                for (int bj = 0; bj < 2; ++bj) { f32x4 v0 = acc[ai][bj][m][0], v1 = acc[ai][bj][m][1];
#pragma unroll
                    for (int j = 0; j < 4; ++j) { const float a = fmaxf(v0[j], 0.f), b = fmaxf(v1[j], 0.f); v0[j] = a * a; v1[j] = b * b; }
                    u32x4 w; w.x = pk2(v0[0], v0[1]); w.y = pk2(v0[2], v0[3]); w.z = pk2(v1[0], v1[1]); w.w = pk2(v1[2], v1[3]);
                    *(u32x4*)(rowp + bj * 128) = w; } }
    }
};

__device__ __forceinline__ void transpose_item(const float* W, int ldn, int k0, int nsrc0, bf16_t* WT, int ldt, int ndst0, LAS float* scr, int lane) {
#pragma unroll 8
    for (int i = 0; i < 32; ++i) { const int kk = 2 * i + (lane >> 5); scr[kk * 33 + (lane & 31)] = W[(size_t)(k0 + kk) * ldn + nsrc0 + (lane & 31)]; }
    asm volatile("s_waitcnt lgkmcnt(0)" ::: "memory");
    const int c = lane & 7;
#pragma unroll
    for (int j = 0; j < 4; ++j) { const int n = (lane >> 3) + 8 * j; const LAS float* s = scr + (8 * c) * 33 + n;
        u32x4 o; o.x = pk2(s[0 * 33], s[1 * 33]); o.y = pk2(s[2 * 33], s[3 * 33]); o.z = pk2(s[4 * 33], s[5 * 33]); o.w = pk2(s[6 * 33], s[7 * 33]);
        *(u32x4*)(WT + (size_t)(ndst0 + n) * ldt + k0 + 8 * c) = o; }
    asm volatile("s_waitcnt lgkmcnt(0)" ::: "memory");
}
__device__ __forceinline__ void conv_seg(int& base, int gw, int NGW, const float* W, int K, int ldn, int nsrc0, int ncols, bf16_t* WT, int ldt, int ndst0, LAS float* scr, int lane) {
    const int nblk = ncols / 32, nitems = (K / 64) * nblk;
    int first = base + (((gw - base) % NGW) + NGW) % NGW;
    for (int it = first; it < base + nitems; it += NGW) { const int r = it - base, kb = r / nblk, nb = r - kb * nblk;
        transpose_item(W, ldn, 64 * kb, nsrc0 + 32 * nb, WT, ldt, ndst0 + 32 * nb, scr, lane); }
    base += nitems;
}
__device__ __forceinline__ void convert_stage_a(const KArgs& a, int l, int gw, int NGW, LAS float* scr, int) {
    const int lane = lane_id_asm();
    const float* W = a.w_in + (size_t)l * D * WIN; bf16_t* WT = (bf16_t*)(a.ws + WS_WB); int base = 0;
    conv_seg(base, gw, NGW, W, D, WIN, 0, 1024, WT, D, 0, scr, lane);
    conv_seg(base, gw, NGW, W, D, WIN, 1536, 1024, WT, D, 1024, scr, lane);
    conv_seg(base, gw, NGW, W, D, WIN, 2560, 512, WT, D, 2048, scr, lane);
    conv_seg(base, gw, NGW, W, D, WIN, 3072, 256, WT, D, 2560, scr, lane);
    conv_seg(base, gw, NGW, W, D, WIN, 1024, 512, WT, D, 2816, scr, lane);
    conv_seg(base, gw, NGW, W, D, WIN, 3328, 3072, WT, D, 3328, scr, lane);
}
__device__ __forceinline__ void convert_stage_b(const KArgs& a, int l, int gw, int NGW, LAS float* scr, int) {
    const int lane = lane_id_asm();
    bf16_t* WB = (bf16_t*)(a.ws + WS_WB); int base = 0;
    const float* wbr = a.w_branch + (size_t)l * 1536 * D;
    for (int i = 0; i < 3; ++i) conv_seg(base, gw, NGW, wbr + (size_t)i * 512 * D, 512, D, 0, D, WB + WB_BR + i * 524288, 512, 0, scr, lane);
    conv_seg(base, gw, NGW, a.w_out + (size_t)l * D * D, D, D, 0, D, WB + WB_OUT, D, 0, scr, lane);
    conv_seg(base, gw, NGW, a.w_ff1 + (size_t)l * D * DFF, D, DFF, 0, DFF, WB + WB_FF1, D, 0, scr, lane);
    conv_seg(base, gw, NGW, a.w_ff2 + (size_t)l * DFF * D, DFF, D, 0, D, WB + WB_FF2, DFF, 0, scr, lane);
}

__device__ __forceinline__ void phase0(const KArgs& a, LAS unsigned char* lds, int gw, int NGW, int wave, int lane) {
    LAS float* cond = (LAS float*)lds;
    LAS float* red = (LAS float*)(lds + 20480);
    const int tid = wave * 64 + lane;
    for (int i = tid; i < 5 * D; i += 512) { const int v = i >> 10, k = i & 1023; const float cv = v < 4 ? a.c[v * D + k] : a.c_ctx[k]; cond[i] = cv / (1.f + __expf(-cv)); }
    __syncthreads();
    float* mods = (float*)(a.ws + WS_MOD);
    const int col = tid & 127, kq = tid >> 7;
    for (int task = blockIdx.x; task < NL * 48; task += gridDim.x) {
        const int l = task / 48, cc = (task % 48) * 128 + col;
        const float* W = a.w_mod + (size_t)l * D * 6144 + cc;
        float s0 = 0.f, s1 = 0.f, s2 = 0.f, s3 = 0.f, s4 = 0.f;
#pragma unroll 8
        for (int k = kq * 256; k < kq * 256 + 256; ++k) { const float w = W[(size_t)k * 6144];
            s0 += w * cond[k]; s1 += w * cond[1024 + k]; s2 += w * cond[2048 + k]; s3 += w * cond[3072 + k]; s4 += w * cond[4096 + k]; }
        red[(kq * 5 + 0) * 128 + col] = s0; red[(kq * 5 + 1) * 128 + col] = s1; red[(kq * 5 + 2) * 128 + col] = s2; red[(kq * 5 + 3) * 128 + col] = s3; red[(kq * 5 + 4) * 128 + col] = s4;
        __syncthreads();
        for (int o = tid; o < 5 * 128; o += 512) { const int v = o >> 7, c2 = o & 127, ccol = (task % 48) * 128 + c2;
            const float r = red[(0 * 5 + v) * 128 + c2] + red[(1 * 5 + v) * 128 + c2] + red[(2 * 5 + v) * 128 + c2] + red[(3 * 5 + v) * 128 + c2];
            mods[((size_t)l * 5 + v) * 6144 + ccol] = r + a.b_mod[l * 6144 + ccol]; }
        __syncthreads();
    }
    __syncthreads();
    LAS float* scr = (LAS float*)(lds + 32768 + wave * 8448);
    bf16_t* LW = (bf16_t*)(a.ws + WS_LW);
    for (int it = gw; it < NL * 2 * 2 * 8 * 2; it += NGW) { const int half = it & 1, mi = it >> 1, n = mi & 7, mat = (mi >> 3) & 1, ld = mi >> 4;
        const float* W = (mat ? a.lru_wx : a.lru_wa) + ((size_t)ld * 8 + n) * 4096;
        transpose_item(W, 64, 0, 32 * half, LW + ((size_t)(ld * 2 + mat) * 8 + n) * 4096, 64, 32 * half, scr, lane); }
    convert_stage_a(a, 0, gw, NGW, scr, lane);
}

__device__ __forceinline__ void norm_phase(const KArgs& a, int l, bool second, int nrows, int gw, int NGW, int lane, int npart) {
    const bool first_read = (l == 0 && !second);
    const float* srcL = first_read ? a.x : a.out; const float* srcC = first_read ? a.ctx : (const float*)(a.ws + WS_XC);
    float* XC = (float*)(a.ws + WS_XC); bf16_t* H = (bf16_t*)(a.ws + WS_H);
    const float* g = (second ? a.norm2_g : a.norm1_g) + l * D; const float* modl = (const float*)(a.ws + WS_MOD) + (size_t)l * 5 * 6144; const int sidx = second ? 3 : 0;
    for (int row = gw; row < nrows; row += NGW) {
        const float* src = row < ML ? srcL + (size_t)row * D : srcC + (size_t)(row - ML) * D; const int v = row < ML ? (row >> 13) : 4;
        const f32x4* xr = (const f32x4*)src + lane; f32x4 xv[4]; float s = 0.f;
#pragma unroll
        for (int j = 0; j < 4; ++j) xv[j] = xr[64 * j];
        if (row >= ML && npart > 0) {
            const float* PART = (const float*)(a.ws + WS_PART);
            for (int sp = 0; sp < npart; ++sp) { const f32x4* pr = (const f32x4*)(PART + ((size_t)sp * MC + (row - ML)) * D) + lane;
#pragma unroll
                for (int j = 0; j < 4; ++j) xv[j] += pr[64 * j]; }
            f32x4* xw = (f32x4*)(XC + (size_t)(row - ML) * D) + lane;
#pragma unroll
            for (int j = 0; j < 4; ++j) xw[64 * j] = xv[j];
        }
#pragma unroll
        for (int j = 0; j < 4; ++j) s += (xv[j][0] * xv[j][0] + xv[j][1] * xv[j][1]) + (xv[j][2] * xv[j][2] + xv[j][3] * xv[j][3]);
        const float rstd = 1.0f / sqrtf(wave_sum(s) * (1.f / D) + 1e-6f);
        if (first_read) { f32x4* cp = (f32x4*)(row < ML ? a.out + (size_t)row * D : XC + (size_t)(row - ML) * D) + lane;
#pragma unroll
            for (int j = 0; j < 4; ++j) cp[64 * j] = xv[j]; }
        u32x2* o8 = (u32x2*)(H + (size_t)row * D) + lane;
#pragma unroll
        for (int j = 0; j < 4; ++j) { const int c = 4 * lane + 256 * j; const f32x4 gg = *(const f32x4*)(g + c), sh = *(const f32x4*)(modl + v * 6144 + sidx * 1024 + c), sc = *(const f32x4*)(modl + v * 6144 + (sidx + 1) * 1024 + c);
            f32x4 h = xv[j] * rstd * gg * (sc + 1.0f) + sh; u32x2 w; w.x = pk2(h[0], h[1]); w.y = pk2(h[2], h[3]); o8[64 * j] = w; }
    }
}
__device__ __forceinline__ void final_norm(const KArgs& a, int gw, int NGW, int lane) {
    for (int row = gw; row < ML; row += NGW) {
        f32x4* xr = (f32x4*)(a.out + (size_t)row * D) + lane; f32x4 xv[4]; float s = 0.f;
#pragma unroll
        for (int j = 0; j < 4; ++j) { xv[j] = xr[64 * j]; s += (xv[j][0] * xv[j][0] + xv[j][1] * xv[j][1]) + (xv[j][2] * xv[j][2] + xv[j][3] * xv[j][3]); }
        const float rstd = 1.0f / sqrtf(wave_sum(s) * (1.f / D) + 1e-6f);
#pragma unroll
        for (int j = 0; j < 4; ++j) { const f32x4 gg = *(const f32x4*)(a.final_g + 4 * lane + 256 * j); xr[64 * j] = xv[j] * rstd * gg; }
    }
}

struct AttnSt { f32x4 o[4]; float m, l; };
struct KVF { bf16x8 k[4]; bf16x8 v[4]; };
__device__ __forceinline__ void kv_load(KVF& f, const bf16_t* k0p, const bf16_t* k1p, const bf16_t* vp) {
    f.k[0] = *(const bf16x8*)k0p; f.k[1] = *(const bf16x8*)(k0p + 32); f.k[2] = *(const bf16x8*)k1p; f.k[3] = *(const bf16x8*)(k1p + 32);
#pragma unroll
    for (int dt = 0; dt < 4; ++dt) f.v[dt] = *(const bf16x8*)(vp + (size_t)dt * 16 * VTOK);
}
template <class BiasF>
__device__ __forceinline__ void attn_compute(AttnSt& st, const KVF& f, const bf16x8 (&qf)[2], BiasF bias) {
    f32x4 s0 = {0.f, 0.f, 0.f, 0.f}, s1 = {0.f, 0.f, 0.f, 0.f};
    s0 = MFMA16(f.k[0], qf[0], s0); s0 = MFMA16(f.k[1], qf[1], s0); s1 = MFMA16(f.k[2], qf[0], s1); s1 = MFMA16(f.k[3], qf[1], s1);
    float t[8]; const float SC = 0.125f * LOG2E;
#pragma unroll
    for (int j = 0; j < 4; ++j) { t[j] = bias(j, s0[j] * SC); t[4 + j] = bias(4 + j, s1[j] * SC); }
    float bm = fmaxf(fmaxf(fmaxf(t[0], t[1]), fmaxf(t[2], t[3])), fmaxf(fmaxf(t[4], t[5]), fmaxf(t[6], t[7])));
    bm = fmaxf(bm, __shfl_xor(bm, 16)); bm = fmaxf(bm, __shfl_xor(bm, 32));
    const float mn = fmaxf(st.m, bm), alpha = fexp2(st.m - mn); st.m = mn;
    float ls = 0.f;
#pragma unroll
    for (int j = 0; j < 8; ++j) { t[j] = fexp2(t[j] - mn); ls += t[j]; }
    st.l = st.l * alpha + ls;
    u32x4 pw; pw.x = pk2(t[0], t[1]); pw.y = pk2(t[2], t[3]); pw.z = pk2(t[4], t[5]); pw.w = pk2(t[6], t[7]);
    const bf16x8 pf = __builtin_bit_cast(bf16x8, pw);
#pragma unroll
    for (int dt = 0; dt < 4; ++dt) { st.o[dt] *= alpha; st.o[dt] = MFMA16(f.v[dt], pf, st.o[dt]); }
}
__device__ __forceinline__ void attn_init(AttnSt& st) {
#pragma unroll
    for (int dt = 0; dt < 4; ++dt) st.o[dt] = (f32x4){0.f, 0.f, 0.f, 0.f};
    st.m = -1.0e30f; st.l = 0.f;
}
__device__ __forceinline__ void attn_store(const AttnSt& st, float lextra, bf16_t* orow, int lane, bool dry) {
    float l = st.l; l += __shfl_xor(l, 16); l += __shfl_xor(l, 32); l += lextra;
    const float inv = 1.0f / l; const int g = lane >> 4;
#pragma unroll
    for (int dt = 0; dt < 4; ++dt) { const f32x4 o = st.o[dt] * inv; u32x2 w; w.x = pk2(o[0], o[1]); w.y = pk2(o[2], o[3]); if (!dry) *(u32x2*)(orow + 16 * dt + 4 * g) = w; }
}
__device__ __forceinline__ void na_item(const KArgs& a, int l, int item, int lane, bool dry) {
    bf16_t* P = (bf16_t*)(a.ws + WS_P); const bf16_t* VT = (const bf16_t*)(a.ws + WS_VTA);
    const int i = item & 3, h = (item >> 2) & 7, r = (item >> 5) & 127, b = item >> 12;
    const int c16 = lane & 15, g = lane >> 4, kk0 = 8 * (c16 >> 2) + (c16 & 3);
    const int cq = 16 * i + c16; const size_t qrow = (size_t)b * S + r * 64 + cq;
    bf16x8 qf[2]; qf[0] = *(const bf16x8*)(P + qrow * PW + C_QA + h * 64 + 8 * g); qf[1] = *(const bf16x8*)(P + qrow * PW + C_QA + h * 64 + 32 + 8 * g);
    const int c0 = (i == 0) ? 0 : (i == 1 ? 8 : (i == 2 ? 24 : 32));
    const int rs = min(max(r - 4, 0), 120), cs = min(max(cq - 8, 0), 48);
    unsigned okm = 0; int idx0 = c0 + 8 * g - cq + 15;
#pragma unroll
    for (int e = 0; e < 8; ++e) { const int kc = c0 + 8 * g + e; okm |= ((kc >= cs) && (kc < cs + 16)) ? (1u << e) : 0u; }
    const float* rpb = a.na_rpb + ((size_t)l * 8 + h) * 15 * 31;
    const bf16_t* kcol = P + C_KA + h * 64 + 8 * g; const bf16_t* vrow = VT + (size_t)((b * 8 + h) * 64 + c16) * VTOK + 8 * g;
    AttnSt st; attn_init(st);
    KVF cur, nxt; float bc[8], bn[8];
#pragma unroll
    for (int e = 0; e < 8; ++e) { bc[e] = 0.f; bn[e] = 0.f; }
    auto loadblk = [&](int blk, KVF& f, float (&bb)[8]) {
        if (blk < 8) { const int R = rs + blk; const size_t tok0 = (size_t)R * 64 + c0; const bf16_t* kp = kcol + ((size_t)b * S + tok0 + kk0) * PW;
            kv_load(f, kp, kp + (size_t)4 * PW, vrow + tok0);
            const float* rp = rpb + (R - r + 7) * 31;
#pragma unroll
            for (int e = 0; e < 8; ++e) bb[e] = rp[min(max(idx0 + e, 0), 30)];
        } else { const int cb = blk - 8; const bf16_t* kp = kcol + ((size_t)ML + b * CTX + 32 * cb + kk0) * PW; kv_load(f, kp, kp + (size_t)4 * PW, vrow + 8192 + 32 * cb); }
    };
    loadblk(0, cur, bc);
    for (int blk = 0; blk < 16; ++blk) {
        loadblk(blk < 15 ? blk + 1 : 15, nxt, bn);
        if (blk < 8) attn_compute(st, cur, qf, [&](int e, float s) { return ((okm >> e) & 1u) ? s + bc[e] * LOG2E : NEGBIG; });
        else attn_compute(st, cur, qf, [](int, float s) { return s; });
        cur = nxt;
#pragma unroll
        for (int e = 0; e < 8; ++e) bc[e] = bn[e];
    }
    attn_store(st, 0.f, P + qrow * PW + C_QA + h * 64, lane, dry);
}
__device__ __forceinline__ void ctx_item(const KArgs& a, int l, int item, bool swa, int lane, bool dry) {
    bf16_t* P = (bf16_t*)(a.ws + WS_P);
    const int i = item & 15, h = (item >> 4) & 7, b = item >> 7;
    const int c16 = lane & 15, g = lane >> 4, kk0 = 8 * (c16 >> 2) + (c16 & 3);
    const size_t qrow = (size_t)ML + b * CTX + 16 * i + c16; const int qc = (swa ? C_QS : C_QA) + h * 64;
    bf16x8 qf[2]; qf[0] = *(const bf16x8*)(P + qrow * PW + qc + 8 * g); qf[1] = *(const bf16x8*)(P + qrow * PW + qc + 32 + 8 * g);
    const bf16_t* kcol = P + (swa ? C_KS + (h >> 2) * 64 : C_KA + h * 64) + 8 * g;
    const bf16_t* vrow = (swa ? (const bf16_t*)(a.ws + WS_VTS) + (size_t)((b * 2 + (h >> 2)) * 64 + c16) * VTOK : (const bf16_t*)(a.ws + WS_VTA) + (size_t)((b * 8 + h) * 64 + c16) * VTOK) + 8 * g;
    AttnSt st; attn_init(st);
    for (int cb = 0; cb < 8; ++cb) { KVF f; const bf16_t* kp = kcol + ((size_t)ML + b * CTX + 32 * cb + kk0) * PW; kv_load(f, kp, kp + (size_t)4 * PW, vrow + 8192 + 32 * cb);
        attn_compute(st, f, qf, [](int, float s) { return s; }); }
    const float lex = swa ? fexp2(a.swa_sink[l * 8 + h] * LOG2E - st.m) : 0.f;
    attn_store(st, lex, P + qrow * PW + qc, lane, dry);
}
__device__ __forceinline__ float inv_freq(int f) { return exp2f(-(float)f * (13.287712379549449f / 16.0f)); }
__device__ __forceinline__ void rope_cs(int pos, int f, float& c, float& s) {
    const float ang = (float)pos * inv_freq(f); float rev = ang * 0.15915494309189535f; rev -= rintf(rev);
    c = __builtin_amdgcn_cosf(rev); s = __builtin_amdgcn_sinf(rev);
}
__device__ __forceinline__ void rope_q(bf16x8 (&qf)[2], int tq, int g) {
    const int pos = (g < 2) ? (tq >> 6) : (tq & 63);
    u32x4 w0 = __builtin_bit_cast(u32x4, qf[0]), w1 = __builtin_bit_cast(u32x4, qf[1]);
#pragma unroll
    for (int q = 0; q < 4; ++q) {
        float c0, s0, c1, s1; rope_cs(pos, 8 * (g & 1) + 2 * q, c0, s0); rope_cs(pos, 8 * (g & 1) + 2 * q + 1, c1, s1);
        const float a0 = bflo(w0[q]), a1 = bfhi(w0[q]), b0 = bflo(w1[q]), b1 = bfhi(w1[q]);
        w0[q] = pk2(a0 * c0 - b0 * s0, a1 * c1 - b1 * s1); w1[q] = pk2(b0 * c0 + a0 * s0, b1 * c1 + a1 * s1);
    }
    qf[0] = __builtin_bit_cast(bf16x8, w0); qf[1] = __builtin_bit_cast(bf16x8, w1);
}
__device__ __forceinline__ void swa_item(const KArgs& a, int l, int item, int, bool dry) {
    const int lane = lane_id_asm();
    bf16_t* P = (bf16_t*)(a.ws + WS_P); const bf16_t* VT = (const bf16_t*)(a.ws + WS_VTS);
    const int qt = item & 511, hp = (item >> 9) & 1, kvh = (item >> 10) & 1, b = item >> 11, h0 = 4 * kvh + 2 * hp;
    const int c16 = lane & 15, g = lane >> 4, kk0 = 8 * (c16 >> 2) + (c16 & 3);
    const int tq = 16 * qt + c16; const size_t qrow = (size_t)b * S + tq;
    bf16x8 qa[2], qb[2];
    qa[0] = *(const bf16x8*)(P + qrow * PW + C_QS + h0 * 64 + 8 * g); qa[1] = *(const bf16x8*)(P + qrow * PW + C_QS + h0 * 64 + 32 + 8 * g);
    qb[0] = *(const bf16x8*)(P + qrow * PW + C_QS + h0 * 64 + 64 + 8 * g); qb[1] = *(const bf16x8*)(P + qrow * PW + C_QS + h0 * 64 + 96 + 8 * g);
    rope_q(qa, tq, g); rope_q(qb, tq, g);
    const bf16_t* kcol = P + C_KS + kvh * 64 + 8 * g; const bf16_t* vrow = VT + (size_t)((b * 2 + kvh) * 64 + c16) * VTOK + 8 * g;
    AttnSt sa, sb; attn_init(sa); attn_init(sb);
    const int kstart = 16 * qt - 128;
    int bfirst = 0, blast = 8; while (kstart + 32 * bfirst + 31 < 0) ++bfirst; while (kstart + 32 * blast >= S) --blast;
    const int nblk = (blast - bfirst + 1) + 8;
    KVF cur, nxt;
    auto loadblk = [&](int q, KVF& f) {
        const int lb = bfirst + q;
        if (lb <= blast) { const int k0 = kstart + 32 * lb; const int ka = min(max(k0 + kk0, 0), S - 1), kb = min(max(k0 + kk0 + 4, 0), S - 1), vt = min(max(k0 + 8 * g, 0), S - 8);
            kv_load(f, kcol + ((size_t)b * S + ka) * PW, kcol + ((size_t)b * S + kb) * PW, VT + (size_t)((b * 2 + kvh) * 64 + c16) * VTOK + vt);
        } else { const int cb = lb - blast - 1; const bf16_t* kp = kcol + ((size_t)ML + b * CTX + 32 * cb + kk0) * PW; kv_load(f, kp, kp + (size_t)4 * PW, vrow + 8192 + 32 * cb); }
    };
    loadblk(0, cur);
    for (int q = 0; q < nblk; ++q) {
        loadblk(q + 1 < nblk ? q + 1 : q, nxt);
        const int lb = bfirst + q;
        if (lb <= blast) { const int kbase = kstart + 32 * lb + 8 * g;
            auto msk = [&](int e, float s) { const int k = kbase + e, dlt = k - tq; return ((k >= 0) && (k < S) && (dlt <= 128) && (dlt >= -128)) ? s : NEGBIG; };
            attn_compute(sa, cur, qa, msk); attn_compute(sb, cur, qb, msk);
        } else { attn_compute(sa, cur, qa, [](int, float s) { return s; }); attn_compute(sb, cur, qb, [](int, float s) { return s; }); }
        cur = nxt;
    }
    attn_store(sa, fexp2(a.swa_sink[l * 8 + h0] * LOG2E - sa.m), P + qrow * PW + C_QS + h0 * 64, lane, dry);
    attn_store(sb, fexp2(a.swa_sink[l * 8 + h0 + 1] * LOG2E - sb.m), P + qrow * PW + C_QS + h0 * 64 + 64, lane, dry);
}
__device__ __forceinline__ void rope_k_phase(const KArgs& a, int gw, int NGW, int lane, bool dry) {
    bf16_t* P = (bf16_t*)(a.ws + WS_P);
    const int hd = lane >> 5, i = lane & 31;
    for (int row = gw; row < ML; row += NGW) {
        const int t = row & (S - 1); const int pos = (i < 16) ? (t >> 6) : (t & 63);
        float c, s; rope_cs(pos, i & 15, c, s);
        bf16_t* p = P + (size_t)row * PW + C_KS + hd * 64;
        const float t1 = bf2f(p[i]), t2 = bf2f(p[i + 32]);
        const unsigned w = pk2(t1 * c - t2 * s, t2 * c + t1 * s);
        if (!dry) { p[i] = (bf16_t)(w & 0xffff); p[i + 32] = (bf16_t)(w >> 16); }
    }
}

__device__ __forceinline__ float neg_expm1(float x) {
    const float ser = -x * (1.f + x * (0.5f + x * (0.16666667f + x * (0.041666668f + x * (0.0083333338f + x * 0.0013888889f)))));
    return x > -0.25f ? ser : 1.f - __expf(x);
}
template <int DIR, bool WRITE>
__device__ __forceinline__ void lru_sweep(const KArgs& a, int l, int b, int n, int sp, float (&carry)[4], float (&arun)[4], int lane, bool dry = false) {
    bf16_t* P = (bf16_t*)(a.ws + WS_P); float* HT = (float*)(a.ws + WS_H); const bf16_t* LW = (const bf16_t*)(a.ws + WS_LW);
    const int c16 = lane & 15, g = lane >> 4; const int gg = DIR ? 3 - g : g;
    const bool lat = sp < 64; const int rowbase = lat ? b * S : ML + b * CTX, seglen = lat ? S : CTX, t0 = (lat ? sp : sp - 64) * 128;
    float ba[4], bx[4], spc[4];
#pragma unroll
    for (int nt = 0; nt < 4; ++nt) { const int ch = n * 64 + 16 * nt + c16, o = (l * 2 + DIR) * 512 + ch;
        ba[nt] = a.lru_ba[o]; bx[nt] = a.lru_bx[o]; const float lam = a.lru_lambda[o]; spc[nt] = (lam < -15.f) ? -lam : log1pf(__expf(-lam)); }
    const bf16_t* lwa = LW + ((size_t)((l * 2 + DIR) * 2 + 0) * 8 + n) * 4096 + c16 * 64 + 8 * g;
    const bf16_t* lwx = LW + ((size_t)((l * 2 + DIR) * 2 + 1) * 8 + n) * 4096 + c16 * 64 + 8 * g;
    const float* cw = a.conv_w + (size_t)l * 4 * 512; const float* cbias = a.conv_b + (size_t)l * 512;
    const int srcm = DIR ? lane + 16 : lane - 16, srcm2 = DIR ? lane + 32 : lane - 32, srct = DIR ? c16 : 48 + c16;
    for (int ti = 0; ti < 8; ++ti) {
        asm volatile("" ::: "memory");
        const int tile = DIR ? 7 - ti : ti; const int tt = t0 + 16 * tile; const int t = tt + c16;
        int lv = lane; asm volatile("" : "+v"(lv)); const int idt = (lv & 15) - 8 * (lv >> 4);
        bf16x8 uf[2];
#pragma unroll
        for (int ks = 0; ks < 2; ++ks) { const int chb = n * 64 + 32 * ks + 8 * g;
            f32x4 u0 = *(const f32x4*)(cbias + chb), u1 = *(const f32x4*)(cbias + chb + 4);
#pragma unroll
            for (int i = 0; i < 4; ++i) { const int tp = t + i - 2; const bool ok = (tp >= 0) && (tp < seglen); const int tc = min(max(tp, 0), seglen - 1);
                const u32x4 xw = *(const u32x4*)(P + (size_t)(rowbase + tc) * PW + C_XB + chb);
                f32x4 w0 = *(const f32x4*)(cw + i * 512 + chb), w1 = *(const f32x4*)(cw + i * 512 + chb + 4);
                if (!ok) { w0 = (f32x4){0.f, 0.f, 0.f, 0.f}; w1 = w0; }
                u0[0] += w0[0] * bflo(xw[0]); u0[1] += w0[1] * bfhi(xw[0]); u0[2] += w0[2] * bflo(xw[1]); u0[3] += w0[3] * bfhi(xw[1]);
                u1[0] += w1[0] * bflo(xw[2]); u1[1] += w1[1] * bfhi(xw[2]); u1[2] += w1[2] * bflo(xw[3]); u1[3] += w1[3] * bfhi(xw[3]); }
            u32x4 pw; pw.x = pk2(u0[0], u0[1]); pw.y = pk2(u0[2], u0[3]); pw.z = pk2(u1[0], u1[1]); pw.w = pk2(u1[2], u1[3]);
            uf[ks] = __builtin_bit_cast(bf16x8, pw); }
#pragma unroll
        for (int nt = 0; nt < 4; ++nt) {
            f32x4 ga = {0.f, 0.f, 0.f, 0.f}, gx = ga, ud = ga;
#pragma unroll
            for (int ks = 0; ks < 2; ++ks) {
                const bf16x8 wa = *(const bf16x8*)(lwa + nt * 1024 + 32 * ks), wx = *(const bf16x8*)(lwx + nt * 1024 + 32 * ks);
                bf16x8 idf;
#pragma unroll
                for (int j = 0; j < 8; ++j) idf[j] = (32 * ks + j == 16 * nt + idt) ? (short)0x3F80 : (short)0;
                ga = MFMA16(uf[ks], wa, ga); gx = MFMA16(uf[ks], wx, gx); ud = MFMA16(uf[ks], idf, ud);
            }
            float av[4], bv[4];
#pragma unroll
            for (int j = 0; j < 4; ++j) {
                const float r = frcp(1.f + __expf(-(ga[j] + ba[nt]))), ii = frcp(1.f + __expf(-(gx[j] + bx[nt])));
                const float la = -8.0f * r * spc[nt];
                av[j] = __expf(la); bv[j] = sqrtf(neg_expm1(2.0f * la)) * ii * ud[j];
            }
            float Pj[4], Hj[4];
#pragma unroll
            for (int jj = 0; jj < 4; ++jj) { const int j = DIR ? 3 - jj : jj;
                if (jj == 0) { Pj[0] = av[j]; Hj[0] = bv[j]; } else { Pj[jj] = Pj[jj - 1] * av[j]; Hj[jj] = av[j] * Hj[jj - 1] + bv[j]; } }
            float Ai = Pj[3], Hi = Hj[3];
            { const float A1 = __shfl(Ai, srcm), H1 = __shfl(Hi, srcm); if (gg >= 1) { Hi = Ai * H1 + Hi; Ai = Ai * A1; } }
            { const float A2 = __shfl(Ai, srcm2), H2 = __shfl(Hi, srcm2); if (gg >= 2) { Hi = Ai * H2 + Hi; Ai = Ai * A2; } }
            float Ae = __shfl(Ai, srcm), He = __shfl(Hi, srcm); if (gg == 0) { Ae = 1.f; He = 0.f; }
            const float At = __shfl(Ai, srct), Ht = __shfl(Hi, srct);
            const float cin = Ae * carry[nt] + He;
            if (WRITE) {
#pragma unroll
                for (int jj = 0; jj < 4; ++jj) { const int j = DIR ? 3 - jj : jj; const float hv = Hj[jj] + Pj[jj] * cin;
                    const size_t row = (size_t)(rowbase + tt + 4 * g + j); const int ch = n * 64 + 16 * nt + c16;
                    if (DIR == 0) HT[row * 512 + ch] = hv;
                    else { bf16_t* gp = P + row * PW + C_GB + ch; const float gbv = bf2f(*gp); const float y = HT[row * 512 + ch] + hv;
                        const float z = 0.7978845608028654f * (gbv + 0.044715f * gbv * gbv * gbv); const float th = 1.f - 2.f * frcp(1.f + __expf(2.f * z));
                        const float ge = 0.5f * gbv * (1.f + th); if (!dry) *gp = (bf16_t)(pk2(y * ge, 0.f) & 0xffff); } }
            }
            carry[nt] = At * carry[nt] + Ht; arun[nt] *= At;
        }
    }
}
__device__ __forceinline__ void lru_pass1_item(const KArgs& a, int l, int item, int lane) {
    const int dir = item & 1, n = (item >> 1) & 7, rest = item >> 4, sp = rest % 66, b = rest / 66;
    float carry[4] = {0.f, 0.f, 0.f, 0.f}, arun[4] = {1.f, 1.f, 1.f, 1.f};
    if (dir) lru_sweep<1, false>(a, l, b, n, sp, carry, arun, lane); else lru_sweep<0, false>(a, l, b, n, sp, carry, arun, lane);
    float* SUM = (float*)(a.ws + WS_SUM);
    if (lane < 16) {
#pragma unroll
        for (int nt = 0; nt < 4; ++nt) { float* p = SUM + ((size_t)((b * 66 + sp) * 2 + dir) * 512 + n * 64 + 16 * nt + lane) * 2; p[0] = arun[nt]; p[1] = carry[nt]; }
    }
}
__device__ __forceinline__ void lru_fold(const float* SUM, int b, int p, int dir, int n, int c16, float (&carry)[4]) {
#pragma unroll
    for (int nt = 0; nt < 4; ++nt) { const float* q = SUM + ((size_t)((b * 66 + p) * 2 + dir) * 512 + n * 64 + 16 * nt + c16) * 2; carry[nt] = q[0] * carry[nt] + q[1]; }
}
__device__ __forceinline__ void lru_pass2_item(const KArgs& a, int l, int item, int lane, bool dry) {
    const int n = item & 7, rest = item >> 3, sp = rest % 66, b = rest / 66; const int c16 = lane & 15;
    const float* SUM = (const float*)(a.ws + WS_SUM);
    float carry[4] = {0.f, 0.f, 0.f, 0.f}, arun[4] = {1.f, 1.f, 1.f, 1.f};
    if (sp < 64) { lru_fold(SUM, b, 64, 0, n, c16, carry); lru_fold(SUM, b, 65, 0, n, c16, carry); for (int p = 0; p < sp; ++p) lru_fold(SUM, b, p, 0, n, c16, carry); }
    else if (sp == 65) lru_fold(SUM, b, 64, 0, n, c16, carry);
    lru_sweep<0, true>(a, l, b, n, sp, carry, arun, lane);
#pragma unroll
    for (int nt = 0; nt < 4; ++nt) carry[nt] = 0.f;
    if (sp < 64) { lru_fold(SUM, b, 65, 1, n, c16, carry); lru_fold(SUM, b, 64, 1, n, c16, carry); for (int p = 63; p > sp; --p) lru_fold(SUM, b, p, 1, n, c16, carry); }
    else if (sp == 64) lru_fold(SUM, b, 65, 1, n, c16, carry);
    lru_sweep<1, true>(a, l, b, n, sp, carry, arun, lane, dry);
}


#define XB_TMO      128
#define XB_XCNT(j)  (256  + 64 * (j))
#define XB_XSUB(j)  (1280 + 64 * (j))
#define XB_XGEN(j)  (2304 + 64 * (j))
#define XB_TOP      3328
#define XB_TOPGEN   3392
#define XCD_BAR_WORDS 3456
#define XB_SPIN_CAP (1u << 18)
__device__ __forceinline__ unsigned xb_ld(unsigned* p)              { return __hip_atomic_load(p, __ATOMIC_RELAXED, __HIP_MEMORY_SCOPE_AGENT); }
__device__ __forceinline__ unsigned xb_add(unsigned* p, unsigned v) { return __hip_atomic_fetch_add(p, v, __ATOMIC_RELAXED, __HIP_MEMORY_SCOPE_AGENT); }
__device__ __forceinline__ unsigned xb_xcc_id() { return (unsigned)__builtin_amdgcn_s_getreg((3 << 11) | 20) & 0xFu; }
#define XB_SPIN(cond, bar) do { unsigned _sp = 0; while (cond) { __builtin_amdgcn_s_sleep(1); \
    if ((++_sp & 255u) == 0u) { if (xb_ld(&(bar)[XB_TMO])) break; if (_sp > XB_SPIN_CAP) { atomicAdd(&(bar)[XB_TMO], 1u); break; } } } } while (0)
struct XcdBarrier { unsigned* bar; unsigned x; volatile LAS unsigned* st; };
__device__ __forceinline__ XcdBarrier xcd_barrier_post(unsigned* bar, volatile LAS unsigned* st) {
    XcdBarrier b; b.bar = bar; b.x = xb_xcc_id(); b.st = st;
    if (threadIdx.x == 0) (void)xb_add(&bar[XB_XCNT(b.x)], 1u);
    return b;
}
__device__ __forceinline__ void xcd_barrier_complete(unsigned* bar, unsigned x, unsigned& nloc, unsigned& nx) {
    const unsigned G = gridDim.x * gridDim.y * gridDim.z;
    unsigned sum, cnt, mine, sp = 0u;
    for (;;) {
        sum = 0u; cnt = 0u; mine = 0u;
#pragma unroll
        for (unsigned j = 0; j < 16; ++j) { const unsigned c = xb_ld(&bar[XB_XCNT(j)]); sum += c; cnt += (c > 0u) ? 1u : 0u; mine = (j == x) ? c : mine; }
        if (sum == G) break;
        __builtin_amdgcn_s_sleep(1);
        if ((++sp & 255u) == 0u) { if (xb_ld(&bar[XB_TMO])) break; if (sp > XB_SPIN_CAP) { atomicAdd(&bar[XB_TMO], 1u); break; } }
    }
    nloc = mine > 0u ? mine : 1u; nx = cnt > 0u ? cnt : 1u;
}
__device__ __forceinline__ void xcd_barrier(const XcdBarrier& b) {
    asm volatile("s_waitcnt vmcnt(0)" ::: "memory");
    __syncthreads();
    if (threadIdx.x == 0) {
        unsigned* bar = b.bar;
        __builtin_amdgcn_s_waitcnt(0);
        unsigned nloc = b.st[0], nx = b.st[1];
        if (nloc == 0u) { xcd_barrier_complete(bar, b.x, nloc, nx); b.st[0] = nloc; b.st[1] = nx; }
        const unsigned old = xb_add(&bar[XB_XSUB(b.x)], 1u);
        const unsigned gen = old / nloc;
        if (old + 1u == (gen + 1u) * nloc) {
            __builtin_amdgcn_fence(__ATOMIC_RELEASE, "agent");
            asm volatile("s_waitcnt vmcnt(0)" ::: "memory");
            const unsigned og = xb_add(&bar[XB_TOP], 1u);
            const unsigned tg = og / nx;
            if (og + 1u == (tg + 1u) * nx) xb_add(&bar[XB_TOPGEN], 1u);
            else XB_SPIN(xb_ld(&bar[XB_TOPGEN]) == tg, bar);
            __builtin_amdgcn_fence(__ATOMIC_ACQUIRE, "agent");
            xb_add(&bar[XB_XGEN(b.x)], 1u);
            asm volatile("s_waitcnt vmcnt(0)" ::: "memory");
        } else {
            XB_SPIN(xb_ld(&bar[XB_XGEN(b.x)]) == gen, bar);
            __builtin_amdgcn_fence(__ATOMIC_ACQUIRE, "agent");
            asm volatile("s_waitcnt vmcnt(0)" ::: "memory");
        }
    }
    __syncthreads();
}

__global__ void __launch_bounds__(512, 2) fwd_kernel(KArgs a) {
    extern __shared__ __attribute__((aligned(16))) unsigned char smem[];
    LAS unsigned char* lds = (LAS unsigned char*)smem;
    cg::grid_group grid = cg::this_grid();
    const int G = gridDim.x, NGW = G * 8;
    const int wave = __builtin_amdgcn_readfirstlane(threadIdx.x >> 6);
    volatile LAS unsigned* bst = (volatile LAS unsigned*)(lds + 131072);
    if (threadIdx.x < 2) bst[threadIdx.x] = 0u;
    __syncthreads();
    XcdBarrier xbar; xbar.bar = (unsigned*)(a.ws + WS_BAR); xbar.x = 0; xbar.st = bst;
    if (a.ph_hi - a.ph_lo > 1) xbar = xcd_barrier_post((unsigned*)(a.ws + WS_BAR), bst);
    for (int ph = a.ph_lo; ph < a.ph_hi; ++ph) {
        bf16_t* P = (bf16_t*)(a.ws + WS_P); bf16_t* H = (bf16_t*)(a.ws + WS_H); bf16_t* WB = (bf16_t*)(a.ws + WS_WB);
        float* XC = (float*)(a.ws + WS_XC);
        int lane = lane_id_asm(); const int gw = blockIdx.x * 8 + wave;
        if (ph == 0) phase0(a, lds, gw, NGW, wave, lane);
        else if (ph == 37) final_norm(a, gw, NGW, lane);
        else {
            const int l = (ph - 1) / 9, k = (ph - 1) % 9; const bool lastl = (l == NL - 1); const int Mrows = lastl ? ML : MT;
            const float* modl = (const float*)(a.ws + WS_MOD) + (size_t)l * 5 * 6144;
            const int reps = ((PROBE_MASK >> k) & 1) ? 2 : 1;
            for (int rep = 0; rep < reps; ++rep) { const bool dry = (rep + 1 < reps);
            if (rep) { xcd_barrier(xbar); lane = lane_id_asm(); }
            if (k == 0) {
                norm_phase(a, l, false, MT, gw, NGW, lane, l > 0 ? 8 : 0);
                if (l > 0) convert_stage_a(a, l, gw, NGW, (LAS float*)(lds + wave * 8448), lane);
            } else if (k == 1) {
                pg8::Gemm g{H, WB, 1}; pg8::Order So; So.init(MT, WIN, G, blockIdx.x, 1, D);
                EpiIn E{P, (bf16_t*)(a.ws + WS_VTA), (bf16_t*)(a.ws + WS_VTS)};
                #ifndef NO_EPIIN
                pg8::gemm_phase<EpiIn, D, D, D>(lds, g, So, E, wave);
#endif
            } else if (k == 2) {
                convert_stage_b(a, l, gw, NGW, (LAS float*)(lds + wave * 8448), lane);
                rope_k_phase(a, gw, NGW, lane, dry);
                constexpr int N1 = NB * 66 * 8 * 2, N2 = N1 + NB * 128 * 8 * 4 / 2, N3 = N2 + NB * 8 * 16;
                unsigned* ctr = (unsigned*)(a.ws + WS_BAR) + 8 * (2 * l + 0 + 2 * NL * rep);
                for (;;) {
                    int it = 0; if (lane == 0) it = (int)__hip_atomic_fetch_add(ctr, 1u, __ATOMIC_RELAXED, __HIP_MEMORY_SCOPE_AGENT);
                    it = __builtin_amdgcn_readfirstlane(it);
                    if (it >= (lastl ? N2 : N3)) break;
                    if (it < N1) lru_pass1_item(a, l, it, lane);
                    else if (it < N2) { na_item(a, l, 2 * (it - N1), lane, dry); na_item(a, l, 2 * (it - N1) + 1, lane, dry); }
                    else ctx_item(a, l, it - N2, false, lane, dry);
                }
            } else if (k == 3) {
                constexpr int N1 = NB * 66 * 8, N2 = N1 + NB * 4 * 512, N3 = N2 + NB * 8 * 16;
                unsigned* ctr = (unsigned*)(a.ws + WS_BAR) + 8 * (2 * l + 1 + 2 * NL * rep);
                for (;;) {
                    int it = 0; if (lane == 0) it = (int)__hip_atomic_fetch_add(ctr, 1u, __ATOMIC_RELAXED, __HIP_MEMORY_SCOPE_AGENT);
                    it = __builtin_amdgcn_readfirstlane(it);
                    if (it >= (lastl ? N2 : N3)) break;
                    if (it < N1) lru_pass2_item(a, l, it, lane, dry);
                    else if (it < N2) swa_item(a, l, it - N1, lane, dry);
                    else ctx_item(a, l, it - N2, true, lane, dry);
                }
            } else if (k == 4) {
                pg8::Gemm g{P, WB + WB_BR, 3}; pg8::Order So; So.init(Mrows, D, G, blockIdx.x, 3, 512);
                EpiMerge E{P, H};
                #ifndef NO_EPIMERGE
                pg8::gemm_phase<EpiMerge, PW, 512, 512, C_QA, C_GB, C_QS, 524288>(lds, g, So, E, wave);
#endif
            } else if (k == 5) {
                pg8::Gemm g{H, WB + WB_OUT, 1}; pg8::Order So; So.init(ML, D, G, blockIdx.x, 1, D, lastl ? 0 : MC / 256, 4);
                EpiRes E{a.out, XC, modl, 2, dry, (float*)(a.ws + WS_PART)};
#ifndef NO_EPIRES
                pg8::gemm_phase<EpiRes, D, D, D>(lds, g, So, E, wave);
#endif
            } else if (k == 8) {
                pg8::Gemm g{P, WB + WB_FF2, 1}; pg8::Order So; So.init(ML, D, G, blockIdx.x, 1, DFF, lastl ? 0 : MC / 256, 8);
                EpiRes E{a.out, XC, modl, 5, dry, (float*)(a.ws + WS_PART)};
#ifndef NO_EPIRES
                pg8::gemm_phase<EpiRes, DFF, DFF, DFF>(lds, g, So, E, wave);
#endif
            } else if (k == 6) {
                norm_phase(a, l, true, Mrows, gw, NGW, lane, lastl ? 0 : 4);
            } else if (k == 7) {
                pg8::Gemm g{H, WB + WB_FF1, 1}; pg8::Order So; So.init(Mrows, DFF, G, blockIdx.x, 1, D);
                EpiFF1 E{P};
                #ifndef NO_EPIFF1
                pg8::gemm_phase<EpiFF1, D, D, D>(lds, g, So, E, wave);
#endif
            }
            }
        }
        if (ph + 1 < a.ph_hi) { if (ph == 0 || !USE_XCD_BAR) { __syncthreads(); grid.sync(); } else xcd_barrier(xbar); if ((PROBE_MASK >> 9) & 1) xcd_barrier(xbar); }
    }
}

extern "C" void kernel_launch(void* const* d_in, const int* in_sizes, int n_in, void* d_out, int out_size, void* d_ws, size_t ws_size, hipStream_t stream) {
    static int grid = 0;
    if (grid == 0) {
        if (n_in != 23 || ws_size < WS_END) { fprintf(stderr, "kernel_launch: unexpected n_in %d or ws_size %zu (< %zu)\n", n_in, ws_size, (size_t)WS_END); grid = -1; return; }
        int dev = 0, cus = 0, per_cu = 0;
        hipGetDevice(&dev); hipDeviceGetAttribute(&cus, hipDeviceAttributeMultiprocessorCount, dev);
        if (hipFuncSetAttribute((const void*)fwd_kernel, hipFuncAttributeMaxDynamicSharedMemorySize, LDS_BYTES) != hipSuccess) { fprintf(stderr, "hipFuncSetAttribute failed\n"); grid = -1; return; }
        if (hipOccupancyMaxActiveBlocksPerMultiprocessor(&per_cu, (const void*)fwd_kernel, 512, LDS_BYTES) != hipSuccess || per_cu < 1) { fprintf(stderr, "occupancy query: %d\n", per_cu); per_cu = 1; }
        (void)hipGetLastError();
        grid = cus;
    }
    if (grid < 0) return;
    KArgs a{};
    const float** f = (const float**)&a;
    for (int i = 0; i < 23; ++i) f[i] = (const float*)d_in[i];
    a.out = (float*)d_out; a.ws = (unsigned char*)d_ws;
#if N_LAUNCHES == 1
    a.ph_lo = 0; a.ph_hi = 38;
    if (hipMemsetAsync((unsigned char*)d_ws + WS_BAR, 0, XCD_BAR_WORDS * 4, stream) != hipSuccess) { fprintf(stderr, "memset failed\n"); return; }
    void* args[] = {&a};
    hipError_t e = hipLaunchCooperativeKernel((const void*)fwd_kernel, dim3(grid), dim3(512), args, LDS_BYTES, stream);
    if (e != hipSuccess) fprintf(stderr, "cooperative launch failed: %s (grid %d)\n", hipGetErrorString(e), grid);
#else
    for (int ph = 0; ph < 38; ++ph) { a.ph_lo = ph; a.ph_hi = ph + 1; hipLaunchKernelGGL(fwd_kernel, dim3(grid), dim3(512), LDS_BYTES, stream, a); }
#endif
}
```

```cpp
#include <hip/hip_runtime.h>
#include <hip/hip_cooperative_groups.h>
#include <cstdio>
#include <cstdint>
namespace cg = cooperative_groups;

#ifndef N_LAUNCHES
#define N_LAUNCHES 1
#endif

#ifndef USE_XCD_BAR
#define USE_XCD_BAR 1
#endif
#ifndef PROBE_MASK
#define PROBE_MASK 0
#endif
#define LAS __attribute__((address_space(3)))
typedef unsigned short bf16_t;
typedef short bf16x8 __attribute__((ext_vector_type(8)));
typedef short s16x4 __attribute__((ext_vector_type(4)));
typedef float f32x4 __attribute__((ext_vector_type(4)));
typedef unsigned u32x4 __attribute__((ext_vector_type(4)));
typedef unsigned u32x2 __attribute__((ext_vector_type(2)));

constexpr int D = 1024, NB = 4, S = 8192, CTX = 256, ML = NB * S, MC = NB * CTX, MT = ML + MC, NL = 4, DFF = 4096;
constexpr int PW = 5760;
constexpr int C_QA = 0, C_KA = 512, C_XB = 1024, C_GB = 1536, C_QS = 2048, C_KS = 2560, C_GA = 2688, C_GR = 3712, C_GS = 4736;
constexpr int VTOK = 8448;
constexpr int WIN = 6400;
constexpr size_t MiB = 1u << 20;
constexpr size_t WS_XC = 0, WS_H = 4 * MiB, WS_P = 70 * MiB, WS_VTA = WS_P + (size_t)MT * PW * 2, WS_VTS = WS_VTA + (size_t)NB * 8 * 64 * VTOK * 2,
                 WS_WB = WS_VTS + (size_t)NB * 2 * 64 * VTOK * 2, WS_MOD = WS_WB + 21 * MiB, WS_SUM = WS_MOD + MiB / 2, WS_LW = WS_SUM + 5 * MiB / 2, WS_BAR = WS_LW + MiB, WS_PART = WS_P + 264 * MiB, WS_END = WS_BAR + 16384;
constexpr int WB_BR = 0, WB_OUT = 3 * 524288, WB_FF1 = WB_OUT + 1048576, WB_FF2 = WB_FF1 + 4194304;
constexpr int LDS_BYTES = 131072 + 64;
constexpr float LOG2E = 1.4426950408889634f;
constexpr float NEGBIG = -3.0e38f;

struct KArgs {
    const float *x, *c, *ctx, *c_ctx, *w_mod, *b_mod, *norm1_g, *norm2_g, *w_in, *na_rpb, *conv_w, *conv_b, *lru_wa, *lru_ba, *lru_wx, *lru_bx, *lru_lambda,
        *swa_sink, *w_branch, *w_out, *w_ff1, *w_ff2, *final_g;
    float* out; unsigned char* ws; int ph_lo, ph_hi;
};

typedef __bf16 bf16x2_t __attribute__((ext_vector_type(2)));
typedef float f32x2_t __attribute__((ext_vector_type(2)));
__device__ __forceinline__ unsigned pk2(float lo, float hi) { f32x2_t v = {lo, hi}; bf16x2_t r = __builtin_convertvector(v, bf16x2_t); return __builtin_bit_cast(unsigned, r); }
__device__ __forceinline__ float bf2f(unsigned short b) { return __uint_as_float(((unsigned)b) << 16); }
__device__ __forceinline__ float bflo(unsigned w) { return __uint_as_float(w << 16); }
__device__ __forceinline__ float bfhi(unsigned w) { return __uint_as_float(w & 0xffff0000u); }
__device__ __forceinline__ float fexp2(float x) { return __builtin_amdgcn_exp2f(x); }
__device__ __forceinline__ float frcp(float x) { return __builtin_amdgcn_rcpf(x); }
__device__ __forceinline__ int lane_id_asm() { int l; asm volatile("v_mbcnt_lo_u32_b32 %0, -1, 0\n\tv_mbcnt_hi_u32_b32 %0, -1, %0" : "=v"(l)); return l; }
__device__ __forceinline__ float wave_sum(float v) {
#pragma unroll
    for (int o = 1; o < 64; o <<= 1) v += __shfl_xor(v, o);
    return v;
}
#define MFMA16(a, b, c) __builtin_amdgcn_mfma_f32_16x16x32_bf16((a), (b), (c), 0, 0, 0)

namespace pg8 {
constexpr int BM = 256, BK = 64, HALF = 128, HTB = HALF * BK * 2, STAGE_BYTES = 8 * HTB, NXCD = 8, WGM = 8;
__host__ __device__ __forceinline__ int lds_byte(int r, int c) { const int st = (r >> 4) * 2 + (c >> 5), rr = r & 15, cc = c & 31, ob = rr * 64 + cc * 2; return st * 1024 + (ob ^ (((ob >> 9) & 1) << 5)); }
__host__ __device__ __forceinline__ void stage_rc(int b, int& R, int& C) { const int st = b / 1024, sb = b % 1024, swz = sb ^ (((sb >> 9) & 1) << 5); R = (st >> 1) * 16 + swz / 64; C = (st & 1) * 32 + (swz % 64) / 2; }
__host__ __device__ __forceinline__ int perm32(int rho) { const int n = rho >> 4, i = rho & 15; return 8 * (i >> 2) + 4 * n + (i & 3); }

struct Unit { int pm, pn, sub, koff, nt, split, ks; };
struct Gemm { const bf16_t* A; const bf16_t* Bt; int nsub; };
struct Order {
    int nM, nN, nwg, G, c, nsub, ntK;
    int xM, KS;
    __device__ void init(int M, int N, int G_, int c_, int nsub_, int K, int xM_ = 0, int KS_ = 1) { nM = M / BM; nN = N / BM; nwg = nM * nN; G = G_; c = c_; nsub = nsub_; ntK = K / BK; xM = xM_; KS = KS_; }
    __device__ bool next(int i, Unit& u) const {
        const int ti = i / nsub; u.sub = i - ti * nsub; u.koff = 0; u.nt = ntK; u.split = 0; u.ks = 0;
        const long L = (long)ti * G + c;
        if (L >= nwg) {
            const int idx = (int)(L - nwg); if (idx >= xM * nN * KS) return false;
            const int t = idx / KS, ks = idx - t * KS; u.pm = nM + t / nN; u.pn = t % nN; u.nt = ntK / KS; u.koff = ks * u.nt * BK; u.split = 1; u.ks = ks; return true;
        }
        int wgid = (int)L; { const int q = nwg / NXCD, r = nwg % NXCD, xcd = wgid % NXCD, off = wgid / NXCD; wgid = (xcd < r ? xcd * (q + 1) : r * (q + 1) + (xcd - r) * q) + off; }
        const int nig = WGM * nN, gid = wgid / nig, fm = gid * WGM, gsz = (nM - fm) < WGM ? (nM - fm) : WGM;
        u.pm = fm + ((wgid % nig) % gsz); u.pn = (wgid % nig) / gsz; return true;
    }
};

template <class Epi, int LDA, int LDB, int K, int A0 = 0, int A1 = 0, int A2 = 0, int BS = 0>
__device__ __forceinline__ void gemm_phase(LAS unsigned char* lds, const Gemm g, const Order& S, const Epi& E, int wid) {
    const int lane = lane_id_asm(), tid = wid * 64 + lane, wr = wid >> 2, wc = wid & 3, fr = lane & 15, fq = lane >> 4;
    unsigned voffA[2], voffB[2];
#pragma unroll
    for (int i = 0; i < 2; ++i) { int R, C; stage_rc(tid * 16 + i * 8192, R, C); const int Rb = Epi::PERM ? ((R & ~31) + perm32(R & 31)) : R;
        voffA[i] = (unsigned)(R * LDA + C) * 2u; voffB[i] = (unsigned)(Rb * LDB + C) * 2u; }
    constexpr size_t kstep = (size_t)(BK * 2);
    constexpr size_t hstepA = (size_t)HALF * LDA * 2, hstepB = (size_t)HALF * LDB * 2;
    constexpr size_t tstepA = 2 * hstepA, tstepB = 2 * hstepB;
    const unsigned ldsw = (unsigned)wid * 1024u;
    const int aoff = lds_byte(wr * 64 + fr, fq * 8), boff = lds_byte(wc * 32 + fr, fq * 8);
#define PG8_SA(b, h) (((b) * 2 + (h)) * HTB)
#define PG8_SB(b, h) ((4 + (b) * 2 + (h)) * HTB)
#define PG8_STAGE(bufoff, gbase, voff) do { _Pragma("unroll") for (int _i = 0; _i < 2; ++_i) \
        __builtin_amdgcn_global_load_lds((const unsigned*)((const char*)(gbase) + (voff)[_i]), (LAS unsigned*)(lds + (bufoff) + ldsw + _i * 8192), 16, 0, 0); } while (0)
#define PG8_LDA(dst, b, h) do { _Pragma("unroll") for (int m = 0; m < 4; ++m) _Pragma("unroll") for (int k = 0; k < 2; ++k) dst[m][k] = *(const LAS bf16x8*)(lds + PG8_SA(b, h) + aoff + m * 2048 + k * 1024); } while (0)
#define PG8_LDB(dst, b, h) do { _Pragma("unroll") for (int n = 0; n < 2; ++n) _Pragma("unroll") for (int k = 0; k < 2; ++k) dst[n][k] = *(const LAS bf16x8*)(lds + PG8_SB(b, h) + boff + n * 2048 + k * 1024); } while (0)
#define PG8_MMA(ai, bj, At, Bt) do { __builtin_amdgcn_s_setprio(1); _Pragma("unroll") for (int m = 0; m < 4; ++m) _Pragma("unroll") for (int n = 0; n < 2; ++n) _Pragma("unroll") for (int k = 0; k < 2; ++k) \
        acc[ai][bj][m][n] = __builtin_amdgcn_mfma_f32_16x16x32_bf16(Bt[n][k], At[m][k], acc[ai][bj][m][n], 0, 0, 0); __builtin_amdgcn_s_setprio(0); } while (0)
#define PG8_WAIT_V(n) asm volatile("s_waitcnt vmcnt(" #n ")" ::: "memory")
#define PG8_WAIT_L(n) asm volatile("s_waitcnt lgkmcnt(" #n ")" ::: "memory")
#define PG8_BAR __builtin_amdgcn_s_barrier()
#define PG8_SCHED __builtin_amdgcn_sched_barrier(0)
    Unit cur, nxt; int ui = 0;
    if (!S.next(0, cur)) return;
    f32x4 acc[2][2][4][2];
#pragma unroll
    for (int a = 0; a < 2; ++a)
#pragma unroll
        for (int b = 0; b < 2; ++b)
#pragma unroll
            for (int m = 0; m < 4; ++m)
#pragma unroll
                for (int n = 0; n < 2; ++n) acc[a][b][m][n] = (f32x4){0.f, 0.f, 0.f, 0.f};
    bf16x8 At[4][2], B0[2][2], B1[2][2];
    const char* cA = (const char*)(g.A + (cur.sub == 0 ? A0 : (cur.sub == 1 ? A1 : A2)) + cur.koff) + (size_t)cur.pm * tstepA; const char* cB = (const char*)(g.Bt + (cur.sub * BS) + cur.koff) + (size_t)cur.pn * tstepB;
    PG8_STAGE(PG8_SB(0, 0), cB, voffB); PG8_STAGE(PG8_SA(0, 0), cA, voffA); PG8_STAGE(PG8_SB(0, 1), cB + hstepB, voffB); PG8_STAGE(PG8_SA(0, 1), cA + hstepA, voffA);
    if (wr == 1) PG8_BAR;
    PG8_WAIT_V(4); PG8_BAR;
    PG8_STAGE(PG8_SB(1, 0), cB + kstep, voffB); PG8_STAGE(PG8_SA(1, 0), cA + kstep, voffA); PG8_STAGE(PG8_SB(1, 1), cB + hstepB + kstep, voffB);
    PG8_WAIT_V(6); PG8_BAR;
    for (;;) {
        const bool has_next = S.next(ui + 1, nxt);
        const char* nA = has_next ? (const char*)(g.A + (nxt.sub == 0 ? A0 : (nxt.sub == 1 ? A1 : A2)) + nxt.koff) + (size_t)nxt.pm * tstepA : cA; const char* nB = has_next ? (const char*)(g.Bt + (nxt.sub * BS) + nxt.koff) + (size_t)nxt.pn * tstepB : cB;
        const int nt = cur.nt;
        for (int t = 0; t < nt; t += 2) {
            const bool last = (t == nt - 2);
            const char* a1 = cA + (size_t)(t + 1) * kstep;
            const char* a2 = last ? nA : cA + (size_t)(t + 2) * kstep; const char* b2 = last ? nB : cB + (size_t)(t + 2) * kstep;
            const char* a3 = a2 + kstep; const char* b3 = b2 + kstep;
            PG8_LDB(B0, 0, 0); PG8_SCHED; PG8_LDA(At, 0, 0); PG8_STAGE(PG8_SA(1, 1), a1 + hstepA, voffA);
            PG8_WAIT_L(8); PG8_BAR; PG8_WAIT_L(0); PG8_MMA(0, 0, At, B0); PG8_BAR; PG8_SCHED;
            PG8_LDB(B1, 0, 1); PG8_STAGE(PG8_SB(0, 0), b2, voffB);
            PG8_BAR; PG8_WAIT_L(0); PG8_MMA(0, 1, At, B1); PG8_BAR;
            PG8_LDA(At, 0, 1); PG8_STAGE(PG8_SA(0, 0), a2, voffA);
            PG8_BAR; PG8_WAIT_L(0); PG8_MMA(1, 0, At, B0); PG8_BAR; PG8_SCHED;
            PG8_STAGE(PG8_SB(0, 1), b2 + hstepB, voffB);
            PG8_WAIT_V(6); PG8_BAR; PG8_MMA(1, 1, At, B1); PG8_BAR;
            PG8_LDB(B0, 1, 0); PG8_SCHED; PG8_LDA(At, 1, 0); PG8_STAGE(PG8_SA(0, 1), a2 + hstepA, voffA);
            PG8_WAIT_L(8); PG8_BAR; PG8_WAIT_L(0); PG8_MMA(0, 0, At, B0); PG8_BAR; PG8_SCHED;
            PG8_LDB(B1, 1, 1); PG8_STAGE(PG8_SB(1, 0), b3, voffB);
            PG8_BAR; PG8_WAIT_L(0); PG8_MMA(0, 1, At, B1); PG8_BAR;
            PG8_LDA(At, 1, 1); PG8_STAGE(PG8_SA(1, 0), a3, voffA);
            PG8_BAR; PG8_WAIT_L(0); PG8_MMA(1, 0, At, B0); PG8_BAR; PG8_SCHED;
            PG8_STAGE(PG8_SB(1, 1), b3 + hstepB, voffB);
            PG8_WAIT_V(6); PG8_BAR; PG8_MMA(1, 1, At, B1); PG8_BAR;
        }
        E(acc, cur, wr, wc, fr, fq);
        if (!has_next) break;
        if (!(Epi::KEEP && cur.sub + 1 < g.nsub)) {
#pragma unroll
            for (int a = 0; a < 2; ++a)
#pragma unroll
                for (int b = 0; b < 2; ++b)
#pragma unroll
                    for (int m = 0; m < 4; ++m)
#pragma unroll
                        for (int n = 0; n < 2; ++n) acc[a][b][m][n] = (f32x4){0.f, 0.f, 0.f, 0.f};
        }
        cur = nxt; cA = nA; cB = nB; ++ui;
    }
    PG8_WAIT_V(0);
    if (wr == 0) PG8_BAR;
    PG8_BAR;
#undef PG8_SA
#undef PG8_SB
#undef PG8_STAGE
#undef PG8_LDA
#undef PG8_LDB
#undef PG8_MMA
#undef PG8_WAIT_V
#undef PG8_WAIT_L
#undef PG8_BAR
#undef PG8_SCHED
}
}

typedef f32x4 AccT[2][2][4][2];
struct EpiIn {
    static constexpr bool PERM = true, KEEP = false;
    bf16_t* P; bf16_t* VTa; bf16_t* VTs;
    __device__ __forceinline__ void operator()(AccT& acc, const pg8::Unit& u, int wr, int wc, int fr, int fq) const {
        const int row0 = u.pm * 256 + wr * 64 + fr, trow = u.pm * 256;
        int b, tokbase; if (trow < ML) { b = trow >> 13; tokbase = trow & 8191; } else { b = (trow - ML) >> 8; tokbase = 8192; }
#pragma unroll
        for (int bj = 0; bj < 2; ++bj) {
            int pc = -1;
            if (u.pn < 10) pc = 256 * u.pn + 128 * bj; else if (u.pn == 10) { if (bj == 0) pc = 2560; } else if (u.pn >= 13) pc = 2688 + 256 * (u.pn - 13) + 128 * bj;
            if (pc >= 0) {
#pragma unroll
                for (int ai = 0; ai < 2; ++ai)
#pragma unroll
                    for (int m = 0; m < 4; ++m) { bf16_t* rowp = P + (size_t)(row0 + ai * 128 + m * 16) * PW + pc + wc * 32 + 8 * fq;
                        const f32x4 v0 = acc[ai][bj][m][0], v1 = acc[ai][bj][m][1];
                        u32x4 w; w.x = pk2(v0[0], v0[1]); w.y = pk2(v0[2], v0[3]); w.z = pk2(v1[0], v1[1]); w.w = pk2(v1[2], v1[3]);
                        *(u32x4*)rowp = w; }
            } else {
                const bool isS = (u.pn == 10); bf16_t* VT = isS ? VTs : VTa; const int nh = isS ? 2 : 8;
                const int cl = (isS ? 0 : 256 * (u.pn - 11) + 128 * bj) + 32 * wc + 8 * fq;
#pragma unroll
                for (int ai = 0; ai < 2; ++ai)
#pragma unroll
                    for (int m = 0; m < 4; ++m) { const int tok = tokbase + wr * 64 + fr + ai * 128 + m * 16;
#pragma unroll
                        for (int n = 0; n < 2; ++n) { const f32x4 v = acc[ai][bj][m][n]; const unsigned w0 = pk2(v[0], v[1]), w1 = pk2(v[2], v[3]);
                            const int c = cl + 4 * n; bf16_t* base = VT + ((size_t)(b * nh + (c >> 6)) * 64 + (c & 63)) * VTOK + tok;
                            base[0] = (bf16_t)(w0 & 0xffff); base[VTOK] = (bf16_t)(w0 >> 16); base[2 * VTOK] = (bf16_t)(w1 & 0xffff); base[3 * VTOK] = (bf16_t)(w1 >> 16); } }
            }
        }
    }
};
struct EpiMerge {
    static constexpr bool PERM = true, KEEP = true;
    const bf16_t* P; bf16_t* Mo;
    __device__ __forceinline__ void operator()(AccT& acc, const pg8::Unit& u, int wr, int wc, int fr, int fq) const {
        const int row0 = u.pm * 256 + wr * 64 + fr, col0 = u.pn * 256 + wc * 32 + 8 * fq;
        const int gc = (u.sub == 0) ? C_GA : (u.sub == 1 ? C_GR : C_GS), gn = (u.sub == 0) ? C_GR : C_GS;
        const bool lastsub = (u.sub == 2);
#pragma unroll
        for (int ai = 0; ai < 2; ++ai)
#pragma unroll
            for (int m = 0; m < 4; ++m) { const size_t row = (size_t)(row0 + ai * 128 + m * 16);
#pragma unroll
                for (int bj = 0; bj < 2; ++bj) { const int col = col0 + bj * 128;
                    const u32x4 wcur = *(const u32x4*)(P + row * PW + gc + col);
                    u32x4 wnx = wcur; if (!lastsub) wnx = *(const u32x4*)(P + row * PW + gn + col);
                    float f[8];
#pragma unroll
                    for (int q = 0; q < 4; ++q) {
                        const float c0 = bflo(wcur[q]), c1 = bfhi(wcur[q]), n0 = bflo(wnx[q]), n1 = bfhi(wnx[q]);
                        const float d0 = 1.f + fexp2(fminf(-c0 * LOG2E, 100.f)), d1 = 1.f + fexp2(fminf(-c1 * LOG2E, 100.f));
                        const float u0 = lastsub ? 1.f : 1.f + fexp2(fminf(-n0 * LOG2E, 100.f)), u1 = lastsub ? 1.f : 1.f + fexp2(fminf(-n1 * LOG2E, 100.f));
                        f[2 * q] = u0 * frcp(d0); f[2 * q + 1] = u1 * frcp(d1);
                    }
                    f32x4 v0 = acc[ai][bj][m][0], v1 = acc[ai][bj][m][1];
                    v0[0] *= f[0]; v0[1] *= f[1]; v0[2] *= f[2]; v0[3] *= f[3]; v1[0] *= f[4]; v1[1] *= f[5]; v1[2] *= f[6]; v1[3] *= f[7];
                    acc[ai][bj][m][0] = v0; acc[ai][bj][m][1] = v1;
                    if (lastsub) { u32x4 w; w.x = pk2(v0[0], v0[1]); w.y = pk2(v0[2], v0[3]); w.z = pk2(v1[0], v1[1]); w.w = pk2(v1[2], v1[3]);
                        *(u32x4*)(Mo + row * D + col) = w; }
                } }
    }
};
struct EpiRes {
    static constexpr bool PERM = false, KEEP = false;
    float* XL; float* XCp; const float* modl; int gidx; bool dry; float* PART;
    __device__ __forceinline__ void operator()(AccT& acc, const pg8::Unit& u, int wr, int wc, int fr, int fq) const {
        const int trow = u.pm * 256, row0 = trow + wr * 64 + fr, col0 = u.pn * 256 + wc * 32 + 4 * fq;
        const int v = trow < ML ? (trow >> 13) : 4;
        float* Xb = trow < ML ? XL + (size_t)row0 * D : XCp + (size_t)(row0 - ML) * D;
        f32x4 gv[2][2];
#pragma unroll
        for (int bj = 0; bj < 2; ++bj)
#pragma unroll
            for (int n = 0; n < 2; ++n) gv[bj][n] = *(const f32x4*)(modl + v * 6144 + gidx * 1024 + col0 + bj * 128 + n * 16);
#pragma unroll
        for (int ai = 0; ai < 2; ++ai)
#pragma unroll
            for (int m = 0; m < 4; ++m) { float* rowp = Xb + (size_t)(ai * 128 + m * 16) * D + col0;
#pragma unroll
                for (int bj = 0; bj < 2; ++bj)
#pragma unroll
                    for (int n = 0; n < 2; ++n) { f32x4* p = (f32x4*)(rowp + bj * 128 + n * 16);
                        if (u.split) { const f32x4 dv = gv[bj][n] * acc[ai][bj][m][n]; if (!dry) *(f32x4*)(PART + ((size_t)u.ks * MC + (row0 - ML) + ai * 128 + m * 16) * D + col0 + bj * 128 + n * 16) = dv; }
                        else { f32x4 xv = *p; xv += gv[bj][n] * acc[ai][bj][m][n]; if (!dry) *p = xv; } } }
    }
};
struct EpiFF1 {
    static constexpr bool PERM = true, KEEP = false;
    bf16_t* Hd;
    __device__ __forceinline__ void operator()(AccT& acc, const pg8::Unit& u, int wr, int wc, int fr, int fq) const {
        const int row0 = u.pm * 256 + wr * 64 + fr, col0 = u.pn * 256 + wc * 32 + 8 * fq;
#pragma unroll
        for (int ai = 0; ai < 2; ++ai)
#pragma unroll
            for (int m = 0; m < 4; ++m) { bf16_t* rowp = Hd + (size_t)(row0 + ai * 128 + m * 16) * DFF + col0;
#pragma unroll
                for (int bj = 0; bj < 2; ++bj) { f32x4 v0 = acc[ai][bj][m][0], v1 = acc[ai][bj][m][1];
#pragma unroll
                    for (int j = 0; j < 4; ++j) { const float a = fmaxf(v0[j], 0.f), b = fmaxf(v1[j], 0.f); v0[j] = a * a; v1[j] = b * b; }
                    u32x4 w; w.x = pk2(v0[0], v0[1]); w.y = pk2(v0[2], v0[3]); w.z = pk2(v1[0], v1[1]); w.w = pk2(v1[2], v1[3]);
                    *(u32x4*)(rowp + bj * 128) = w; } }
    }
};

__device__ __forceinline__ void transpose_item(const float* W, int ldn, int k0, int nsrc0, bf16_t* WT, int ldt, int ndst0, LAS float* scr, int lane) {
#pragma unroll 8
    for (int i = 0; i < 32; ++i) { const int kk = 2 * i + (lane >> 5); scr[kk * 33 + (lane & 31)] = W[(size_t)(k0 + kk) * ldn + nsrc0 + (lane & 31)]; }
    asm volatile("s_waitcnt lgkmcnt(0)" ::: "memory");
    const int c = lane & 7;
#pragma unroll
    for (int j = 0; j < 4; ++j) { const int n = (lane >> 3) + 8 * j; const LAS float* s = scr + (8 * c) * 33 + n;
        u32x4 o; o.x = pk2(s[0 * 33], s[1 * 33]); o.y = pk2(s[2 * 33], s[3 * 33]); o.z = pk2(s[4 * 33], s[5 * 33]); o.w = pk2(s[6 * 33], s[7 * 33]);
        *(u32x4*)(WT + (size_t)(ndst0 + n) * ldt + k0 + 8 * c) = o; }
    asm volatile("s_waitcnt lgkmcnt(0)" ::: "memory");
}
__device__ __forceinline__ void conv_seg(int& base, int gw, int NGW, const float* W, int K, int ldn, int nsrc0, int ncols, bf16_t* WT, int ldt, int ndst0, LAS float* scr, int lane) {
    const int nblk = ncols / 32, nitems = (K / 64) * nblk;
    int first = base + (((gw - base) % NGW) + NGW) % NGW;
    for (int it = first; it < base + nitems; it += NGW) { const int r = it - base, kb = r / nblk, nb = r - kb * nblk;
        transpose_item(W, ldn, 64 * kb, nsrc0 + 32 * nb, WT, ldt, ndst0 + 32 * nb, scr, lane); }
    base += nitems;
}
__device__ __forceinline__ void convert_stage_a(const KArgs& a, int l, int gw, int NGW, LAS float* scr, int) {
    const int lane = lane_id_asm();
    const float* W = a.w_in + (size_t)l * D * WIN; bf16_t* WT = (bf16_t*)(a.ws + WS_WB); int base = 0;
    conv_seg(base, gw, NGW, W, D, WIN, 0, 1024, WT, D, 0, scr, lane);
    conv_seg(base, gw, NGW, W, D, WIN, 1536, 1024, WT, D, 1024, scr, lane);
    conv_seg(base, gw, NGW, W, D, WIN, 2560, 512, WT, D, 2048, scr, lane);
    conv_seg(base, gw, NGW, W, D, WIN, 3072, 256, WT, D, 2560, scr, lane);
    conv_seg(base, gw, NGW, W, D, WIN, 1024, 512, WT, D, 2816, scr, lane);
    conv_seg(base, gw, NGW, W, D, WIN, 3328, 3072, WT, D, 3328, scr, lane);
}
__device__ __forceinline__ void convert_stage_b(const KArgs& a, int l, int gw, int NGW, LAS float* scr, int) {
    const int lane = lane_id_asm();
    bf16_t* WB = (bf16_t*)(a.ws + WS_WB); int base = 0;
    const float* wbr = a.w_branch + (size_t)l * 1536 * D;
    for (int i = 0; i < 3; ++i) conv_seg(base, gw, NGW, wbr + (size_t)i * 512 * D, 512, D, 0, D, WB + WB_BR + i * 524288, 512, 0, scr, lane);
    conv_seg(base, gw, NGW, a.w_out + (size_t)l * D * D, D, D, 0, D, WB + WB_OUT, D, 0, scr, lane);
    conv_seg(base, gw, NGW, a.w_ff1 + (size_t)l * D * DFF, D, DFF, 0, DFF, WB + WB_FF1, D, 0, scr, lane);
    conv_seg(base, gw, NGW, a.w_ff2 + (size_t)l * DFF * D, DFF, D, 0, D, WB + WB_FF2, DFF, 0, scr, lane);
}

__device__ __forceinline__ void phase0(const KArgs& a, LAS unsigned char* lds, int gw, int NGW, int wave, int lane) {
    LAS float* cond = (LAS float*)lds;
    LAS float* red = (LAS float*)(lds + 20480);
    const int tid = wave * 64 + lane;
    for (int i = tid; i < 5 * D; i += 512) { const int v = i >> 10, k = i & 1023; const float cv = v < 4 ? a.c[v * D + k] : a.c_ctx[k]; cond[i] = cv / (1.f + __expf(-cv)); }
    __syncthreads();
    float* mods = (float*)(a.ws + WS_MOD);
    const int col = tid & 127, kq = tid >> 7;
    for (int task = blockIdx.x; task < NL * 48; task += gridDim.x) {
        const int l = task / 48, cc = (task % 48) * 128 + col;
        const float* W = a.w_mod + (size_t)l * D * 6144 + cc;
        float s0 = 0.f, s1 = 0.f, s2 = 0.f, s3 = 0.f, s4 = 0.f;
#pragma unroll 8
        for (int k = kq * 256; k < kq * 256 + 256; ++k) { const float w = W[(size_t)k * 6144];
            s0 += w * cond[k]; s1 += w * cond[1024 + k]; s2 += w * cond[2048 + k]; s3 += w * cond[3072 + k]; s4 += w * cond[4096 + k]; }
        red[(kq * 5 + 0) * 128 + col] = s0; red[(kq * 5 + 1) * 128 + col] = s1; red[(kq * 5 + 2) * 128 + col] = s2; red[(kq * 5 + 3) * 128 + col] = s3; red[(kq * 5 + 4) * 128 + col] = s4;
        __syncthreads();
        for (int o = tid; o < 5 * 128; o += 512) { const int v = o >> 7, c2 = o & 127, ccol = (task % 48) * 128 + c2;
            const float r = red[(0 * 5 + v) * 128 + c2] + red[(1 * 5 + v) * 128 + c2] + red[(2 * 5 + v) * 128 + c2] + red[(3 * 5 + v) * 128 + c2];
            mods[((size_t)l * 5 + v) * 6144 + ccol] = r + a.b_mod[l * 6144 + ccol]; }
        __syncthreads();
    }
    __syncthreads();
    LAS float* scr = (LAS float*)(lds + 32768 + wave * 8448);
    bf16_t* LW = (bf16_t*)(a.ws + WS_LW);
    for (int it = gw; it < NL * 2 * 2 * 8 * 2; it += NGW) { const int half = it & 1, mi = it >> 1, n = mi & 7, mat = (mi >> 3) & 1, ld = mi >> 4;
        const float* W = (mat ? a.lru_wx : a.lru_wa) + ((size_t)ld * 8 + n) * 4096;
        transpose_item(W, 64, 0, 32 * half, LW + ((size_t)(ld * 2 + mat) * 8 + n) * 4096, 64, 32 * half, scr, lane); }
    convert_stage_a(a, 0, gw, NGW, scr, lane);
}

__device__ __forceinline__ void norm_phase(const KArgs& a, int l, bool second, int nrows, int gw, int NGW, int lane, int npart) {
    const bool first_read = (l == 0 && !second);
    const float* srcL = first_read ? a.x : a.out; const float* srcC = first_read ? a.ctx : (const float*)(a.ws + WS_XC);
    float* XC = (float*)(a.ws + WS_XC); bf16_t* H = (bf16_t*)(a.ws + WS_H);
    const float* g = (second ? a.norm2_g : a.norm1_g) + l * D; const float* modl = (const float*)(a.ws + WS_MOD) + (size_t)l * 5 * 6144; const int sidx = second ? 3 : 0;
    for (int row = gw; row < nrows; row += NGW) {
        const float* src = row < ML ? srcL + (size_t)row * D : srcC + (size_t)(row - ML) * D; const int v = row < ML ? (row >> 13) : 4;
        const f32x4* xr = (const f32x4*)src + lane; f32x4 xv[4]; float s = 0.f;
#pragma unroll
        for (int j = 0; j < 4; ++j) xv[j] = xr[64 * j];
        if (row >= ML && npart > 0) {
            const float* PART = (const float*)(a.ws + WS_PART);
            for (int sp = 0; sp < npart; ++sp) { const f32x4* pr = (const f32x4*)(PART + ((size_t)sp * MC + (row - ML)) * D) + lane;
#pragma unroll
                for (int j = 0; j < 4; ++j) xv[j] += pr[64 * j]; }
            f32x4* xw = (f32x4*)(XC + (size_t)(row - ML) * D) + lane;
#pragma unroll
            for (int j = 0; j < 4; ++j) xw[64 * j] = xv[j];
        }
#pragma unroll
        for (int j = 0; j < 4; ++j) s += (xv[j][0] * xv[j][0] + xv[j][1] * xv[j][1]) + (xv[j][2] * xv[j][2] + xv[j][3] * xv[j][3]);
        const float rstd = 1.0f / sqrtf(wave_sum(s) * (1.f / D) + 1e-6f);
        if (first_read) { f32x4* cp = (f32x4*)(row < ML ? a.out + (size_t)row * D : XC + (size_t)(row - ML) * D) + lane;
#pragma unroll
            for (int j = 0; j < 4; ++j) cp[64 * j] = xv[j]; }
        u32x2* o8 = (u32x2*)(H + (size_t)row * D) + lane;
#pragma unroll
        for (int j = 0; j < 4; ++j) { const int c = 4 * lane + 256 * j; const f32x4 gg = *(const f32x4*)(g + c), sh = *(const f32x4*)(modl + v * 6144 + sidx * 1024 + c), sc = *(const f32x4*)(modl + v * 6144 + (sidx + 1) * 1024 + c);
            f32x4 h = xv[j] * rstd * gg * (sc + 1.0f) + sh; u32x2 w; w.x = pk2(h[0], h[1]); w.y = pk2(h[2], h[3]); o8[64 * j] = w; }
    }
}
__device__ __forceinline__ void final_norm(const KArgs& a, int gw, int NGW, int lane) {
    for (int row = gw; row < ML; row += NGW) {
        f32x4* xr = (f32x4*)(a.out + (size_t)row * D) + lane; f32x4 xv[4]; float s = 0.f;
#pragma unroll
        for (int j = 0; j < 4; ++j) { xv[j] = xr[64 * j]; s += (xv[j][0] * xv[j][0] + xv[j][1] * xv[j][1]) + (xv[j][2] * xv[j][2] + xv[j][3] * xv[j][3]); }
        const float rstd = 1.0f / sqrtf(wave_sum(s) * (1.f / D) + 1e-6f);
#pragma unroll
        for (int j = 0; j < 4; ++j) { const f32x4 gg = *(const f32x4*)(a.final_g + 4 * lane + 256 * j); xr[64 * j] = xv[j] * rstd * gg; }
    }
}

struct AttnSt { f32x4 o[4]; float m, l; };
struct KVF { bf16x8 k[4]; bf16x8 v[4]; };
__device__ __forceinline__ void kv_load(KVF& f, const bf16_t* k0p, const bf16_t* k1p, const bf16_t* vp) {
    f.k[0] = *(const bf16x8*)k0p; f.k[1] = *(const bf16x8*)(k0p + 32); f.k[2] = *(const bf16x8*)k1p; f.k[3] = *(const bf16x8*)(k1p + 32);
#pragma unroll
    for (int dt = 0; dt < 4; ++dt) f.v[dt] = *(const bf16x8*)(vp + (size_t)dt * 16 * VTOK);
}
template <class BiasF>
__device__ __forceinline__ void attn_compute(AttnSt& st, const KVF& f, const bf16x8 (&qf)[2], BiasF bias) {
    f32x4 s0 = {0.f, 0.f, 0.f, 0.f}, s1 = {0.f, 0.f, 0.f, 0.f};
    s0 = MFMA16(f.k[0], qf[0], s0); s0 = MFMA16(f.k[1], qf[1], s0); s1 = MFMA16(f.k[2], qf[0], s1); s1 = MFMA16(f.k[3], qf[1], s1);
    float t[8]; const float SC = 0.125f * LOG2E;
#pragma unroll
    for (int j = 0; j < 4; ++j) { t[j] = bias(j, s0[j] * SC); t[4 + j] = bias(4 + j, s1[j] * SC); }
    float bm = fmaxf(fmaxf(fmaxf(t[0], t[1]), fmaxf(t[2], t[3])), fmaxf(fmaxf(t[4], t[5]), fmaxf(t[6], t[7])));
    bm = fmaxf(bm, __shfl_xor(bm, 16)); bm = fmaxf(bm, __shfl_xor(bm, 32));
    const float mn = fmaxf(st.m, bm), alpha = fexp2(st.m - mn); st.m = mn;
    float ls = 0.f;
#pragma unroll
    for (int j = 0; j < 8; ++j) { t[j] = fexp2(t[j] - mn); ls += t[j]; }
    st.l = st.l * alpha + ls;
    u32x4 pw; pw.x = pk2(t[0], t[1]); pw.y = pk2(t[2], t[3]); pw.z = pk2(t[4], t[5]); pw.w = pk2(t[6], t[7]);
    const bf16x8 pf = __builtin_bit_cast(bf16x8, pw);
#pragma unroll
    for (int dt = 0; dt < 4; ++dt) { st.o[dt] *= alpha; st.o[dt] = MFMA16(f.v[dt], pf, st.o[dt]); }
}
__device__ __forceinline__ void attn_init(AttnSt& st) {
#pragma unroll
    for (int dt = 0; dt < 4; ++dt) st.o[dt] = (f32x4){0.f, 0.f, 0.f, 0.f};
    st.m = -1.0e30f; st.l = 0.f;
}
__device__ __forceinline__ void attn_store(const AttnSt& st, float lextra, bf16_t* orow, int lane, bool dry) {
    float l = st.l; l += __shfl_xor(l, 16); l += __shfl_xor(l, 32); l += lextra;
    const float inv = 1.0f / l; const int g = lane >> 4;
#pragma unroll
    for (int dt = 0; dt < 4; ++dt) { const f32x4 o = st.o[dt] * inv; u32x2 w; w.x = pk2(o[0], o[1]); w.y = pk2(o[2], o[3]); if (!dry) *(u32x2*)(orow + 16 * dt + 4 * g) = w; }
}
__device__ __forceinline__ void na_item(const KArgs& a, int l, int item, int lane, bool dry) {
    bf16_t* P = (bf16_t*)(a.ws + WS_P); const bf16_t* VT = (const bf16_t*)(a.ws + WS_VTA);
    const int i = item & 3, h = (item >> 2) & 7, r = (item >> 5) & 127, b = item >> 12;
    const int c16 = lane & 15, g = lane >> 4, kk0 = 8 * (c16 >> 2) + (c16 & 3);
    const int cq = 16 * i + c16; const size_t qrow = (size_t)b * S + r * 64 + cq;
    bf16x8 qf[2]; qf[0] = *(const bf16x8*)(P + qrow * PW + C_QA + h * 64 + 8 * g); qf[1] = *(const bf16x8*)(P + qrow * PW + C_QA + h * 64 + 32 + 8 * g);
    const int c0 = (i == 0) ? 0 : (i == 1 ? 8 : (i == 2 ? 24 : 32));
    const int rs = min(max(r - 4, 0), 120), cs = min(max(cq - 8, 0), 48);
    unsigned okm = 0; int idx0 = c0 + 8 * g - cq + 15;
#pragma unroll
    for (int e = 0; e < 8; ++e) { const int kc = c0 + 8 * g + e; okm |= ((kc >= cs) && (kc < cs + 16)) ? (1u << e) : 0u; }
    const float* rpb = a.na_rpb + ((size_t)l * 8 + h) * 15 * 31;
    const bf16_t* kcol = P + C_KA + h * 64 + 8 * g; const bf16_t* vrow = VT + (size_t)((b * 8 + h) * 64 + c16) * VTOK + 8 * g;
    AttnSt st; attn_init(st);
    KVF cur, nxt; float bc[8], bn[8];
#pragma unroll
    for (int e = 0; e < 8; ++e) { bc[e] = 0.f; bn[e] = 0.f; }
    auto loadblk = [&](int blk, KVF& f, float (&bb)[8]) {
        if (blk < 8) { const int R = rs + blk; const size_t tok0 = (size_t)R * 64 + c0; const bf16_t* kp = kcol + ((size_t)b * S + tok0 + kk0) * PW;
            kv_load(f, kp, kp + (size_t)4 * PW, vrow + tok0);
            const float* rp = rpb + (R - r + 7) * 31;
#pragma unroll
            for (int e = 0; e < 8; ++e) bb[e] = rp[min(max(idx0 + e, 0), 30)];
        } else { const int cb = blk - 8; const bf16_t* kp = kcol + ((size_t)ML + b * CTX + 32 * cb + kk0) * PW; kv_load(f, kp, kp + (size_t)4 * PW, vrow + 8192 + 32 * cb); }
    };
    loadblk(0, cur, bc);
    for (int blk = 0; blk < 16; ++blk) {
        loadblk(blk < 15 ? blk + 1 : 15, nxt, bn);
        if (blk < 8) attn_compute(st, cur, qf, [&](int e, float s) { return ((okm >> e) & 1u) ? s + bc[e] * LOG2E : NEGBIG; });
        else attn_compute(st, cur, qf, [](int, float s) { return s; });
        cur = nxt;
#pragma unroll
        for (int e = 0; e < 8; ++e) bc[e] = bn[e];
    }
    attn_store(st, 0.f, P + qrow * PW + C_QA + h * 64, lane, dry);
}
__device__ __forceinline__ void ctx_item(const KArgs& a, int l, int item, bool swa, int lane, bool dry) {
    bf16_t* P = (bf16_t*)(a.ws + WS_P);
    const int i = item & 15, h = (item >> 4) & 7, b = item >> 7;
    const int c16 = lane & 15, g = lane >> 4, kk0 = 8 * (c16 >> 2) + (c16 & 3);
    const size_t qrow = (size_t)ML + b * CTX + 16 * i + c16; const int qc = (swa ? C_QS : C_QA) + h * 64;
    bf16x8 qf[2]; qf[0] = *(const bf16x8*)(P + qrow * PW + qc + 8 * g); qf[1] = *(const bf16x8*)(P + qrow * PW + qc + 32 + 8 * g);
    const bf16_t* kcol = P + (swa ? C_KS + (h >> 2) * 64 : C_KA + h * 64) + 8 * g;
    const bf16_t* vrow = (swa ? (const bf16_t*)(a.ws + WS_VTS) + (size_t)((b * 2 + (h >> 2)) * 64 + c16) * VTOK : (const bf16_t*)(a.ws + WS_VTA) + (size_t)((b * 8 + h) * 64 + c16) * VTOK) + 8 * g;
    AttnSt st; attn_init(st);
    for (int cb = 0; cb < 8; ++cb) { KVF f; const bf16_t* kp = kcol + ((size_t)ML + b * CTX + 32 * cb + kk0) * PW; kv_load(f, kp, kp + (size_t)4 * PW, vrow + 8192 + 32 * cb);
        attn_compute(st, f, qf, [](int, float s) { return s; }); }
    const float lex = swa ? fexp2(a.swa_sink[l * 8 + h] * LOG2E - st.m) : 0.f;
    attn_store(st, lex, P + qrow * PW + qc, lane, dry);
}
__device__ __forceinline__ float inv_freq(int f) { return exp2f(-(float)f * (13.287712379549449f / 16.0f)); }
__device__ __forceinline__ void rope_cs(int pos, int f, float& c, float& s) {
    const float ang = (float)pos * inv_freq(f); float rev = ang * 0.15915494309189535f; rev -= rintf(rev);
    c = __builtin_amdgcn_cosf(rev); s = __builtin_amdgcn_sinf(rev);
}
__device__ __forceinline__ void rope_q(bf16x8 (&qf)[2], int tq, int g) {
    const int pos = (g < 2) ? (tq >> 6) : (tq & 63);
    u32x4 w0 = __builtin_bit_cast(u32x4, qf[0]), w1 = __builtin_bit_cast(u32x4, qf[1]);
#pragma unroll
    for (int q = 0; q < 4; ++q) {
        float c0, s0, c1, s1; rope_cs(pos, 8 * (g & 1) + 2 * q, c0, s0); rope_cs(pos, 8 * (g & 1) + 2 * q + 1, c1, s1);
        const float a0 = bflo(w0[q]), a1 = bfhi(w0[q]), b0 = bflo(w1[q]), b1 = bfhi(w1[q]);
        w0[q] = pk2(a0 * c0 - b0 * s0, a1 * c1 - b1 * s1); w1[q] = pk2(b0 * c0 + a0 * s0, b1 * c1 + a1 * s1);
    }
    qf[0] = __builtin_bit_cast(bf16x8, w0); qf[1] = __builtin_bit_cast(bf16x8, w1);
}
__device__ __forceinline__ void swa_item(const KArgs& a, int l, int item, int, bool dry) {
    const int lane = lane_id_asm();
    bf16_t* P = (bf16_t*)(a.ws + WS_P); const bf16_t* VT = (const bf16_t*)(a.ws + WS_VTS);
    const int qt = item & 511, hp = (item >> 9) & 1, kvh = (item >> 10) & 1, b = item >> 11, h0 = 4 * kvh + 2 * hp;
    const int c16 = lane & 15, g = lane >> 4, kk0 = 8 * (c16 >> 2) + (c16 & 3);
    const int tq = 16 * qt + c16; const size_t qrow = (size_t)b * S + tq;
    bf16x8 qa[2], qb[2];
    qa[0] = *(const bf16x8*)(P + qrow * PW + C_QS + h0 * 64 + 8 * g); qa[1] = *(const bf16x8*)(P + qrow * PW + C_QS + h0 * 64 + 32 + 8 * g);
    qb[0] = *(const bf16x8*)(P + qrow * PW + C_QS + h0 * 64 + 64 + 8 * g); qb[1] = *(const bf16x8*)(P + qrow * PW + C_QS + h0 * 64 + 96 + 8 * g);
    rope_q(qa, tq, g); rope_q(qb, tq, g);
    const bf16_t* kcol = P + C_KS + kvh * 64 + 8 * g; const bf16_t* vrow = VT + (size_t)((b * 2 + kvh) * 64 + c16) * VTOK + 8 * g;
    AttnSt sa, sb; attn_init(sa); attn_init(sb);
    const int kstart = 16 * qt - 128;
    int bfirst = 0, blast = 8; while (kstart + 32 * bfirst + 31 < 0) ++bfirst; while (kstart + 32 * blast >= S) --blast;
    const int nblk = (blast - bfirst + 1) + 8;
    KVF cur, nxt;
    auto loadblk = [&](int q, KVF& f) {
        const int lb = bfirst + q;
        if (lb <= blast) { const int k0 = kstart + 32 * lb; const int ka = min(max(k0 + kk0, 0), S - 1), kb = min(max(k0 + kk0 + 4, 0), S - 1), vt = min(max(k0 + 8 * g, 0), S - 8);
            kv_load(f, kcol + ((size_t)b * S + ka) * PW, kcol + ((size_t)b * S + kb) * PW, VT + (size_t)((b * 2 + kvh) * 64 + c16) * VTOK + vt);
        } else { const int cb = lb - blast - 1; const bf16_t* kp = kcol + ((size_t)ML + b * CTX + 32 * cb + kk0) * PW; kv_load(f, kp, kp + (size_t)4 * PW, vrow + 8192 + 32 * cb); }
    };
    loadblk(0, cur);
    for (int q = 0; q < nblk; ++q) {
        loadblk(q + 1 < nblk ? q + 1 : q, nxt);
        const int lb = bfirst + q;
        if (lb <= blast) { const int kbase = kstart + 32 * lb + 8 * g;
            auto msk = [&](int e, float s) { const int k = kbase + e, dlt = k - tq; return ((k >= 0) && (k < S) && (dlt <= 128) && (dlt >= -128)) ? s : NEGBIG; };
            attn_compute(sa, cur, qa, msk); attn_compute(sb, cur, qb, msk);
        } else { attn_compute(sa, cur, qa, [](int, float s) { return s; }); attn_compute(sb, cur, qb, [](int, float s) { return s; }); }
        cur = nxt;
    }
    attn_store(sa, fexp2(a.swa_sink[l * 8 + h0] * LOG2E - sa.m), P + qrow * PW + C_QS + h0 * 64, lane, dry);
    attn_store(sb, fexp2(a.swa_sink[l * 8 + h0 + 1] * LOG2E - sb.m), P + qrow * PW + C_QS + h0 * 64 + 64, lane, dry);
}
__device__ __forceinline__ void rope_k_phase(const KArgs& a, int gw, int NGW, int lane, bool dry) {
    bf16_t* P = (bf16_t*)(a.ws + WS_P);
    const int hd = lane >> 5, i = lane & 31;
    for (int row = gw; row < ML; row += NGW) {
        const int t = row & (S - 1); const int pos = (i < 16) ? (t >> 6) : (t & 63);
        float c, s; rope_cs(pos, i & 15, c, s);
        bf16_t* p = P + (size_t)row * PW + C_KS + hd * 64;
        const float t1 = bf2f(p[i]), t2 = bf2f(p[i + 32]);
        const unsigned w = pk2(t1 * c - t2 * s, t2 * c + t1 * s);
        if (!dry) { p[i] = (bf16_t)(w & 0xffff); p[i + 32] = (bf16_t)(w >> 16); }
    }
}

__device__ __forceinline__ float neg_expm1(float x) {
    const float ser = -x * (1.f + x * (0.5f + x * (0.16666667f + x * (0.041666668f + x * (0.0083333338f + x * 0.0013888889f)))));
    return x > -0.25f ? ser : 1.f - __expf(x);
}
template <int DIR, bool WRITE>
__device__ __forceinline__ void lru_sweep(const KArgs& a, int l, int b, int n, int sp, float (&carry)[4], float (&arun)[4], int lane, bool dry = false) {
    bf16_t* P = (bf16_t*)(a.ws + WS_P); float* HT = (float*)(a.ws + WS_H); const bf16_t* LW = (const bf16_t*)(a.ws + WS_LW);
    const int c16 = lane & 15, g = lane >> 4; const int gg = DIR ? 3 - g : g;
    const bool lat = sp < 64; const int rowbase = lat ? b * S : ML + b * CTX, seglen = lat ? S : CTX, t0 = (lat ? sp : sp - 64) * 128;
    float ba[4], bx[4], spc[4];
#pragma unroll
    for (int nt = 0; nt < 4; ++nt) { const int ch = n * 64 + 16 * nt + c16, o = (l * 2 + DIR) * 512 + ch;
        ba[nt] = a.lru_ba[o]; bx[nt] = a.lru_bx[o]; const float lam = a.lru_lambda[o]; spc[nt] = (lam < -15.f) ? -lam : log1pf(__expf(-lam)); }
    const bf16_t* lwa = LW + ((size_t)((l * 2 + DIR) * 2 + 0) * 8 + n) * 4096 + c16 * 64 + 8 * g;
    const bf16_t* lwx = LW + ((size_t)((l * 2 + DIR) * 2 + 1) * 8 + n) * 4096 + c16 * 64 + 8 * g;
    const float* cw = a.conv_w + (size_t)l * 4 * 512; const float* cbias = a.conv_b + (size_t)l * 512;
    const int srcm = DIR ? lane + 16 : lane - 16, srcm2 = DIR ? lane + 32 : lane - 32, srct = DIR ? c16 : 48 + c16;
    for (int ti = 0; ti < 8; ++ti) {
        asm volatile("" ::: "memory");
        const int tile = DIR ? 7 - ti : ti; const int tt = t0 + 16 * tile; const int t = tt + c16;
        int lv = lane; asm volatile("" : "+v"(lv)); const int idt = (lv & 15) - 8 * (lv >> 4);
        f32x4* HT4 = (f32x4*)HT + ((size_t)((rowbase + tt) >> 2) + g) * 512 + n * 64 + c16;
        f32x4 htv[4]; unsigned short gbr[4][4];
        if (WRITE && DIR == 1) {
#pragma unroll
            for (int nt = 0; nt < 4; ++nt) { htv[nt] = HT4[16 * nt];
#pragma unroll
                for (int j = 0; j < 4; ++j) gbr[nt][j] = P[(size_t)(rowbase + tt + 4 * g + j) * PW + C_GB + n * 64 + 16 * nt + c16]; }
        }
        bf16x8 uf[2];
#pragma unroll
        for (int ks = 0; ks < 2; ++ks) { const int chb = n * 64 + 32 * ks + 8 * g;
            f32x4 u0 = *(const f32x4*)(cbias + chb), u1 = *(const f32x4*)(cbias + chb + 4);
#pragma unroll
            for (int i = 0; i < 4; ++i) { const int tp = t + i - 2; const bool ok = (tp >= 0) && (tp < seglen); const int tc = min(max(tp, 0), seglen - 1);
                const u32x4 xw = *(const u32x4*)(P + (size_t)(rowbase + tc) * PW + C_XB + chb);
                f32x4 w0 = *(const f32x4*)(cw + i * 512 + chb), w1 = *(const f32x4*)(cw + i * 512 + chb + 4);
                if (!ok) { w0 = (f32x4){0.f, 0.f, 0.f, 0.f}; w1 = w0; }
                u0[0] += w0[0] * bflo(xw[0]); u0[1] += w0[1] * bfhi(xw[0]); u0[2] += w0[2] * bflo(xw[1]); u0[3] += w0[3] * bfhi(xw[1]);
                u1[0] += w1[0] * bflo(xw[2]); u1[1] += w1[1] * bfhi(xw[2]); u1[2] += w1[2] * bflo(xw[3]); u1[3] += w1[3] * bfhi(xw[3]); }
            u32x4 pw; pw.x = pk2(u0[0], u0[1]); pw.y = pk2(u0[2], u0[3]); pw.z = pk2(u1[0], u1[1]); pw.w = pk2(u1[2], u1[3]);
            uf[ks] = __builtin_bit_cast(bf16x8, pw); }
#pragma unroll
        for (int nt = 0; nt < 4; ++nt) {
            f32x4 ga = {0.f, 0.f, 0.f, 0.f}, gx = ga, ud = ga;
#pragma unroll
            for (int ks = 0; ks < 2; ++ks) {
                const bf16x8 wa = *(const bf16x8*)(lwa + nt * 1024 + 32 * ks), wx = *(const bf16x8*)(lwx + nt * 1024 + 32 * ks);
                bf16x8 idf;
#pragma unroll
                for (int j = 0; j < 8; ++j) idf[j] = (32 * ks + j == 16 * nt + idt) ? (short)0x3F80 : (short)0;
                ga = MFMA16(uf[ks], wa, ga); gx = MFMA16(uf[ks], wx, gx); ud = MFMA16(uf[ks], idf, ud);
            }
            float av[4], bv[4];
#pragma unroll
            for (int j = 0; j < 4; ++j) {
                const float r = frcp(1.f + __expf(-(ga[j] + ba[nt]))), ii = frcp(1.f + __expf(-(gx[j] + bx[nt])));
                const float la = -8.0f * r * spc[nt];
                av[j] = __expf(la); bv[j] = __builtin_amdgcn_sqrtf(neg_expm1(2.0f * la)) * ii * ud[j];
            }
            float Pj[4], Hj[4];
#pragma unroll
            for (int jj = 0; jj < 4; ++jj) { const int j = DIR ? 3 - jj : jj;
                if (jj == 0) { Pj[0] = av[j]; Hj[0] = bv[j]; } else { Pj[jj] = Pj[jj - 1] * av[j]; Hj[jj] = av[j] * Hj[jj - 1] + bv[j]; } }
            float Ai = Pj[3], Hi = Hj[3];
            { const float A1 = __shfl(Ai, srcm), H1 = __shfl(Hi, srcm); if (gg >= 1) { Hi = Ai * H1 + Hi; Ai = Ai * A1; } }
            { const float A2 = __shfl(Ai, srcm2), H2 = __shfl(Hi, srcm2); if (gg >= 2) { Hi = Ai * H2 + Hi; Ai = Ai * A2; } }
            float Ae = __shfl(Ai, srcm), He = __shfl(Hi, srcm); if (gg == 0) { Ae = 1.f; He = 0.f; }
            const float At = __shfl(Ai, srct), Ht = __shfl(Hi, srct);
            const float cin = Ae * carry[nt] + He;
            if (WRITE) {
                f32x4 hv4;
#pragma unroll
                for (int jj = 0; jj < 4; ++jj) { const int j = DIR ? 3 - jj : jj; hv4[j] = Hj[jj] + Pj[jj] * cin; }
                if (DIR == 0) HT4[16 * nt] = hv4;
                else {
#pragma unroll
                    for (int j = 0; j < 4; ++j) { const float gbv = bf2f(gbr[nt][j]); const float y = htv[nt][j] + hv4[j];
                        const float z = 0.7978845608028654f * (gbv + 0.044715f * gbv * gbv * gbv); const float th = 1.f - 2.f * frcp(1.f + __expf(2.f * z));
                        const float ge = 0.5f * gbv * (1.f + th);
                        if (!dry) P[(size_t)(rowbase + tt + 4 * g + j) * PW + C_GB + n * 64 + 16 * nt + c16] = (bf16_t)(pk2(y * ge, 0.f) & 0xffff); }
                }
            }
            carry[nt] = At * carry[nt] + Ht; arun[nt] *= At;
        }
    }
}
__device__ __forceinline__ void lru_pass1_item(const KArgs& a, int l, int item, int lane) {
    const int dir = item & 1, n = (item >> 1) & 7, rest = item >> 4, sp = rest % 66, b = rest / 66;
    float carry[4] = {0.f, 0.f, 0.f, 0.f}, arun[4] = {1.f, 1.f, 1.f, 1.f};
    if (dir) lru_sweep<1, false>(a, l, b, n, sp, carry, arun, lane); else lru_sweep<0, false>(a, l, b, n, sp, carry, arun, lane);
    float* SUM = (float*)(a.ws + WS_SUM);
    if (lane < 16) {
#pragma unroll
        for (int nt = 0; nt < 4; ++nt) { float* p = SUM + ((size_t)((b * 66 + sp) * 2 + dir) * 512 + n * 64 + 16 * nt + lane) * 2; p[0] = arun[nt]; p[1] = carry[nt]; }
    }
}
template <int DIR>
__device__ __forceinline__ void lru_carry(const float* SUM, int b, int n, int sp, int lane, float (&carry)[4]) {
    typedef float f32x2v __attribute__((ext_vector_type(2)));
    const int c16 = lane & 15, g = lane >> 4;
    const int npred = DIR ? 65 - sp : (sp < 64 ? sp + 2 : sp - 64);
    const int q = (npred + 3) >> 2, i0 = g * q, i1 = min(i0 + q, npred);
    float Ac[4] = {1.f, 1.f, 1.f, 1.f}, Hc[4] = {0.f, 0.f, 0.f, 0.f};
    for (int i = i0; i < i1; i += 4) {
        f32x2v v[4][4];
#pragma unroll
        for (int u = 0; u < 4; ++u) { const int ii = min(i + u, i1 - 1); const int p = DIR ? 65 - ii : (ii < 2 ? 64 + ii : ii - 2);
#pragma unroll
            for (int nt = 0; nt < 4; ++nt) { v[u][nt] = *(const f32x2v*)(SUM + ((size_t)((b * 66 + p) * 2 + DIR) * 512 + n * 64 + 16 * nt + c16) * 2); if (i + u >= i1) v[u][nt] = (f32x2v){1.f, 0.f}; } }
#pragma unroll
        for (int u = 0; u < 4; ++u)
#pragma unroll
            for (int nt = 0; nt < 4; ++nt) { Hc[nt] = v[u][nt].x * Hc[nt] + v[u][nt].y; Ac[nt] = v[u][nt].x * Ac[nt]; }
    }
#pragma unroll
    for (int nt = 0; nt < 4; ++nt) { float c = 0.f;
#pragma unroll
        for (int gi = 0; gi < 4; ++gi) { const float Ag = __shfl(Ac[nt], c16 + 16 * gi), Hg = __shfl(Hc[nt], c16 + 16 * gi); c = Ag * c + Hg; }
        carry[nt] = c; }
}
__device__ __forceinline__ void lru_pass2_item(const KArgs& a, int l, int item, int lane, bool dry) {
    const int n = item & 7, rest = item >> 3, sp = rest % 66, b = rest / 66;
    const float* SUM = (const float*)(a.ws + WS_SUM);
    float carry[4], arun[4] = {1.f, 1.f, 1.f, 1.f};
    lru_carry<0>(SUM, b, n, sp, lane, carry);
    lru_sweep<0, true>(a, l, b, n, sp, carry, arun, lane);
    lru_carry<1>(SUM, b, n, sp, lane, carry);
    lru_sweep<1, true>(a, l, b, n, sp, carry, arun, lane, dry);
}

#define XB_TMO      128
#define XB_XCNT(j)  (256  + 64 * (j))
#define XB_XSUB(j)  (1280 + 64 * (j))
#define XB_XGEN(j)  (2304 + 64 * (j))
#define XB_TOP      3328
#define XB_TOPGEN   3392
#define XCD_BAR_WORDS 3456
#define XB_SPIN_CAP (1u << 18)
__device__ __forceinline__ unsigned xb_ld(unsigned* p)              { return __hip_atomic_load(p, __ATOMIC_RELAXED, __HIP_MEMORY_SCOPE_AGENT); }
__device__ __forceinline__ unsigned xb_add(unsigned* p, unsigned v) { return __hip_atomic_fetch_add(p, v, __ATOMIC_RELAXED, __HIP_MEMORY_SCOPE_AGENT); }
__device__ __forceinline__ unsigned xb_xcc_id() { return (unsigned)__builtin_amdgcn_s_getreg((3 << 11) | 20) & 0xFu; }
#define XB_SPIN(cond, bar) do { unsigned _sp = 0; while (cond) { __builtin_amdgcn_s_sleep(1); \
    if ((++_sp & 255u) == 0u) { if (xb_ld(&(bar)[XB_TMO])) break; if (_sp > XB_SPIN_CAP) { atomicAdd(&(bar)[XB_TMO], 1u); break; } } } } while (0)
struct XcdBarrier { unsigned* bar; unsigned x; volatile LAS unsigned* st; };
__device__ __forceinline__ XcdBarrier xcd_barrier_post(unsigned* bar, volatile LAS unsigned* st) {
    XcdBarrier b; b.bar = bar; b.x = xb_xcc_id(); b.st = st;
    if (threadIdx.x == 0) (void)xb_add(&bar[XB_XCNT(b.x)], 1u);
    return b;
}
__device__ __forceinline__ void xcd_barrier_complete(unsigned* bar, unsigned x, unsigned& nloc, unsigned& nx) {
    const unsigned G = gridDim.x * gridDim.y * gridDim.z;
    unsigned sum, cnt, mine, sp = 0u;
    for (;;) {
        sum = 0u; cnt = 0u; mine = 0u;
#pragma unroll
        for (unsigned j = 0; j < 16; ++j) { const unsigned c = xb_ld(&bar[XB_XCNT(j)]); sum += c; cnt += (c > 0u) ? 1u : 0u; mine = (j == x) ? c : mine; }
        if (sum == G) break;
        __builtin_amdgcn_s_sleep(1);
        if ((++sp & 255u) == 0u) { if (xb_ld(&bar[XB_TMO])) break; if (sp > XB_SPIN_CAP) { atomicAdd(&bar[XB_TMO], 1u); break; } }
    }
    nloc = mine > 0u ? mine : 1u; nx = cnt > 0u ? cnt : 1u;
}
__device__ __forceinline__ void xcd_barrier(const XcdBarrier& b) {
    asm volatile("s_waitcnt vmcnt(0)" ::: "memory");
    __syncthreads();
    if (threadIdx.x == 0) {
        unsigned* bar = b.bar;
        __builtin_amdgcn_s_waitcnt(0);
        unsigned nloc = b.st[0], nx = b.st[1];
        if (nloc == 0u) { xcd_barrier_complete(bar, b.x, nloc, nx); b.st[0] = nloc; b.st[1] = nx; }
        const unsigned old = xb_add(&bar[XB_XSUB(b.x)], 1u);
        const unsigned gen = old / nloc;
        if (old + 1u == (gen + 1u) * nloc) {
            __builtin_amdgcn_fence(__ATOMIC_RELEASE, "agent");
            asm volatile("s_waitcnt vmcnt(0)" ::: "memory");
            const unsigned og = xb_add(&bar[XB_TOP], 1u);
            const unsigned tg = og / nx;
            if (og + 1u == (tg + 1u) * nx) xb_add(&bar[XB_TOPGEN], 1u);
            else XB_SPIN(xb_ld(&bar[XB_TOPGEN]) == tg, bar);
            __builtin_amdgcn_fence(__ATOMIC_ACQUIRE, "agent");
            xb_add(&bar[XB_XGEN(b.x)], 1u);
            asm volatile("s_waitcnt vmcnt(0)" ::: "memory");
        } else {
            XB_SPIN(xb_ld(&bar[XB_XGEN(b.x)]) == gen, bar);
            __builtin_amdgcn_fence(__ATOMIC_ACQUIRE, "agent");
            asm volatile("s_waitcnt vmcnt(0)" ::: "memory");
        }
    }
    __syncthreads();
}

__global__ void __launch_bounds__(512, 2) fwd_kernel(KArgs a) {
    extern __shared__ __attribute__((aligned(16))) unsigned char smem[];
    LAS unsigned char* lds = (LAS unsigned char*)smem;
    cg::grid_group grid = cg::this_grid();
    const int G = gridDim.x, NGW = G * 8;
    const int wave = __builtin_amdgcn_readfirstlane(threadIdx.x >> 6);
    volatile LAS unsigned* bst = (volatile LAS unsigned*)(lds + 131072);
    if (threadIdx.x < 2) bst[threadIdx.x] = 0u;
    __syncthreads();
    XcdBarrier xbar; xbar.bar = (unsigned*)(a.ws + WS_BAR); xbar.x = 0; xbar.st = bst;
    if (a.ph_hi - a.ph_lo > 1) xbar = xcd_barrier_post((unsigned*)(a.ws + WS_BAR), bst);
    for (int ph = a.ph_lo; ph < a.ph_hi; ++ph) {
        bf16_t* P = (bf16_t*)(a.ws + WS_P); bf16_t* H = (bf16_t*)(a.ws + WS_H); bf16_t* WB = (bf16_t*)(a.ws + WS_WB);
        float* XC = (float*)(a.ws + WS_XC);
        int lane = lane_id_asm(); const int gw = blockIdx.x * 8 + wave;
        if (ph == 0) phase0(a, lds, gw, NGW, wave, lane);
        else if (ph == 37) final_norm(a, gw, NGW, lane);
        else {
            const int l = (ph - 1) / 9, k = (ph - 1) % 9; const bool lastl = (l == NL - 1); const int Mrows = lastl ? ML : MT;
            const float* modl = (const float*)(a.ws + WS_MOD) + (size_t)l * 5 * 6144;
            const int reps = ((PROBE_MASK >> k) & 1) ? 2 : 1;
            for (int rep = 0; rep < reps; ++rep) { const bool dry = (rep + 1 < reps);
            if (rep) { xcd_barrier(xbar); lane = lane_id_asm(); }
            if (k == 0) {
                norm_phase(a, l, false, MT, gw, NGW, lane, l > 0 ? 8 : 0);
                if (l > 0) convert_stage_a(a, l, gw, NGW, (LAS float*)(lds + wave * 8448), lane);
            } else if (k == 1) {
                pg8::Gemm g{H, WB, 1}; pg8::Order So; So.init(MT, WIN, G, blockIdx.x, 1, D);
                EpiIn E{P, (bf16_t*)(a.ws + WS_VTA), (bf16_t*)(a.ws + WS_VTS)};
                #ifndef NO_EPIIN
                pg8::gemm_phase<EpiIn, D, D, D>(lds, g, So, E, wave);
#endif
            } else if (k == 2) {
                convert_stage_b(a, l, gw, NGW, (LAS float*)(lds + wave * 8448), lane);
                rope_k_phase(a, gw, NGW, lane, dry);
                constexpr int N1 = NB * 66 * 8 * 2, N2 = N1 + NB * 128 * 8 * 4 / 2, N3 = N2 + NB * 8 * 16;
                unsigned* ctr = (unsigned*)(a.ws + WS_BAR) + 8 * (2 * l + 0 + 2 * NL * rep);
                for (;;) {
                    int it = 0; if (lane == 0) it = (int)__hip_atomic_fetch_add(ctr, 1u, __ATOMIC_RELAXED, __HIP_MEMORY_SCOPE_AGENT);
                    it = __builtin_amdgcn_readfirstlane(it);
                    if (it >= (lastl ? N2 : N3)) break;
                    if (it < N1) { if ((PROBE_MASK >> 12) & 1) lru_pass1_item(a, l, it, lane); lru_pass1_item(a, l, it, lane); }
                    else if (it < N2) { if ((PROBE_MASK >> 13) & 1) { na_item(a, l, 2 * (it - N1), lane, true); na_item(a, l, 2 * (it - N1) + 1, lane, true); } na_item(a, l, 2 * (it - N1), lane, dry); na_item(a, l, 2 * (it - N1) + 1, lane, dry); }
                    else ctx_item(a, l, it - N2, false, lane, dry);
                }
            } else if (k == 3) {
                constexpr int N1 = NB * 66 * 8, N2 = N1 + NB * 4 * 512, N3 = N2 + NB * 8 * 16;
                unsigned* ctr = (unsigned*)(a.ws + WS_BAR) + 8 * (2 * l + 1 + 2 * NL * rep);
                for (;;) {
                    int it = 0; if (lane == 0) it = (int)__hip_atomic_fetch_add(ctr, 1u, __ATOMIC_RELAXED, __HIP_MEMORY_SCOPE_AGENT);
                    it = __builtin_amdgcn_readfirstlane(it);
                    if (it >= (lastl ? N2 : N3)) break;
                    if (it < N1) { if ((PROBE_MASK >> 14) & 1) lru_pass2_item(a, l, it, lane, true); lru_pass2_item(a, l, it, lane, dry); }
                    else if (it < N2) { if ((PROBE_MASK >> 15) & 1) swa_item(a, l, it - N1, lane, true); swa_item(a, l, it - N1, lane, dry); }
                    else ctx_item(a, l, it - N2, true, lane, dry);
                }
            } else if (k == 4) {
                pg8::Gemm g{P, WB + WB_BR, 3}; pg8::Order So; So.init(Mrows, D, G, blockIdx.x, 3, 512);
                EpiMerge E{P, H};
                #ifndef NO_EPIMERGE
                pg8::gemm_phase<EpiMerge, PW, 512, 512, C_QA, C_GB, C_QS, 524288>(lds, g, So, E, wave);
#endif
            } else if (k == 5) {
                pg8::Gemm g{H, WB + WB_OUT, 1}; pg8::Order So; So.init(ML, D, G, blockIdx.x, 1, D, lastl ? 0 : MC / 256, 4);
                EpiRes E{a.out, XC, modl, 2, dry, (float*)(a.ws + WS_PART)};
#ifndef NO_EPIRES
                pg8::gemm_phase<EpiRes, D, D, D>(lds, g, So, E, wave);
#endif
            } else if (k == 8) {
                pg8::Gemm g{P, WB + WB_FF2, 1}; pg8::Order So; So.init(ML, D, G, blockIdx.x, 1, DFF, lastl ? 0 : MC / 256, 8);
                EpiRes E{a.out, XC, modl, 5, dry, (float*)(a.ws + WS_PART)};
#ifndef NO_EPIRES
                pg8::gemm_phase<EpiRes, DFF, DFF, DFF>(lds, g, So, E, wave);
#endif
            } else if (k == 6) {
                norm_phase(a, l, true, Mrows, gw, NGW, lane, lastl ? 0 : 4);
            } else if (k == 7) {
                pg8::Gemm g{H, WB + WB_FF1, 1}; pg8::Order So; So.init(Mrows, DFF, G, blockIdx.x, 1, D);
                EpiFF1 E{P};
                #ifndef NO_EPIFF1
                pg8::gemm_phase<EpiFF1, D, D, D>(lds, g, So, E, wave);
#endif
            }
            }
        }
        if (ph + 1 < a.ph_hi) { if (ph == 0 || !USE_XCD_BAR) { __syncthreads(); grid.sync(); } else xcd_barrier(xbar); if ((PROBE_MASK >> 9) & 1) xcd_barrier(xbar); }
    }
}

extern "C" void kernel_launch(void* const* d_in, const int* in_sizes, int n_in, void* d_out, int out_size, void* d_ws, size_t ws_size, hipStream_t stream) {
    static int grid = 0;
    if (grid == 0) {
        if (n_in != 23 || ws_size < WS_END) { fprintf(stderr, "kernel_launch: unexpected n_in %d or ws_size %zu (< %zu)\n", n_in, ws_size, (size_t)WS_END); grid = -1; return; }
        int dev = 0, cus = 0, per_cu = 0;
        hipGetDevice(&dev); hipDeviceGetAttribute(&cus, hipDeviceAttributeMultiprocessorCount, dev);
        if (hipFuncSetAttribute((const void*)fwd_kernel, hipFuncAttributeMaxDynamicSharedMemorySize, LDS_BYTES) != hipSuccess) { fprintf(stderr, "hipFuncSetAttribute failed\n"); grid = -1; return; }
        if (hipOccupancyMaxActiveBlocksPerMultiprocessor(&per_cu, (const void*)fwd_kernel, 512, LDS_BYTES) != hipSuccess || per_cu < 1) { fprintf(stderr, "occupancy query: %d\n", per_cu); per_cu = 1; }
        (void)hipGetLastError();
        grid = cus;
    }
    if (grid < 0) return;
    KArgs a{};
    const float** f = (const float**)&a;
    for (int i = 0; i < 23; ++i) f[i] = (const float*)d_in[i];
    a.out = (float*)d_out; a.ws = (unsigned char*)d_ws;
#if N_LAUNCHES == 1
    a.ph_lo = 0; a.ph_hi = 38;
    if (hipMemsetAsync((unsigned char*)d_ws + WS_BAR, 0, XCD_BAR_WORDS * 4, stream) != hipSuccess) { fprintf(stderr, "memset failed\n"); return; }
    void* args[] = {&a};
    hipError_t e = hipLaunchCooperativeKernel((const void*)fwd_kernel, dim3(grid), dim3(512), args, LDS_BYTES, stream);
    if (e != hipSuccess) fprintf(stderr, "cooperative launch failed: %s (grid %d)\n", hipGetErrorString(e), grid);
#else
    for (int ph = 0; ph < 38; ++ph) { a.ph_lo = ph; a.ph_hi = ph + 1; hipLaunchKernelGGL(fwd_kernel, dim3(grid), dim3(512), LDS_BYTES, stream, a); }
#endif
}
```

```cpp
#include <hip/hip_runtime.h>
#include <hip/hip_cooperative_groups.h>
#include <cstdio>
#include <cstdint>
namespace cg = cooperative_groups;

#ifndef N_LAUNCHES
#define N_LAUNCHES 1
#endif

#ifndef USE_XCD_BAR
#define USE_XCD_BAR 1
#endif
#ifndef STAGGER_TICKS
#define STAGGER_TICKS 0
#endif
#ifndef PROBE_MASK
#define PROBE_MASK 0
#endif
#define LAS __attribute__((address_space(3)))
typedef unsigned short bf16_t;
typedef short bf16x8 __attribute__((ext_vector_type(8)));
typedef short s16x4 __attribute__((ext_vector_type(4)));
typedef float f32x4 __attribute__((ext_vector_type(4)));
typedef unsigned u32x4 __attribute__((ext_vector_type(4)));
typedef unsigned u32x2 __attribute__((ext_vector_type(2)));

constexpr int D = 1024, NB = 4, S = 8192, CTX = 256, ML = NB * S, MC = NB * CTX, MT = ML + MC, NL = 4, DFF = 4096;
constexpr int PW = 2688;
constexpr int GCH = 384;
constexpr int C_QA = 0, C_KA = 512, C_XB = 1024, C_GB = 1536, C_QS = 2048, C_KS = 2560, C_GA = 0, C_GR = 1024, C_GS = 2048;
constexpr int VTOK = 8448;
constexpr int WIN = 6400;
constexpr size_t MiB = 1u << 20;
constexpr size_t WS_XC = 0, WS_H = 4 * MiB, WS_P = 70 * MiB, WS_G = WS_P + (size_t)MT * PW * 2, WS_VTA = WS_P + (size_t)MT * 5760 * 2, WS_VTS = WS_VTA + (size_t)NB * 8 * 64 * VTOK * 2,
                 WS_WB = WS_VTS + (size_t)NB * 2 * 64 * VTOK * 2, WS_MOD = WS_WB + 21 * MiB, WS_SUM = WS_MOD + MiB / 2, WS_LW = WS_SUM + 5 * MiB / 2, WS_BAR = WS_LW + MiB, WS_PART = WS_P + 264 * MiB, WS_END = WS_BAR + 16384;
constexpr int WB_BR = 0, WB_OUT = 3 * 524288, WB_FF1 = WB_OUT + 1048576, WB_FF2 = WB_FF1 + 4194304;
constexpr int WAVE_LDS = 19712;
constexpr int LDS_BYTES = 8 * WAVE_LDS + 64;
constexpr float LOG2E = 1.4426950408889634f;
constexpr float NEGBIG = -3.0e38f;

struct KArgs {
    const float *x, *c, *ctx, *c_ctx, *w_mod, *b_mod, *norm1_g, *norm2_g, *w_in, *na_rpb, *conv_w, *conv_b, *lru_wa, *lru_ba, *lru_wx, *lru_bx, *lru_lambda,
        *swa_sink, *w_branch, *w_out, *w_ff1, *w_ff2, *final_g;
    float* out; unsigned char* ws; int ph_lo, ph_hi;
};

typedef __bf16 bf16x2_t __attribute__((ext_vector_type(2)));
typedef float f32x2_t __attribute__((ext_vector_type(2)));
__device__ __forceinline__ unsigned pk2(float lo, float hi) { f32x2_t v = {lo, hi}; bf16x2_t r = __builtin_convertvector(v, bf16x2_t); return __builtin_bit_cast(unsigned, r); }
__device__ __forceinline__ float bf2f(unsigned short b) { return __uint_as_float(((unsigned)b) << 16); }
__device__ __forceinline__ float bflo(unsigned w) { return __uint_as_float(w << 16); }
__device__ __forceinline__ float bfhi(unsigned w) { return __uint_as_float(w & 0xffff0000u); }
__device__ __forceinline__ float fexp2(float x) { return __builtin_amdgcn_exp2f(x); }
__device__ __forceinline__ float frcp(float x) { return __builtin_amdgcn_rcpf(x); }
__device__ __forceinline__ int lane_id_asm() { int l; asm volatile("v_mbcnt_lo_u32_b32 %0, -1, 0\n\tv_mbcnt_hi_u32_b32 %0, -1, %0" : "=v"(l)); return l; }
__device__ __forceinline__ float shfl_lane(float v, int src) { return __uint_as_float((unsigned)__builtin_amdgcn_ds_bpermute(src << 2, (int)__float_as_uint(v))); }
__device__ __forceinline__ float wave_sum(float v, int lane) {
#pragma unroll
    for (int o = 1; o < 64; o <<= 1) v += shfl_lane(v, lane ^ o);
    return v;
}
__device__ __forceinline__ float lane_xor16(float x, int lane) { const unsigned u = __float_as_uint(x); const auto r = __builtin_amdgcn_permlane16_swap(u, u, false, false); return __uint_as_float((lane & 16) ? r[0] : r[1]); }
__device__ __forceinline__ float lane_xor32(float x, int lane) { const unsigned u = __float_as_uint(x); const auto r = __builtin_amdgcn_permlane32_swap(u, u, false, false); return __uint_as_float((lane & 32) ? r[0] : r[1]); }
__device__ __forceinline__ float xmax16(float x) { const unsigned u = __float_as_uint(x); const auto r = __builtin_amdgcn_permlane16_swap(u, u, false, false); const float a = __uint_as_float(r[0]), b = __uint_as_float(r[1]); return a > b ? a : b; }
__device__ __forceinline__ float xmax32(float x) { const unsigned u = __float_as_uint(x); const auto r = __builtin_amdgcn_permlane32_swap(u, u, false, false); const float a = __uint_as_float(r[0]), b = __uint_as_float(r[1]); return a > b ? a : b; }
__device__ __forceinline__ float xsum16(float x) { const unsigned u = __float_as_uint(x); const auto r = __builtin_amdgcn_permlane16_swap(u, u, false, false); return __uint_as_float(r[0]) + __uint_as_float(r[1]); }
__device__ __forceinline__ float xsum32(float x) { const unsigned u = __float_as_uint(x); const auto r = __builtin_amdgcn_permlane32_swap(u, u, false, false); return __uint_as_float(r[0]) + __uint_as_float(r[1]); }
#define MFMA16(a, b, c) __builtin_amdgcn_mfma_f32_16x16x32_bf16((a), (b), (c), 0, 0, 0)

namespace pg8 {
constexpr int BM = 256, BK = 64, HALF = 128, HTB = HALF * BK * 2, STAGE_BYTES = 8 * HTB, NXCD = 8, WGM = 8;
__host__ __device__ __forceinline__ int lds_byte(int r, int c) { const int st = (r >> 4) * 2 + (c >> 5), rr = r & 15, cc = c & 31, ob = rr * 64 + cc * 2; return st * 1024 + (ob ^ (((ob >> 9) & 1) << 5)); }
__host__ __device__ __forceinline__ void stage_rc(int b, int& R, int& C) { const int st = b / 1024, sb = b % 1024, swz = sb ^ (((sb >> 9) & 1) << 5); R = (st >> 1) * 16 + swz / 64; C = (st & 1) * 32 + (swz % 64) / 2; }
__host__ __device__ __forceinline__ int perm32(int rho) { const int n = rho >> 4, i = rho & 15; return 8 * (i >> 2) + 4 * n + (i & 3); }

struct Unit { int pm, pn, sub, koff, nt, split, ks; };
struct Gemm { const bf16_t* A; const bf16_t* Bt; int nsub; };
struct Order {
    int nM, nN, nwg, G, c, nsub, ntK;
    int xM, KS;
    __device__ void init(int M, int N, int G_, int c_, int nsub_, int K, int xM_ = 0, int KS_ = 1) { nM = M / BM; nN = N / BM; nwg = nM * nN; G = G_; c = c_; nsub = nsub_; ntK = K / BK; xM = xM_; KS = KS_; }
    __device__ bool next(int i, Unit& u) const {
        const int ti = i / nsub; u.sub = i - ti * nsub; u.koff = 0; u.nt = ntK; u.split = 0; u.ks = 0;
        const long L = (long)ti * G + c;
        if (L >= nwg) {
            const int idx = (int)(L - nwg); if (idx >= xM * nN * KS) return false;
            const int t = idx / KS, ks = idx - t * KS; u.pm = nM + t / nN; u.pn = t % nN; u.nt = ntK / KS; u.koff = ks * u.nt * BK; u.split = 1; u.ks = ks; return true;
        }
        int wgid = (int)L; { const int q = nwg / NXCD, r = nwg % NXCD, xcd = wgid % NXCD, off = wgid / NXCD; wgid = (xcd < r ? xcd * (q + 1) : r * (q + 1) + (xcd - r) * q) + off; }
        const int nig = WGM * nN, gid = wgid / nig, fm = gid * WGM, gsz = (nM - fm) < WGM ? (nM - fm) : WGM;
        u.pm = fm + ((wgid % nig) % gsz); u.pn = (wgid % nig) / gsz; return true;
    }
};

template <class Epi, int LDA, int LDB, int K, int A0 = 0, int A1 = 0, int A2 = 0, int BS = 0>
__device__ __forceinline__ void gemm_phase(LAS unsigned char* lds, const Gemm g, const Order& S, const Epi& E, int wid, int stagger = 0) {
    if (stagger > 0) { const unsigned long long t0 = __builtin_amdgcn_s_memrealtime(); while (__builtin_amdgcn_s_memrealtime() - t0 < (unsigned long long)stagger) __builtin_amdgcn_s_sleep(8); }
    const int lane = lane_id_asm(), tid = wid * 64 + lane, wr = wid >> 2, wc = wid & 3, fr = lane & 15, fq = lane >> 4;
    unsigned voffA[2], voffB[2];
#pragma unroll
    for (int i = 0; i < 2; ++i) { int R, C; stage_rc(tid * 16 + i * 8192, R, C); const int Rb = Epi::NT ? (64 * (R >> 5) + 4 * (R & 15) + ((R >> 4) & 1)) : (Epi::PERM ? ((R & ~31) + perm32(R & 31)) : R);
        voffA[i] = (unsigned)(R * LDA + C) * 2u; voffB[i] = (unsigned)(Rb * LDB + C) * 2u; }
    constexpr size_t kstep = (size_t)(BK * 2);
    constexpr size_t hstepA = (size_t)HALF * LDA * 2, hstepB = Epi::NT ? (size_t)2 * LDB * 2 : (size_t)HALF * LDB * 2;
    constexpr size_t tstepA = 2 * hstepA, tstepB = (size_t)BM * LDB * 2;
    const unsigned ldsw = (unsigned)wid * 1024u;
    const int aoff = lds_byte(wr * 64 + fr, fq * 8), boff = lds_byte(wc * 32 + fr, fq * 8);
#define PG8_SA(b, h) (((b) * 2 + (h)) * HTB)
#define PG8_SB(b, h) ((4 + (b) * 2 + (h)) * HTB)
#define PG8_STAGE(bufoff, gbase, voff) do { _Pragma("unroll") for (int _i = 0; _i < 2; ++_i) \
        __builtin_amdgcn_global_load_lds((const unsigned*)((const char*)(gbase) + (voff)[_i]), (LAS unsigned*)(lds + (bufoff) + ldsw + _i * 8192), 16, 0, 0); } while (0)
#define PG8_LDA(dst, b, h) do { _Pragma("unroll") for (int m = 0; m < 4; ++m) _Pragma("unroll") for (int k = 0; k < 2; ++k) dst[m][k] = *(const LAS bf16x8*)(lds + PG8_SA(b, h) + aoff + m * 2048 + k * 1024); } while (0)
#define PG8_LDB(dst, b, h) do { _Pragma("unroll") for (int n = 0; n < 2; ++n) _Pragma("unroll") for (int k = 0; k < 2; ++k) dst[n][k] = *(const LAS bf16x8*)(lds + PG8_SB(b, h) + boff + n * 2048 + k * 1024); } while (0)
#define PG8_MMA(ai, bj, At, Bt) do { __builtin_amdgcn_s_setprio(1); _Pragma("unroll") for (int m = 0; m < 4; ++m) _Pragma("unroll") for (int n = 0; n < 2; ++n) _Pragma("unroll") for (int k = 0; k < 2; ++k) \
        acc[ai][bj][m][n] = Epi::NT ? __builtin_amdgcn_mfma_f32_16x16x32_bf16(At[m][k], Bt[n][k], acc[ai][bj][m][n], 0, 0, 0) : __builtin_amdgcn_mfma_f32_16x16x32_bf16(Bt[n][k], At[m][k], acc[ai][bj][m][n], 0, 0, 0); __builtin_amdgcn_s_setprio(0); } while (0)
#define PG8_WAIT_V(n) asm volatile("s_waitcnt vmcnt(" #n ")" ::: "memory")
#define PG8_WAIT_L(n) asm volatile("s_waitcnt lgkmcnt(" #n ")" ::: "memory")
#define PG8_BAR __builtin_amdgcn_s_barrier()
#define PG8_SCHED __builtin_amdgcn_sched_barrier(0)
    Unit cur, nxt; int ui = 0;
    if (!S.next(0, cur)) return;
    f32x4 acc[2][2][4][2];
#pragma unroll
    for (int a = 0; a < 2; ++a)
#pragma unroll
        for (int b = 0; b < 2; ++b)
#pragma unroll
            for (int m = 0; m < 4; ++m)
#pragma unroll
                for (int n = 0; n < 2; ++n) acc[a][b][m][n] = (f32x4){0.f, 0.f, 0.f, 0.f};
    bf16x8 At[4][2], B0[2][2], B1[2][2];
    const char* cA = (const char*)(g.A + (cur.sub == 0 ? A0 : (cur.sub == 1 ? A1 : A2)) + cur.koff) + (size_t)cur.pm * tstepA; const char* cB = (const char*)(g.Bt + (cur.sub * BS) + cur.koff) + (size_t)cur.pn * tstepB;
    PG8_STAGE(PG8_SB(0, 0), cB, voffB); PG8_STAGE(PG8_SA(0, 0), cA, voffA); PG8_STAGE(PG8_SB(0, 1), cB + hstepB, voffB); PG8_STAGE(PG8_SA(0, 1), cA + hstepA, voffA);
    if (wr == 1) PG8_BAR;
    PG8_WAIT_V(4); PG8_BAR;
    PG8_STAGE(PG8_SB(1, 0), cB + kstep, voffB); PG8_STAGE(PG8_SA(1, 0), cA + kstep, voffA); PG8_STAGE(PG8_SB(1, 1), cB + hstepB + kstep, voffB);
    PG8_WAIT_V(6); PG8_BAR;
    for (;;) {
        const bool has_next = S.next(ui + 1, nxt);
        const char* nA = has_next ? (const char*)(g.A + (nxt.sub == 0 ? A0 : (nxt.sub == 1 ? A1 : A2)) + nxt.koff) + (size_t)nxt.pm * tstepA : cA; const char* nB = has_next ? (const char*)(g.Bt + (nxt.sub * BS) + nxt.koff) + (size_t)nxt.pn * tstepB : cB;
        const int nt = cur.nt;
        for (int t = 0; t < nt; t += 2) {
            const bool last = (t == nt - 2);
            const char* a1 = cA + (size_t)(t + 1) * kstep;
            const char* a2 = last ? nA : cA + (size_t)(t + 2) * kstep; const char* b2 = last ? nB : cB + (size_t)(t + 2) * kstep;
            const char* a3 = a2 + kstep; const char* b3 = b2 + kstep;
            PG8_LDB(B0, 0, 0); PG8_SCHED; PG8_LDA(At, 0, 0); PG8_STAGE(PG8_SA(1, 1), a1 + hstepA, voffA);
            PG8_WAIT_L(8); PG8_BAR; PG8_WAIT_L(0); PG8_MMA(0, 0, At, B0); PG8_BAR; PG8_SCHED;
            PG8_LDB(B1, 0, 1); PG8_STAGE(PG8_SB(0, 0), b2, voffB);
            PG8_BAR; PG8_WAIT_L(0); PG8_MMA(0, 1, At, B1); PG8_BAR;
            PG8_LDA(At, 0, 1); PG8_STAGE(PG8_SA(0, 0), a2, voffA);
            PG8_BAR; PG8_WAIT_L(0); PG8_MMA(1, 0, At, B0); PG8_BAR; PG8_SCHED;
            PG8_STAGE(PG8_SB(0, 1), b2 + hstepB, voffB);
            PG8_WAIT_V(6); PG8_BAR; PG8_MMA(1, 1, At, B1); PG8_BAR;
            PG8_LDB(B0, 1, 0); PG8_SCHED; PG8_LDA(At, 1, 0); PG8_STAGE(PG8_SA(0, 1), a2 + hstepA, voffA);
            PG8_WAIT_L(8); PG8_BAR; PG8_WAIT_L(0); PG8_MMA(0, 0, At, B0); PG8_BAR; PG8_SCHED;
            PG8_LDB(B1, 1, 1); PG8_STAGE(PG8_SB(1, 0), b3, voffB);
            PG8_BAR; PG8_WAIT_L(0); PG8_MMA(0, 1, At, B1); PG8_BAR;
            PG8_LDA(At, 1, 1); PG8_STAGE(PG8_SA(1, 0), a3, voffA);
            PG8_BAR; PG8_WAIT_L(0); PG8_MMA(1, 0, At, B0); PG8_BAR; PG8_SCHED;
            PG8_STAGE(PG8_SB(1, 1), b3 + hstepB, voffB);
            PG8_WAIT_V(6); PG8_BAR; PG8_MMA(1, 1, At, B1); PG8_BAR;
        }
        E(acc, cur, wr, wc, fr, fq);
        if (!has_next) break;
        if (!(Epi::KEEP && cur.sub + 1 < g.nsub)) {
#pragma unroll
            for (int a = 0; a < 2; ++a)
#pragma unroll
                for (int b = 0; b < 2; ++b)
#pragma unroll
                    for (int m = 0; m < 4; ++m)
#pragma unroll
                        for (int n = 0; n < 2; ++n) acc[a][b][m][n] = (f32x4){0.f, 0.f, 0.f, 0.f};
        }
        cur = nxt; cA = nA; cB = nB; ++ui;
    }
    PG8_WAIT_V(0);
    if (wr == 0) PG8_BAR;
    PG8_BAR;
#undef PG8_SA
#undef PG8_SB
#undef PG8_STAGE
#undef PG8_LDA
#undef PG8_LDB
#undef PG8_MMA
#undef PG8_WAIT_V
#undef PG8_WAIT_L
#undef PG8_BAR
#undef PG8_SCHED
}
}

typedef f32x4 AccT[2][2][4][2];
__device__ __forceinline__ void store_rows16(LAS unsigned char* slab, int lane, u32x4 w, bf16_t* base  , size_t ld) {
    const int fr = lane & 15, fq = lane >> 4;
    *(LAS u32x4*)(slab + fr * 80 + fq * 16) = w;
    asm volatile("s_waitcnt lgkmcnt(0)" ::: "memory");
    const u32x4 v = *(const LAS u32x4*)(slab + (lane >> 2) * 80 + (lane & 3) * 16);
    asm volatile("s_waitcnt lgkmcnt(0)" ::: "memory");
    __builtin_nontemporal_store(v, (u32x4*)(base + (size_t)(lane >> 2) * ld + (lane & 3) * 8));
}

__device__ __forceinline__ size_t g_base(int gt, int pm, int wr, int wc, int lane) {
    return ((((size_t)gt * (MT / 256) + pm) * 64 + wr * 32) * 4 + wc) * 64 + lane;
}
struct EpiIn {
    static constexpr bool PERM = false, KEEP = false, NT = true;
    bf16_t* P; bf16_t* VTa; bf16_t* VTs; bool dry; bf16_t* G;
    __device__ __forceinline__ void operator()(AccT& acc, const pg8::Unit& u, int wr, int wc, int fr, int fq) const {
        if (dry) return;
        const int trow = u.pm * 256, lane = fq * 16 + fr;
        if (u.pn >= 13) {
            u32x2* Gq = (u32x2*)G + g_base(u.pn - 13, u.pm, wr, wc, lane);
#pragma unroll
            for (int ai = 0; ai < 2; ++ai)
#pragma unroll
                for (int m = 0; m < 4; ++m)
#pragma unroll
                    for (int j = 0; j < 4; ++j) { u32x2 w; w.x = pk2(acc[ai][0][m][0][j], acc[ai][0][m][1][j]); w.y = pk2(acc[ai][1][m][0][j], acc[ai][1][m][1][j]);
                        __builtin_nontemporal_store(w, Gq + ((ai * 4 + m) * 4 + j) * 256); }
            return;
        }
        const bool isV = (u.pn == 10 && wc >= 2) || u.pn == 11 || u.pn == 12;
        if (!isV) {
            const int pc = (u.pn < 10 ? 256 * u.pn : 2560) + 64 * wc + 4 * fr;
            bf16_t* Pb = P + (size_t)(trow + wr * 64 + 4 * fq) * PW + pc;
#pragma unroll
            for (int ai = 0; ai < 2; ++ai)
#pragma unroll
                for (int m = 0; m < 4; ++m)
#pragma unroll
                    for (int j = 0; j < 4; ++j) { u32x2 w; w.x = pk2(acc[ai][0][m][0][j], acc[ai][0][m][1][j]); w.y = pk2(acc[ai][1][m][0][j], acc[ai][1][m][1][j]);
                        __builtin_nontemporal_store(w, (u32x2*)(Pb + (size_t)(ai * 128 + m * 16 + j) * PW)); }
            return;
        }
        int b, tokbase; if (trow < ML) { b = trow >> 13; tokbase = trow & 8191; } else { b = (trow - ML) >> 8; tokbase = 8192; }
        const bool isS = (u.pn == 10); bf16_t* VT = isS ? VTs : VTa; const int nh = isS ? 2 : 8;
        const int cl = (isS ? 64 * (wc - 2) : 256 * (u.pn - 11) + 64 * wc) + 4 * fr;
        bf16_t* vb = VT + ((size_t)(b * nh + (cl >> 6)) * 64 + (cl & 63)) * VTOK + tokbase + wr * 64 + 4 * fq;
#pragma unroll
        for (int ai = 0; ai < 2; ++ai)
#pragma unroll
            for (int m = 0; m < 4; ++m)
#pragma unroll
                for (int c = 0; c < 4; ++c) { const f32x4 v = acc[ai][c >> 1][m][c & 1]; u32x2 w; w.x = pk2(v[0], v[1]); w.y = pk2(v[2], v[3]);
                    *(u32x2*)(vb + (size_t)c * VTOK + ai * 128 + m * 16) = w; }
    }
};
struct EpiMerge {
    static constexpr bool PERM = false, KEEP = true, NT = true;
    const bf16_t* G; bf16_t* Mo;
    __device__ __forceinline__ void operator()(AccT& acc, const pg8::Unit& u, int wr, int wc, int fr, int fq) const {
        const int lane = fq * 16 + fr; const bool lastsub = (u.sub == 2);
        const u32x2* Gc = (const u32x2*)G + g_base(4 * u.sub + u.pn, u.pm, wr, wc, lane); const u32x2* Gn = Gc + (lastsub ? 0 : (size_t)4 * (MT / 256) * 64 * 4 * 64);
        bf16_t* Mb = Mo + (size_t)(u.pm * 256 + wr * 64 + 4 * fq) * D + u.pn * 256 + wc * 64 + 4 * fr;
#pragma unroll
        for (int am = 0; am < 4; ++am) {
            const int ai = am >> 1, m0 = (am & 1) * 2;
            u32x2 wcur[2][4], wnx[2][4];
#pragma unroll
            for (int m = 0; m < 2; ++m)
#pragma unroll
                for (int j = 0; j < 4; ++j) { wcur[m][j] = Gc[((ai * 4 + m0 + m) * 4 + j) * 256]; wnx[m][j] = Gn[((ai * 4 + m0 + m) * 4 + j) * 256]; }
            __builtin_amdgcn_sched_barrier(0);
#pragma unroll
            for (int mm = 0; mm < 2; ++mm)
#pragma unroll
                for (int j = 0; j < 4; ++j) { const int m = m0 + mm;
                    float f[4];
#pragma unroll
                    for (int q = 0; q < 2; ++q) {
                        const float c0 = bflo(wcur[mm][j][q]), c1 = bfhi(wcur[mm][j][q]), n0 = bflo(wnx[mm][j][q]), n1 = bfhi(wnx[mm][j][q]);
                        const float d0 = 1.f + fexp2(fminf(-c0 * LOG2E, 100.f)), d1 = 1.f + fexp2(fminf(-c1 * LOG2E, 100.f));
                        const float u0 = lastsub ? 1.f : 1.f + fexp2(fminf(-n0 * LOG2E, 100.f)), u1 = lastsub ? 1.f : 1.f + fexp2(fminf(-n1 * LOG2E, 100.f));
                        f[2 * q] = u0 * frcp(d0); f[2 * q + 1] = u1 * frcp(d1);
                    }
                    const float v0 = acc[ai][0][m][0][j] * f[0], v1 = acc[ai][0][m][1][j] * f[1], v2 = acc[ai][1][m][0][j] * f[2], v3 = acc[ai][1][m][1][j] * f[3];
                    acc[ai][0][m][0][j] = v0; acc[ai][0][m][1][j] = v1; acc[ai][1][m][0][j] = v2; acc[ai][1][m][1][j] = v3;
                    if (lastsub) { u32x2 w; w.x = pk2(v0, v1); w.y = pk2(v2, v3); *(u32x2*)(Mb + (size_t)(ai * 128 + m * 16 + j) * D) = w; }
                }
            __builtin_amdgcn_sched_barrier(0);
        }
    }
};
struct EpiRes {
    static constexpr bool PERM = false, KEEP = false, NT = true;
    float* XL; unsigned char* ws; const float* modl; int gidx; bool dry; const float* XLsrc;
    __device__ __forceinline__ void operator()(AccT& acc, const pg8::Unit& u, int wr, int wc, int fr_, int fq_) const {
        int lq = fq_ * 16 + fr_; asm volatile("" : "+v"(lq)); const int fr = lq & 15, fq = lq >> 4;
        const int trow = u.pm * 256, row0 = trow + wr * 64 + 4 * fq, col0 = u.pn * 256 + wc * 64 + 4 * fr;
        const int v = trow < ML ? (trow >> 13) : 4;
        const f32x4 gv = *(const f32x4*)(modl + v * 6144 + gidx * 1024 + col0);
        if (u.split) {
#pragma unroll
            for (int ai = 0; ai < 2; ++ai)
#pragma unroll
                for (int m = 0; m < 4; ++m)
#pragma unroll
                    for (int j = 0; j < 4; ++j) { const f32x4 a4 = {acc[ai][0][m][0][j], acc[ai][0][m][1][j], acc[ai][1][m][0][j], acc[ai][1][m][1][j]};
                        if (!dry) *(f32x4*)((float*)(ws + WS_PART) + ((size_t)u.ks * MC + (row0 - ML) + ai * 128 + m * 16 + j) * D + col0) = gv * a4; }
            return;
        }
        float* Xb = (trow < ML ? XL + (size_t)row0 * D : (float*)(ws + WS_XC) + (size_t)(row0 - ML) * D) + col0;
        const float* Xr = (trow < ML ? XLsrc + (size_t)row0 * D : (const float*)(ws + WS_XC) + (size_t)(row0 - ML) * D) + col0;
#pragma unroll
        for (int ai = 0; ai < 2; ++ai) {
            f32x4 xv[4][4];
#pragma unroll
            for (int m = 0; m < 4; ++m)
#pragma unroll
                for (int j = 0; j < 4; ++j) xv[m][j] = *(const f32x4*)(Xr + (size_t)(ai * 128 + m * 16 + j) * D);
            __builtin_amdgcn_sched_barrier(0);
#pragma unroll
            for (int m = 0; m < 4; ++m)
#pragma unroll
                for (int j = 0; j < 4; ++j) { const f32x4 a4 = {acc[ai][0][m][0][j], acc[ai][0][m][1][j], acc[ai][1][m][0][j], acc[ai][1][m][1][j]};
                    const f32x4 o = xv[m][j] + gv * a4; if (!dry) *(f32x4*)(Xb + (size_t)(ai * 128 + m * 16 + j) * D) = o; }
            __builtin_amdgcn_sched_barrier(0);
        }
    }
};
struct EpiFF1 {
    static constexpr bool PERM = false, KEEP = false, NT = true;
    bf16_t* Hd;
    __device__ __forceinline__ void operator()(AccT& acc, const pg8::Unit& u, int wr, int wc, int fr, int fq) const {
        bf16_t* Hb = Hd + (size_t)(u.pm * 256 + wr * 64 + 4 * fq) * DFF + u.pn * 256 + wc * 64 + 4 * fr;
#pragma unroll
        for (int ai = 0; ai < 2; ++ai)
#pragma unroll
            for (int m = 0; m < 4; ++m)
#pragma unroll
                for (int j = 0; j < 4; ++j) {
                    const float a0 = fmaxf(acc[ai][0][m][0][j], 0.f), a1 = fmaxf(acc[ai][0][m][1][j], 0.f), a2 = fmaxf(acc[ai][1][m][0][j], 0.f), a3 = fmaxf(acc[ai][1][m][1][j], 0.f);
                    u32x2 w; w.x = pk2(a0 * a0, a1 * a1); w.y = pk2(a2 * a2, a3 * a3);
                    __builtin_nontemporal_store(w, (u32x2*)(Hb + (size_t)(ai * 128 + m * 16 + j) * DFF)); }
    }
};

__device__ __forceinline__ void transpose_item(const float* W, int ldn, int k0, int nsrc0, bf16_t* WT, int ldt, int ndst0, LAS float* scr, int lane) {
#pragma unroll 8
    for (int i = 0; i < 32; ++i) { const int kk = 2 * i + (lane >> 5); scr[kk * 33 + (lane & 31)] = W[(size_t)(k0 + kk) * ldn + nsrc0 + (lane & 31)]; }
    asm volatile("s_waitcnt lgkmcnt(0)" ::: "memory");
    const int c = lane & 7;
#pragma unroll
    for (int j = 0; j < 4; ++j) { const int n = (lane >> 3) + 8 * j; const LAS float* s = scr + (8 * c) * 33 + n;
        u32x4 o; o.x = pk2(s[0 * 33], s[1 * 33]); o.y = pk2(s[2 * 33], s[3 * 33]); o.z = pk2(s[4 * 33], s[5 * 33]); o.w = pk2(s[6 * 33], s[7 * 33]);
        *(u32x4*)(WT + (size_t)(ndst0 + n) * ldt + k0 + 8 * c) = o; }
    asm volatile("s_waitcnt lgkmcnt(0)" ::: "memory");
}
__device__ __forceinline__ void conv_seg(int& base, int gw, int NGW, const float* W, int K, int ldn, int nsrc0, int ncols, bf16_t* WT, int ldt, int ndst0, LAS float* scr, int lane) {
    const int nblk = ncols / 32, nitems = (K / 64) * nblk;
    int first = base + (((gw - base) % NGW) + NGW) % NGW;
    for (int it = first; it < base + nitems; it += NGW) { const int r = it - base, kb = r / nblk, nb = r - kb * nblk;
        transpose_item(W, ldn, 64 * kb, nsrc0 + 32 * nb, WT, ldt, ndst0 + 32 * nb, scr, lane); }
    base += nitems;
}
__device__ __forceinline__ void convert_stage_a(const KArgs& a, int l, int gw, int NGW, LAS float* scr, int) {
    const int lane = lane_id_asm();
    const float* W = a.w_in + (size_t)l * D * WIN; bf16_t* WT = (bf16_t*)(a.ws + WS_WB); int base = 0;
    conv_seg(base, gw, NGW, W, D, WIN, 0, 1024, WT, D, 0, scr, lane);
    conv_seg(base, gw, NGW, W, D, WIN, 1536, 1024, WT, D, 1024, scr, lane);
    conv_seg(base, gw, NGW, W, D, WIN, 2560, 512, WT, D, 2048, scr, lane);
    conv_seg(base, gw, NGW, W, D, WIN, 3072, 256, WT, D, 2560, scr, lane);
    conv_seg(base, gw, NGW, W, D, WIN, 1024, 512, WT, D, 2816, scr, lane);
    conv_seg(base, gw, NGW, W, D, WIN, 3328, 3072, WT, D, 3328, scr, lane);
}
__device__ __forceinline__ void convert_stage_b(const KArgs& a, int l, int gw, int NGW, LAS float* scr, int) {
    const int lane = lane_id_asm();
    bf16_t* WB = (bf16_t*)(a.ws + WS_WB); int base = 0;
    const float* wbr = a.w_branch + (size_t)l * 1536 * D;
    for (int i = 0; i < 3; ++i) conv_seg(base, gw, NGW, wbr + (size_t)i * 512 * D, 512, D, 0, D, WB + WB_BR + i * 524288, 512, 0, scr, lane);
    conv_seg(base, gw, NGW, a.w_out + (size_t)l * D * D, D, D, 0, D, WB + WB_OUT, D, 0, scr, lane);
    conv_seg(base, gw, NGW, a.w_ff1 + (size_t)l * D * DFF, D, DFF, 0, DFF, WB + WB_FF1, D, 0, scr, lane);
    conv_seg(base, gw, NGW, a.w_ff2 + (size_t)l * DFF * D, DFF, D, 0, D, WB + WB_FF2, DFF, 0, scr, lane);
}

__device__ __forceinline__ void phase0(const KArgs& a, LAS unsigned char* lds, int gw, int NGW, int wave, int lane) {
    LAS float* cond = (LAS float*)lds;
    LAS float* red = (LAS float*)(lds + 20480);
    const int tid = wave * 64 + lane;
    for (int i = tid; i < 5 * D; i += 512) { const int v = i >> 10, k = i & 1023; const float cv = v < 4 ? a.c[v * D + k] : a.c_ctx[k]; cond[i] = cv / (1.f + __expf(-cv)); }
    __syncthreads();
    float* mods = (float*)(a.ws + WS_MOD);
    const int col = tid & 127, kq = tid >> 7;
    for (int task = blockIdx.x; task < NL * 48; task += gridDim.x) {
        const int l = task / 48, cc = (task % 48) * 128 + col;
        const float* W = a.w_mod + (size_t)l * D * 6144 + cc;
        float s0 = 0.f, s1 = 0.f, s2 = 0.f, s3 = 0.f, s4 = 0.f;
#pragma unroll 32
        for (int k = kq * 256; k < kq * 256 + 256; ++k) { const float w = W[(size_t)k * 6144];
            s0 += w * cond[k]; s1 += w * cond[1024 + k]; s2 += w * cond[2048 + k]; s3 += w * cond[3072 + k]; s4 += w * cond[4096 + k]; }
        red[(kq * 5 + 0) * 128 + col] = s0; red[(kq * 5 + 1) * 128 + col] = s1; red[(kq * 5 + 2) * 128 + col] = s2; red[(kq * 5 + 3) * 128 + col] = s3; red[(kq * 5 + 4) * 128 + col] = s4;
        __syncthreads();
        for (int o = tid; o < 5 * 128; o += 512) { const int v = o >> 7, c2 = o & 127, ccol = (task % 48) * 128 + c2;
            const float r = red[(0 * 5 + v) * 128 + c2] + red[(1 * 5 + v) * 128 + c2] + red[(2 * 5 + v) * 128 + c2] + red[(3 * 5 + v) * 128 + c2];
            mods[((size_t)l * 5 + v) * 6144 + ccol] = r + a.b_mod[l * 6144 + ccol]; }
        __syncthreads();
    }
    __syncthreads();
    LAS float* scr = (LAS float*)(lds + 32768 + wave * 8448);
    bf16_t* LW = (bf16_t*)(a.ws + WS_LW);
    for (int it = gw; it < NL * 2 * 2 * 8 * 2; it += NGW) { const int half = it & 1, mi = it >> 1, n = mi & 7, mat = (mi >> 3) & 1, ld = mi >> 4;
        const float* W = (mat ? a.lru_wx : a.lru_wa) + ((size_t)ld * 8 + n) * 4096;
        transpose_item(W, 64, 0, 32 * half, LW + ((size_t)(ld * 2 + mat) * 8 + n) * 4096, 64, 32 * half, scr, lane); }
    convert_stage_a(a, 0, gw, NGW, scr, lane);
}

__device__ __forceinline__ void norm_phase(const KArgs& a, int l, bool second, int nrows, int gw, int NGW, int, int npart) {
    const int lane = lane_id_asm();
    const bool first_read = (l == 0 && !second);
    const float* srcL = first_read ? a.x : a.out; const float* srcC = first_read ? a.ctx : (const float*)(a.ws + WS_XC);
    float* XC = (float*)(a.ws + WS_XC); bf16_t* H = (bf16_t*)(a.ws + WS_H);
    const float* g = (second ? a.norm2_g : a.norm1_g) + l * D; const float* modl = (const float*)(a.ws + WS_MOD) + (size_t)l * 5 * 6144; const int sidx = second ? 3 : 0;
    auto load_row = [&](int row, f32x4 (&xv)[4]) {
        const float* src = row < ML ? srcL + (size_t)row * D : srcC + (size_t)(row - ML) * D;
        const f32x4* xr = (const f32x4*)src + lane;
#pragma unroll
        for (int j = 0; j < 4; ++j) xv[j] = xr[64 * j];
    };
    auto fold_row = [&](int row, f32x4 (&xv)[4]) {
        if (row >= ML && npart > 0) {
            const float* PART = (const float*)(a.ws + WS_PART);
            for (int sp = 0; sp < npart; sp += 4) { f32x4 pv[4][4];
#pragma unroll
                for (int q = 0; q < 4; ++q) { const f32x4* pr = (const f32x4*)(PART + ((size_t)(sp + q) * MC + (row - ML)) * D) + lane;
#pragma unroll
                    for (int j = 0; j < 4; ++j) pv[q][j] = pr[64 * j]; }
#pragma unroll
                for (int q = 0; q < 4; ++q)
#pragma unroll
                    for (int j = 0; j < 4; ++j) xv[j] += pv[q][j]; }
        }
        if (row >= ML && (npart > 0 || first_read)) { f32x4* xw = (f32x4*)(XC + (size_t)(row - ML) * D) + lane;
#pragma unroll
            for (int j = 0; j < 4; ++j) xw[64 * j] = xv[j]; }
    };
    auto ssq = [&](const f32x4 (&xv)[4]) { float s = 0.f;
#pragma unroll
        for (int j = 0; j < 4; ++j) s += (xv[j][0] * xv[j][0] + xv[j][1] * xv[j][1]) + (xv[j][2] * xv[j][2] + xv[j][3] * xv[j][3]);
        return s; };
    auto emit = [&](int row, const f32x4 (&xv)[4], float rstd) {
        const int v = row < ML ? (row >> 13) : 4; u32x2* o8 = (u32x2*)(H + (size_t)row * D) + lane;
#pragma unroll
        for (int j = 0; j < 4; ++j) { const int c = 4 * lane + 256 * j; const f32x4 gg = *(const f32x4*)(g + c), sh = *(const f32x4*)(modl + v * 6144 + sidx * 1024 + c), sc = *(const f32x4*)(modl + v * 6144 + (sidx + 1) * 1024 + c);
            f32x4 h = xv[j] * rstd * gg * (sc + 1.0f) + sh; u32x2 w; w.x = pk2(h[0], h[1]); w.y = pk2(h[2], h[3]); o8[64 * j] = w; }
    };
    for (int row = gw; row < nrows; row += 2 * NGW) {
        const int row1 = row + NGW; const bool has1 = row1 < nrows; const int r1 = has1 ? row1 : row;
        f32x4 xa[4], xb[4];
        load_row(row, xa); load_row(r1, xb);
        fold_row(row, xa); if (has1) fold_row(r1, xb);
        float sa = ssq(xa), sb = ssq(xb);
#pragma unroll
        for (int o = 1; o < 64; o <<= 1) { sa += shfl_lane(sa, lane ^ o); sb += shfl_lane(sb, lane ^ o); }
        emit(row, xa, 1.0f / sqrtf(sa * (1.f / D) + 1e-6f));
        if (has1) emit(r1, xb, 1.0f / sqrtf(sb * (1.f / D) + 1e-6f));
    }
}
__device__ __forceinline__ void final_norm(const KArgs& a, int gw, int NGW, int) {
    const int lane = lane_id_asm();
    for (int row = gw; row < ML; row += 2 * NGW) {
        const int row1 = row + NGW; const bool has1 = row1 < ML; const int r1 = has1 ? row1 : row;
        f32x4* xa = (f32x4*)(a.out + (size_t)row * D) + lane; f32x4* xb = (f32x4*)(a.out + (size_t)r1 * D) + lane; f32x4 va[4], vb[4]; float sa = 0.f, sb = 0.f;
#pragma unroll
        for (int j = 0; j < 4; ++j) { va[j] = xa[64 * j]; vb[j] = xb[64 * j]; }
#pragma unroll
        for (int j = 0; j < 4; ++j) { sa += (va[j][0] * va[j][0] + va[j][1] * va[j][1]) + (va[j][2] * va[j][2] + va[j][3] * va[j][3]); sb += (vb[j][0] * vb[j][0] + vb[j][1] * vb[j][1]) + (vb[j][2] * vb[j][2] + vb[j][3] * vb[j][3]); }
#pragma unroll
        for (int o = 1; o < 64; o <<= 1) { sa += shfl_lane(sa, lane ^ o); sb += shfl_lane(sb, lane ^ o); }
        const float ra = 1.0f / sqrtf(sa * (1.f / D) + 1e-6f), rb = 1.0f / sqrtf(sb * (1.f / D) + 1e-6f);
#pragma unroll
        for (int j = 0; j < 4; ++j) { const f32x4 gg = *(const f32x4*)(a.final_g + 4 * lane + 256 * j); xa[64 * j] = va[j] * ra * gg; if (has1) xb[64 * j] = vb[j] * rb * gg; }
    }
}

struct AttnSt { f32x4 o[4]; float m, l; };
struct KVF { bf16x8 k[4]; bf16x8 v[4]; };
__device__ __forceinline__ void kv_load(KVF& f, const bf16_t* kr0, const bf16_t* kr1, const bf16_t* kr2, const bf16_t* kr3, const bf16_t* vp) {
    f.k[0] = *(const bf16x8*)kr0; f.k[1] = *(const bf16x8*)kr1; f.k[2] = *(const bf16x8*)kr2; f.k[3] = *(const bf16x8*)kr3;
#pragma unroll
    for (int dt = 0; dt < 4; ++dt) f.v[dt] = *(const bf16x8*)(vp + (size_t)dt * 16 * VTOK);
}
__device__ __forceinline__ void k_to_frags(KVF& f, LAS unsigned char* slab, int lane) {
    LAS unsigned char* wp = slab + (lane >> 3) * 144 + (lane & 7) * 16;
    LAS unsigned char* wv = slab + 4608 + (lane >> 2) * 80 + (lane & 3) * 16;
#pragma unroll
    for (int j = 0; j < 4; ++j) { *(LAS bf16x8*)(wp + j * 8 * 144) = f.k[j]; *(LAS bf16x8*)(wv + j * 16 * 80) = f.v[j]; }
    asm volatile("s_waitcnt lgkmcnt(0)" ::: "memory");
    const int c16 = lane & 15, g = lane >> 4;
    const LAS unsigned char* rp = slab + (8 * (c16 >> 2) + (c16 & 3)) * 144 + g * 16;
    const LAS unsigned char* rv = slab + 4608 + c16 * 80 + g * 16;
    f.k[0] = *(const LAS bf16x8*)rp; f.k[1] = *(const LAS bf16x8*)(rp + 64); f.k[2] = *(const LAS bf16x8*)(rp + 4 * 144); f.k[3] = *(const LAS bf16x8*)(rp + 4 * 144 + 64);
#pragma unroll
    for (int dt = 0; dt < 4; ++dt) f.v[dt] = *(const LAS bf16x8*)(rv + dt * 16 * 80);
    asm volatile("s_waitcnt lgkmcnt(0)" ::: "memory");
}
template <class BiasF>
__device__ __forceinline__ void attn_compute(AttnSt& st, const KVF& f, const bf16x8 (&qf)[2], BiasF bias) {
    f32x4 s0 = {0.f, 0.f, 0.f, 0.f}, s1 = {0.f, 0.f, 0.f, 0.f};
    s0 = MFMA16(f.k[0], qf[0], s0); s0 = MFMA16(f.k[1], qf[1], s0); s1 = MFMA16(f.k[2], qf[0], s1); s1 = MFMA16(f.k[3], qf[1], s1);
    float t[8]; const float SC = 0.125f * LOG2E;
#pragma unroll
    for (int j = 0; j < 4; ++j) { t[j] = bias(j, s0[j] * SC); t[4 + j] = bias(4 + j, s1[j] * SC); }
    float bm = fmaxf(fmaxf(fmaxf(t[0], t[1]), fmaxf(t[2], t[3])), fmaxf(fmaxf(t[4], t[5]), fmaxf(t[6], t[7])));
    bm = xmax16(bm); bm = xmax32(bm);
    const bool grow = bm > st.m + 8.0f;
    if (__builtin_amdgcn_ballot_w64(grow) != 0ull) {
        const float mn = grow ? bm : st.m, alpha = fexp2(st.m - mn); st.m = mn; st.l *= alpha;
#pragma unroll
        for (int dt = 0; dt < 4; ++dt) st.o[dt] *= alpha;
    }
    const float mn = st.m;
    float ls = 0.f;
#pragma unroll
    for (int j = 0; j < 8; ++j) { t[j] = fexp2(t[j] - mn); ls += t[j]; }
    st.l += ls;
    u32x4 pw; pw.x = pk2(t[0], t[1]); pw.y = pk2(t[2], t[3]); pw.z = pk2(t[4], t[5]); pw.w = pk2(t[6], t[7]);
    const bf16x8 pf = __builtin_bit_cast(bf16x8, pw);
#pragma unroll
    for (int dt = 0; dt < 4; ++dt) st.o[dt] = MFMA16(f.v[dt], pf, st.o[dt]);
}
__device__ __forceinline__ void attn_init(AttnSt& st) {
#pragma unroll
    for (int dt = 0; dt < 4; ++dt) st.o[dt] = (f32x4){0.f, 0.f, 0.f, 0.f};
    st.m = -1.0e30f; st.l = 0.f;
}
__device__ __forceinline__ void attn_store(const AttnSt& st, float lextra, bf16_t* orow, int lane, bool dry) {
    float l = st.l; l = xsum16(l); l = xsum32(l); l += lextra;
    const float inv = 1.0f / l; const int g = lane >> 4;
#pragma unroll
    for (int dt = 0; dt < 4; ++dt) { const f32x4 o = st.o[dt] * inv; u32x2 w; w.x = pk2(o[0], o[1]); w.y = pk2(o[2], o[3]); if (!dry) *(u32x2*)(orow + 16 * dt + 4 * g) = w; }
}
__device__ __forceinline__ void na_item(const KArgs& a, int l, int item, LAS unsigned char* slab, bool dry) {
    const int lane = lane_id_asm();
    bf16_t* P = (bf16_t*)(a.ws + WS_P); const bf16_t* VT = (const bf16_t*)(a.ws + WS_VTA);
    const int i = item & 3, h = (item >> 2) & 7, r = (item >> 5) & 127, b = item >> 12;
    const int c16 = lane & 15, g = lane >> 4, kk0 = 8 * (c16 >> 2) + (c16 & 3);
    const int cq = 16 * i + c16; const size_t qrow = (size_t)b * S + r * 64 + cq;
    bf16x8 qf[2]; qf[0] = *(const bf16x8*)(P + qrow * PW + C_QA + h * 64 + 8 * g); qf[1] = *(const bf16x8*)(P + qrow * PW + C_QA + h * 64 + 32 + 8 * g);
    const int c0 = (i == 0) ? 0 : (i == 1 ? 8 : (i == 2 ? 24 : 32));
    const int rs = min(max(r - 4, 0), 120), cs = min(max(cq - 8, 0), 48);
    unsigned okm = 0; int idx0 = c0 + 8 * g - cq + 15;
#pragma unroll
    for (int e = 0; e < 8; ++e) { const int kc = c0 + 8 * g + e; okm |= ((kc >= cs) && (kc < cs + 16)) ? (1u << e) : 0u; }
    const float* rpb = a.na_rpb + ((size_t)l * 8 + h) * 15 * 31;
    const bf16_t* kcol = P + C_KA + h * 64 + (lane & 7) * 8 + (size_t)(lane >> 3) * PW; const bf16_t* vrow = VT + (size_t)((b * 8 + h) * 64 + (lane >> 2)) * VTOK + 8 * (lane & 3);
    AttnSt st; attn_init(st);
    KVF cur, nxt; float bc[8], bn[8];
#pragma unroll
    for (int e = 0; e < 8; ++e) { bc[e] = 0.f; bn[e] = 0.f; }
    auto loadblk = [&](int blk, KVF& f, float (&bb)[8]) {
        if (blk < 8) { const int R = rs + blk; const size_t tok0 = (size_t)R * 64 + c0; const bf16_t* kp = kcol + ((size_t)b * S + tok0) * PW;
            kv_load(f, kp, kp + (size_t)8 * PW, kp + (size_t)16 * PW, kp + (size_t)24 * PW, vrow + tok0);
            const float* rp = rpb + (R - r + 7) * 31;
#pragma unroll
            for (int e = 0; e < 8; ++e) bb[e] = rp[min(max(idx0 + e, 0), 30)];
        } else { const int cb = blk - 8; const bf16_t* kp = kcol + ((size_t)ML + b * CTX + 32 * cb) * PW; kv_load(f, kp, kp + (size_t)8 * PW, kp + (size_t)16 * PW, kp + (size_t)24 * PW, vrow + 8192 + 32 * cb); }
    };
    loadblk(0, cur, bc);
    for (int blk = 0; blk < 16; ++blk) {
        loadblk(blk < 15 ? blk + 1 : 15, nxt, bn);
        k_to_frags(cur, slab, lane);
        if (blk < 8) attn_compute(st, cur, qf, [&](int e, float s) { return ((okm >> e) & 1u) ? s + bc[e] * LOG2E : NEGBIG; });
        else attn_compute(st, cur, qf, [](int, float s) { return s; });
        cur = nxt;
#pragma unroll
        for (int e = 0; e < 8; ++e) bc[e] = bn[e];
    }
    attn_store(st, 0.f, P + qrow * PW + C_QA + h * 64, lane, dry);
}
__device__ __forceinline__ void na_pair(const KArgs& a, int l, int pitem, LAS unsigned char* slab, bool dry) {
    const int lane = lane_id_asm();
    bf16_t* P = (bf16_t*)(a.ws + WS_P); const bf16_t* VT = (const bf16_t*)(a.ws + WS_VTA);
    const int i0 = 2 * (pitem & 1), h = (pitem >> 1) & 7, r = (pitem >> 4) & 127, b = pitem >> 11;
    const int c16 = lane & 15, g = lane >> 4;
    const int rs = min(max(r - 4, 0), 120);
    const float* rpb = a.na_rpb + ((size_t)l * 8 + h) * 15 * 31;
    const bf16_t* kcol = P + C_KA + h * 64 + (lane & 7) * 8 + (size_t)(lane >> 3) * PW; const bf16_t* vrow = VT + (size_t)((b * 8 + h) * 64 + (lane >> 2)) * VTOK + 8 * (lane & 3);
    AttnSt stA, stB; attn_init(stA); attn_init(stB);
    bf16x8 qA[2], qB[2];
    const size_t qrowA = (size_t)b * S + r * 64 + 16 * i0 + c16, qrowB = qrowA + 16;
    qA[0] = *(const bf16x8*)(P + qrowA * PW + C_QA + h * 64 + 8 * g); qA[1] = *(const bf16x8*)(P + qrowA * PW + C_QA + h * 64 + 32 + 8 * g);
    qB[0] = *(const bf16x8*)(P + qrowB * PW + C_QA + h * 64 + 8 * g); qB[1] = *(const bf16x8*)(P + qrowB * PW + C_QA + h * 64 + 32 + 8 * g);
    auto local_pass = [&](AttnSt& st, const bf16x8 (&qf)[2], int i) {
        const int cq = 16 * i + c16, c0 = (i == 0) ? 0 : (i == 1 ? 8 : (i == 2 ? 24 : 32)), cs = min(max(cq - 8, 0), 48);
        unsigned okm = 0; const int idx0 = c0 + 8 * g - cq + 15;
#pragma unroll
        for (int e = 0; e < 8; ++e) { const int kc = c0 + 8 * g + e; okm |= ((kc >= cs) && (kc < cs + 16)) ? (1u << e) : 0u; }
        KVF cur, nxt; float bc[8], bn[8];
        auto loadblk = [&](int blk, KVF& f, float (&bb)[8]) { const int R = rs + blk; const size_t tok0 = (size_t)R * 64 + c0; const bf16_t* kp = kcol + ((size_t)b * S + tok0) * PW;
            kv_load(f, kp, kp + (size_t)8 * PW, kp + (size_t)16 * PW, kp + (size_t)24 * PW, vrow + tok0);
            const float* rp = rpb + (R - r + 7) * 31;
#pragma unroll
            for (int e = 0; e < 8; ++e) bb[e] = rp[min(max(idx0 + e, 0), 30)]; };
        loadblk(0, cur, bc);
        for (int blk = 0; blk < 8; ++blk) {
            loadblk(blk < 7 ? blk + 1 : 7, nxt, bn);
            k_to_frags(cur, slab, lane);
            attn_compute(st, cur, qf, [&](int e, float s) { return ((okm >> e) & 1u) ? s + bc[e] * LOG2E : NEGBIG; });
            cur = nxt;
#pragma unroll
            for (int e = 0; e < 8; ++e) bc[e] = bn[e];
        }
    };
    local_pass(stA, qA, i0);
    local_pass(stB, qB, i0 + 1);
    {
        KVF cur, nxt;
        auto loadctx = [&](int cb, KVF& f) { const bf16_t* kp = kcol + ((size_t)ML + b * CTX + 32 * cb) * PW; kv_load(f, kp, kp + (size_t)8 * PW, kp + (size_t)16 * PW, kp + (size_t)24 * PW, vrow + 8192 + 32 * cb); };
        loadctx(0, cur);
        for (int cb = 0; cb < 8; ++cb) {
            loadctx(cb < 7 ? cb + 1 : 7, nxt);
            k_to_frags(cur, slab, lane);
            attn_compute(stA, cur, qA, [](int, float s) { return s; }); attn_compute(stB, cur, qB, [](int, float s) { return s; });
            cur = nxt;
        }
    }
    attn_store(stA, 0.f, P + qrowA * PW + C_QA + h * 64, lane, dry);
    attn_store(stB, 0.f, P + qrowB * PW + C_QA + h * 64, lane, dry);
}
__device__ __forceinline__ void ctx_item(const KArgs& a, int l, int item, bool swa, int lane, LAS unsigned char* slab, bool dry) {
    bf16_t* P = (bf16_t*)(a.ws + WS_P);
    const int i = item & 15, h = (item >> 4) & 7, b = item >> 7;
    const int c16 = lane & 15, g = lane >> 4, kk0 = 8 * (c16 >> 2) + (c16 & 3);
    const size_t qrow = (size_t)ML + b * CTX + 16 * i + c16; const int qc = (swa ? C_QS : C_QA) + h * 64;
    bf16x8 qf[2]; qf[0] = *(const bf16x8*)(P + qrow * PW + qc + 8 * g); qf[1] = *(const bf16x8*)(P + qrow * PW + qc + 32 + 8 * g);
    const bf16_t* kcol = P + (swa ? C_KS + (h >> 2) * 64 : C_KA + h * 64) + (lane & 7) * 8 + (size_t)(lane >> 3) * PW;
    const bf16_t* vrow = (swa ? (const bf16_t*)(a.ws + WS_VTS) + (size_t)((b * 2 + (h >> 2)) * 64 + (lane >> 2)) * VTOK : (const bf16_t*)(a.ws + WS_VTA) + (size_t)((b * 8 + h) * 64 + (lane >> 2)) * VTOK) + 8 * (lane & 3);
    AttnSt st; attn_init(st);
    for (int cb = 0; cb < 8; ++cb) { KVF f; const bf16_t* kp = kcol + ((size_t)ML + b * CTX + 32 * cb) * PW; kv_load(f, kp, kp + (size_t)8 * PW, kp + (size_t)16 * PW, kp + (size_t)24 * PW, vrow + 8192 + 32 * cb);
        k_to_frags(f, slab, lane);
        attn_compute(st, f, qf, [](int, float s) { return s; }); }
    const float lex = swa ? fexp2(a.swa_sink[l * 8 + h] * LOG2E - st.m) : 0.f;
    attn_store(st, lex, P + qrow * PW + qc, lane, dry);
}
__device__ __forceinline__ float inv_freq(int f) { return exp2f(-(float)f * (13.287712379549449f / 16.0f)); }
__device__ __forceinline__ void rope_cs(int pos, int f, float& c, float& s) {
    const float ang = (float)pos * inv_freq(f); float rev = ang * 0.15915494309189535f; rev -= rintf(rev);
    c = __builtin_amdgcn_cosf(rev); s = __builtin_amdgcn_sinf(rev);
}
__device__ __forceinline__ void rope_q(bf16x8 (&qf)[2], int tq, int g) {
    const int pos = (g < 2) ? (tq >> 6) : (tq & 63);
    u32x4 w0 = __builtin_bit_cast(u32x4, qf[0]), w1 = __builtin_bit_cast(u32x4, qf[1]);
#pragma unroll
    for (int q = 0; q < 4; ++q) {
        float c0, s0, c1, s1; rope_cs(pos, 8 * (g & 1) + 2 * q, c0, s0); rope_cs(pos, 8 * (g & 1) + 2 * q + 1, c1, s1);
        const float a0 = bflo(w0[q]), a1 = bfhi(w0[q]), b0 = bflo(w1[q]), b1 = bfhi(w1[q]);
        w0[q] = pk2(a0 * c0 - b0 * s0, a1 * c1 - b1 * s1); w1[q] = pk2(b0 * c0 + a0 * s0, b1 * c1 + a1 * s1);
    }
    qf[0] = __builtin_bit_cast(bf16x8, w0); qf[1] = __builtin_bit_cast(bf16x8, w1);
}
__device__ __forceinline__ void swa_item(const KArgs& a, int l, int item, LAS unsigned char* slab, bool dry) {
    const int lane = lane_id_asm();
    bf16_t* P = (bf16_t*)(a.ws + WS_P); const bf16_t* VT = (const bf16_t*)(a.ws + WS_VTS);
    const int qt = item & 511, hp = (item >> 9) & 1, kvh = (item >> 10) & 1, b = item >> 11, h0 = 4 * kvh + 2 * hp;
    const int c16 = lane & 15, g = lane >> 4, kk0 = 8 * (c16 >> 2) + (c16 & 3);
    const int tq = 16 * qt + c16; const size_t qrow = (size_t)b * S + tq;
    bf16x8 qa[2], qb[2];
    qa[0] = *(const bf16x8*)(P + qrow * PW + C_QS + h0 * 64 + 8 * g); qa[1] = *(const bf16x8*)(P + qrow * PW + C_QS + h0 * 64 + 32 + 8 * g);
    qb[0] = *(const bf16x8*)(P + qrow * PW + C_QS + h0 * 64 + 64 + 8 * g); qb[1] = *(const bf16x8*)(P + qrow * PW + C_QS + h0 * 64 + 96 + 8 * g);
    rope_q(qa, tq, g); rope_q(qb, tq, g);
    const bf16_t* kcol = P + C_KS + kvh * 64 + (lane & 7) * 8; const bf16_t* vrow = VT + (size_t)((b * 2 + kvh) * 64 + (lane >> 2)) * VTOK + 8 * (lane & 3); const int lr = lane >> 3;
    AttnSt sa, sb; attn_init(sa); attn_init(sb);
    const int kstart = 16 * qt - 128;
    int bfirst = 0, blast = 8; while (kstart + 32 * bfirst + 31 < 0) ++bfirst; while (kstart + 32 * blast >= S) --blast;
    const int nblk = (blast - bfirst + 1) + 8;
    KVF cur, nxt;
    auto loadblk = [&](int q, KVF& f) {
        const int lb = bfirst + q;
        if (lb <= blast) { const int k0 = kstart + 32 * lb + lr; const int r0 = min(max(k0, 0), S - 1), r1 = min(max(k0 + 8, 0), S - 1), r2 = min(max(k0 + 16, 0), S - 1), r3 = min(max(k0 + 24, 0), S - 1), vt = min(max(k0 - lr + 8 * (lane & 3), 0), S - 8);
            const bf16_t* kb = kcol + (size_t)b * S * PW;
            kv_load(f, kb + (size_t)r0 * PW, kb + (size_t)r1 * PW, kb + (size_t)r2 * PW, kb + (size_t)r3 * PW, VT + (size_t)((b * 2 + kvh) * 64 + (lane >> 2)) * VTOK + vt);
        } else { const int cb = lb - blast - 1; const bf16_t* kp = kcol + ((size_t)ML + b * CTX + 32 * cb + lr) * PW; kv_load(f, kp, kp + (size_t)8 * PW, kp + (size_t)16 * PW, kp + (size_t)24 * PW, vrow + 8192 + 32 * cb); }
    };
    loadblk(0, cur);
    for (int q = 0; q < nblk; ++q) {
        loadblk(q + 1 < nblk ? q + 1 : q, nxt);
        k_to_frags(cur, slab, lane);
        const int lb = bfirst + q;
        const int kb0 = kstart + 32 * lb;
        const bool edge = (lb == 0) || (lb >= 8) || (kb0 < 0) || (kb0 + 31 >= S);
        if (lb <= blast && edge) { const int kbase = kb0 + 8 * g;
            auto msk = [&](int e, float s) { const int k = kbase + e, dlt = k - tq; return ((k >= 0) && (k < S) && (dlt <= 128) && (dlt >= -128)) ? s : NEGBIG; };
            attn_compute(sa, cur, qa, msk); attn_compute(sb, cur, qb, msk);
        } else { attn_compute(sa, cur, qa, [](int, float s) { return s; }); attn_compute(sb, cur, qb, [](int, float s) { return s; }); }
        cur = nxt;
    }
    attn_store(sa, fexp2(a.swa_sink[l * 8 + h0] * LOG2E - sa.m), P + qrow * PW + C_QS + h0 * 64, lane, dry);
    attn_store(sb, fexp2(a.swa_sink[l * 8 + h0 + 1] * LOG2E - sb.m), P + qrow * PW + C_QS + h0 * 64 + 64, lane, dry);
}
__device__ __forceinline__ void rope_k_phase(const KArgs& a, int gw, int NGW, int, bool dry) {
    const int lane = lane_id_asm();
    bf16_t* P = (bf16_t*)(a.ws + WS_P);
    const int hd = lane >> 5, i = lane & 31;
    for (int row = gw; row < ML; row += NGW) {
        const int t = row & (S - 1); const int pos = (i < 16) ? (t >> 6) : (t & 63);
        float c, s; rope_cs(pos, i & 15, c, s);
        bf16_t* p = P + (size_t)row * PW + C_KS + hd * 64;
        const float t1 = bf2f(p[i]), t2 = bf2f(p[i + 32]);
        const unsigned w = pk2(t1 * c - t2 * s, t2 * c + t1 * s);
        if (!dry) { p[i] = (bf16_t)(w & 0xffff); p[i + 32] = (bf16_t)(w >> 16); }
    }
}

__device__ __forceinline__ float softplus_neg(float lam) {
    const float x = __expf(-fmaxf(lam, -80.f));
    const float ser = x * (1.f - x * (0.5f - x * (0.33333334f - x * (0.25f - x * 0.2f))));
    const float big = (lam < -15.f) ? -lam : __builtin_amdgcn_logf(1.f + x) * 0.6931471806f;
    return x < 0.03f ? ser : big;
}
__device__ __forceinline__ float neg_expm1(float x) {
    const float ser = -x * (1.f + x * (0.5f + x * (0.16666667f + x * (0.041666668f + x * (0.0083333338f + x * 0.0013888889f)))));
    return x > -0.25f ? ser : 1.f - __expf(x);
}
template <int DIR, bool WRITE>
__device__ __forceinline__ void lru_sweep(const KArgs& a, int l, int b, int n, int sp, float (&carry)[4], float (&arun)[4], int lane, LAS unsigned char* wl, bool dry = false) {
    bf16_t* P = (bf16_t*)(a.ws + WS_P); float* HT = (float*)(a.ws + WS_H); const bf16_t* LW = (const bf16_t*)(a.ws + WS_LW);
    const int c16 = lane & 15, g = lane >> 4; const int gg = DIR ? 3 - g : g;
    const bool lat = sp < 64; const int rowbase = lat ? b * S : ML + b * CTX, seglen = lat ? S : CTX, t0 = (lat ? sp : sp - 64) * 128;
    float ba[4], bx[4], spc[4];
#pragma unroll
    for (int nt = 0; nt < 4; ++nt) { const int ch = n * 64 + 16 * nt + c16, o = (l * 2 + DIR) * 512 + ch;
        ba[nt] = a.lru_ba[o]; bx[nt] = a.lru_bx[o]; const float lam = a.lru_lambda[o]; spc[nt] = softplus_neg(lam); }
    LAS float* cwl = (LAS float*)(wl + 18432);
    {
        const float* cw = a.conv_w + (size_t)l * 4 * 512 + n * 64; const float* cbias = a.conv_b + (size_t)l * 512 + n * 64;
        int lq = lane; asm volatile("" : "+v"(lq));
        const bf16_t* wsrc = LW + ((size_t)((l * 2 + DIR) * 2) * 8 + n) * 4096 + lq * 8;
        LAS unsigned char* wdst = wl + (lq >> 3) * 144 + (lq & 7) * 16;
#pragma unroll
        for (int mat = 0; mat < 2; ++mat) {
            u32x4 wv[8];
#pragma unroll
            for (int k = 0; k < 8; ++k) wv[k] = *(const u32x4*)(wsrc + mat * 32768 + k * 512);
#pragma unroll
            for (int k = 0; k < 8; ++k) *(LAS u32x4*)(wdst + mat * 9216 + k * 1152) = wv[k];
        }
        float cv[5];
#pragma unroll
        for (int i = 0; i < 4; ++i) cv[i] = cw[i * 512 + lq];
        cv[4] = cbias[lq];
#pragma unroll
        for (int i = 0; i < 5; ++i) cwl[i * 64 + lq] = cv[i];
        asm volatile("s_waitcnt lgkmcnt(0)" ::: "memory");
    }
    const LAS unsigned char* wfr = wl + c16 * 144 + 16 * g;
    const int srcm = DIR ? lane + 16 : lane - 16, srcm2 = DIR ? lane + 32 : lane - 32, srct = DIR ? c16 : 48 + c16;
    for (int ti = 0; ti < 8; ++ti) {
        asm volatile("" ::: "memory");
        const int tile = DIR ? 7 - ti : ti; const int tt = t0 + 16 * tile; const int t = tt + c16;
        int lv = lane; asm volatile("" : "+v"(lv)); const int idt = (lv & 15) - 8 * (lv >> 4);
        f32x4* HT4 = (f32x4*)HT + ((size_t)((rowbase + tt) >> 2) + g) * 512 + n * 64 + c16;
        f32x4 htv[4]; unsigned short gbr[4][4];
        if (WRITE && DIR == 1) {
#pragma unroll
            for (int nt = 0; nt < 4; ++nt) { htv[nt] = HT4[16 * nt];
#pragma unroll
                for (int j = 0; j < 4; ++j) gbr[nt][j] = P[(size_t)(rowbase + tt + 4 * g + j) * PW + C_GB + n * 64 + 16 * nt + c16]; }
        }
        bf16x8 uf[2];
        u32x4 xr[2][4];
#pragma unroll
        for (int ks = 0; ks < 2; ++ks)
#pragma unroll
            for (int i = 0; i < 4; ++i) { const int tc = min(max(t + i - 2, 0), seglen - 1); xr[ks][i] = *(const u32x4*)(P + (size_t)(rowbase + tc) * PW + C_XB + n * 64 + 32 * ks + 8 * g); }
#pragma unroll
        for (int ks = 0; ks < 2; ++ks) { const int chl = 32 * ks + 8 * g;
            f32x4 u0 = *(const LAS f32x4*)(cwl + 256 + chl), u1 = *(const LAS f32x4*)(cwl + 256 + chl + 4);
#pragma unroll
            for (int i = 0; i < 4; ++i) { const int tp = t + i - 2; const bool ok = (tp >= 0) && (tp < seglen);
                const u32x4 xw = xr[ks][i];
                f32x4 w0 = *(const LAS f32x4*)(cwl + i * 64 + chl), w1 = *(const LAS f32x4*)(cwl + i * 64 + chl + 4);
                if (!ok) { w0 = (f32x4){0.f, 0.f, 0.f, 0.f}; w1 = w0; }
                u0[0] += w0[0] * bflo(xw[0]); u0[1] += w0[1] * bfhi(xw[0]); u0[2] += w0[2] * bflo(xw[1]); u0[3] += w0[3] * bfhi(xw[1]);
                u1[0] += w1[0] * bflo(xw[2]); u1[1] += w1[1] * bfhi(xw[2]); u1[2] += w1[2] * bflo(xw[3]); u1[3] += w1[3] * bfhi(xw[3]); }
            u32x4 pw; pw.x = pk2(u0[0], u0[1]); pw.y = pk2(u0[2], u0[3]); pw.z = pk2(u1[0], u1[1]); pw.w = pk2(u1[2], u1[3]);
            uf[ks] = __builtin_bit_cast(bf16x8, pw); }
#pragma unroll
        for (int nt = 0; nt < 4; ++nt) {
            f32x4 ga = {0.f, 0.f, 0.f, 0.f}, gx = ga, ud = ga;
#pragma unroll
            for (int ks = 0; ks < 2; ++ks) {
                const bf16x8 wa = *(const LAS bf16x8*)(wfr + nt * 2304 + ks * 64), wx = *(const LAS bf16x8*)(wfr + 9216 + nt * 2304 + ks * 64);
                bf16x8 idf;
#pragma unroll
                for (int j = 0; j < 8; ++j) idf[j] = (32 * ks + j == 16 * nt + idt) ? (short)0x3F80 : (short)0;
                ga = MFMA16(uf[ks], wa, ga); gx = MFMA16(uf[ks], wx, gx); ud = MFMA16(uf[ks], idf, ud);
            }
            float av[4], bv[4];
#pragma unroll
            for (int j = 0; j < 4; ++j) {
                const float r = frcp(1.f + __expf(-(ga[j] + ba[nt]))), ii = frcp(1.f + __expf(-(gx[j] + bx[nt])));
                const float la = -8.0f * r * spc[nt];
                av[j] = __expf(la); bv[j] = __builtin_amdgcn_sqrtf(neg_expm1(2.0f * la)) * ii * ud[j];
            }
            float Pj[4], Hj[4];
#pragma unroll
            for (int jj = 0; jj < 4; ++jj) { const int j = DIR ? 3 - jj : jj;
                if (jj == 0) { Pj[0] = av[j]; Hj[0] = bv[j]; } else { Pj[jj] = Pj[jj - 1] * av[j]; Hj[jj] = av[j] * Hj[jj - 1] + bv[j]; } }
            float Ai = Pj[3], Hi = Hj[3];
            { const float A1 = shfl_lane(Ai, srcm), H1 = shfl_lane(Hi, srcm); if (gg >= 1) { Hi = Ai * H1 + Hi; Ai = Ai * A1; } }
            { const float A2 = shfl_lane(Ai, srcm2), H2 = shfl_lane(Hi, srcm2); if (gg >= 2) { Hi = Ai * H2 + Hi; Ai = Ai * A2; } }
            float Ae = shfl_lane(Ai, srcm), He = shfl_lane(Hi, srcm); if (gg == 0) { Ae = 1.f; He = 0.f; }
            const float At = shfl_lane(Ai, srct), Ht = shfl_lane(Hi, srct);
            const float cin = Ae * carry[nt] + He;
            if (WRITE) {
                f32x4 hv4;
#pragma unroll
                for (int jj = 0; jj < 4; ++jj) { const int j = DIR ? 3 - jj : jj; hv4[j] = Hj[jj] + Pj[jj] * cin; }
                if (DIR == 0) HT4[16 * nt] = hv4;
                else {
#pragma unroll
                    for (int j = 0; j < 4; ++j) { const float gbv = bf2f(gbr[nt][j]); const float y = htv[nt][j] + hv4[j];
                        const float z = 0.7978845608028654f * (gbv + 0.044715f * gbv * gbv * gbv); const float th = 1.f - 2.f * frcp(1.f + __expf(2.f * z));
                        const float ge = 0.5f * gbv * (1.f + th);
                        if (!dry) P[(size_t)(rowbase + tt + 4 * g + j) * PW + C_GB + n * 64 + 16 * nt + c16] = (bf16_t)(pk2(y * ge, 0.f) & 0xffff); }
                }
            }
            carry[nt] = At * carry[nt] + Ht; arun[nt] *= At;
        }
    }
}
__device__ __forceinline__ void lru_pass1_item(const KArgs& a, int l, int item, int lane, LAS unsigned char* wl) {
    const int dir = item & 1, n = (item >> 1) & 7, rest = item >> 4, sp = rest % 66, b = rest / 66;
    float carry[4] = {0.f, 0.f, 0.f, 0.f}, arun[4] = {1.f, 1.f, 1.f, 1.f};
    if (dir) lru_sweep<1, false>(a, l, b, n, sp, carry, arun, lane, wl); else lru_sweep<0, false>(a, l, b, n, sp, carry, arun, lane, wl);
    float* SUM = (float*)(a.ws + WS_SUM);
    if (lane < 16) {
#pragma unroll
        for (int nt = 0; nt < 4; ++nt) { float* p = SUM + ((size_t)((b * 66 + sp) * 2 + dir) * 512 + n * 64 + 16 * nt + lane) * 2; p[0] = arun[nt]; p[1] = carry[nt]; }
    }
}
template <int DIR>
__device__ __forceinline__ void lru_carry(const float* SUM, int b, int n, int sp, int lane, float (&carry)[4]) {
    typedef float f32x2v __attribute__((ext_vector_type(2)));
    const int c16 = lane & 15, g = lane >> 4;
    const int npred = DIR ? 65 - sp : (sp < 64 ? sp + 2 : sp - 64);
    const int q = (npred + 3) >> 2, i0 = g * q, i1 = min(i0 + q, npred);
    float Ac[4] = {1.f, 1.f, 1.f, 1.f}, Hc[4] = {0.f, 0.f, 0.f, 0.f};
    for (int i = i0; i < i1; i += 4) {
        f32x2v v[4][4];
#pragma unroll
        for (int u = 0; u < 4; ++u) { const int ii = min(i + u, i1 - 1); const int p = DIR ? 65 - ii : (ii < 2 ? 64 + ii : ii - 2);
#pragma unroll
            for (int nt = 0; nt < 4; ++nt) { v[u][nt] = *(const f32x2v*)(SUM + ((size_t)((b * 66 + p) * 2 + DIR) * 512 + n * 64 + 16 * nt + c16) * 2); if (i + u >= i1) v[u][nt] = (f32x2v){1.f, 0.f}; } }
#pragma unroll
        for (int u = 0; u < 4; ++u)
#pragma unroll
            for (int nt = 0; nt < 4; ++nt) { Hc[nt] = v[u][nt].x * Hc[nt] + v[u][nt].y; Ac[nt] = v[u][nt].x * Ac[nt]; }
    }
#pragma unroll
    for (int nt = 0; nt < 4; ++nt) { float c = 0.f;
#pragma unroll
        for (int gi = 0; gi < 4; ++gi) { const float Ag = shfl_lane(Ac[nt], c16 + 16 * gi), Hg = shfl_lane(Hc[nt], c16 + 16 * gi); c = Ag * c + Hg; }
        carry[nt] = c; }
}
__device__ __forceinline__ void lru_pass2_item(const KArgs& a, int l, int item, int lane, LAS unsigned char* wl, bool dry) {
    const int n = item & 7, rest = item >> 3, sp = rest % 66, b = rest / 66;
    const float* SUM = (const float*)(a.ws + WS_SUM);
    float carry[4], arun[4] = {1.f, 1.f, 1.f, 1.f};
    lru_carry<0>(SUM, b, n, sp, lane, carry);
    lru_sweep<0, true>(a, l, b, n, sp, carry, arun, lane, wl);
    lru_carry<1>(SUM, b, n, sp, lane, carry);
    lru_sweep<1, true>(a, l, b, n, sp, carry, arun, lane, wl, dry);
}

#define XB_TMO      128
#define XB_XCNT(j)  (256  + 64 * (j))
#define XB_XSUB(j)  (1280 + 64 * (j))
#define XB_XGEN(j)  (2304 + 64 * (j))
#define XB_TOP      3328
#define XB_TOPGEN   3392
#define XCD_BAR_WORDS 3456
#define XB_SPIN_CAP (1u << 18)
__device__ __forceinline__ unsigned xb_ld(unsigned* p)              { return __hip_atomic_load(p, __ATOMIC_RELAXED, __HIP_MEMORY_SCOPE_AGENT); }
__device__ __forceinline__ unsigned xb_add(unsigned* p, unsigned v) { return __hip_atomic_fetch_add(p, v, __ATOMIC_RELAXED, __HIP_MEMORY_SCOPE_AGENT); }
__device__ __forceinline__ unsigned xb_xcc_id() { return (unsigned)__builtin_amdgcn_s_getreg((3 << 11) | 20) & 0xFu; }
#define XB_SPIN(cond, bar) do { unsigned _sp = 0; while (cond) { __builtin_amdgcn_s_sleep(1); \
    if ((++_sp & 255u) == 0u) { if (xb_ld(&(bar)[XB_TMO])) break; if (_sp > XB_SPIN_CAP) { atomicAdd(&(bar)[XB_TMO], 1u); break; } } } } while (0)
struct XcdBarrier { unsigned* bar; unsigned x; volatile LAS unsigned* st; };
__device__ __forceinline__ XcdBarrier xcd_barrier_post(unsigned* bar, volatile LAS unsigned* st) {
    XcdBarrier b; b.bar = bar; b.x = xb_xcc_id(); b.st = st;
    if (threadIdx.x == 0) (void)xb_add(&bar[XB_XCNT(b.x)], 1u);
    return b;
}
__device__ __forceinline__ void xcd_barrier_complete(unsigned* bar, unsigned x, unsigned& nloc, unsigned& nx) {
    const unsigned G = gridDim.x * gridDim.y * gridDim.z;
    unsigned sum, cnt, mine, sp = 0u;
    for (;;) {
        sum = 0u; cnt = 0u; mine = 0u;
#pragma unroll
        for (unsigned j = 0; j < 16; ++j) { const unsigned c = xb_ld(&bar[XB_XCNT(j)]); sum += c; cnt += (c > 0u) ? 1u : 0u; mine = (j == x) ? c : mine; }
        if (sum == G) break;
        __builtin_amdgcn_s_sleep(1);
        if ((++sp & 255u) == 0u) { if (xb_ld(&bar[XB_TMO])) break; if (sp > XB_SPIN_CAP) { atomicAdd(&bar[XB_TMO], 1u); break; } }
    }
    nloc = mine > 0u ? mine : 1u; nx = cnt > 0u ? cnt : 1u;
}
__device__ __forceinline__ void xcd_barrier(const XcdBarrier& b) {
    asm volatile("s_waitcnt vmcnt(0)" ::: "memory");
    __syncthreads();
    if (threadIdx.x == 0) {
        unsigned* bar = b.bar;
        __builtin_amdgcn_s_waitcnt(0);
        unsigned nloc = b.st[0], nx = b.st[1];
        if (nloc == 0u) { xcd_barrier_complete(bar, b.x, nloc, nx); b.st[0] = nloc; b.st[1] = nx; }
        const unsigned old = xb_add(&bar[XB_XSUB(b.x)], 1u);
        const unsigned gen = old / nloc;
        if (old + 1u == (gen + 1u) * nloc) {
            __builtin_amdgcn_fence(__ATOMIC_RELEASE, "agent");
            asm volatile("s_waitcnt vmcnt(0)" ::: "memory");
            const unsigned og = xb_add(&bar[XB_TOP], 1u);
            const unsigned tg = og / nx;
            if (og + 1u == (tg + 1u) * nx) xb_add(&bar[XB_TOPGEN], 1u);
            else XB_SPIN(xb_ld(&bar[XB_TOPGEN]) == tg, bar);
            __builtin_amdgcn_fence(__ATOMIC_ACQUIRE, "agent");
            xb_add(&bar[XB_XGEN(b.x)], 1u);
            asm volatile("s_waitcnt vmcnt(0)" ::: "memory");
        } else {
            XB_SPIN(xb_ld(&bar[XB_XGEN(b.x)]) == gen, bar);
            __builtin_amdgcn_fence(__ATOMIC_ACQUIRE, "agent");
            asm volatile("s_waitcnt vmcnt(0)" ::: "memory");
        }
    }
    __syncthreads();
}

__global__ void __launch_bounds__(512, 2) fwd_kernel(KArgs a) {
    extern __shared__ __attribute__((aligned(16))) unsigned char smem[];
    LAS unsigned char* lds = (LAS unsigned char*)smem;
    cg::grid_group grid = cg::this_grid();
    const int G = gridDim.x, NGW = G * 8;
    const int wave = __builtin_amdgcn_readfirstlane(threadIdx.x >> 6);
    volatile LAS unsigned* bst = (volatile LAS unsigned*)(lds + 8 * WAVE_LDS);
    if (threadIdx.x < 2) bst[threadIdx.x] = 0u;
    __syncthreads();
    XcdBarrier xbar; xbar.bar = (unsigned*)(a.ws + WS_BAR); xbar.x = 0; xbar.st = bst;
    if (a.ph_hi - a.ph_lo > 1) xbar = xcd_barrier_post((unsigned*)(a.ws + WS_BAR), bst);
    for (int ph = a.ph_lo; ph < a.ph_hi; ++ph) {
        bf16_t* P = (bf16_t*)(a.ws + WS_P); bf16_t* H = (bf16_t*)(a.ws + WS_H); bf16_t* WB = (bf16_t*)(a.ws + WS_WB);
        float* XC = (float*)(a.ws + WS_XC);
        int lane = lane_id_asm(); const int gw = blockIdx.x * 8 + wave;
        if (ph == 0) phase0(a, lds, gw, NGW, wave, lane);
        else if (ph == 37) final_norm(a, gw, NGW, lane);
        else {
            const int l = (ph - 1) / 9, k = (ph - 1) % 9; const bool lastl = (l == NL - 1); const int Mrows = lastl ? ML : MT;
            const float* modl = (const float*)(a.ws + WS_MOD) + (size_t)l * 5 * 6144;
            const int reps = ((PROBE_MASK >> k) & 1) ? 2 : 1;
            for (int rep = 0; rep < reps; ++rep) { const bool dry = (rep + 1 < reps);
            if (rep) { xcd_barrier(xbar); lane = lane_id_asm(); }
            if (k == 0) {
                norm_phase(a, l, false, MT, gw, NGW, lane, l > 0 ? 8 : 0);
                if (l > 0) convert_stage_a(a, l, gw, NGW, (LAS float*)(lds + wave * WAVE_LDS), lane);
            } else if (k == 1) {
                pg8::Gemm g{H, WB, 1}; pg8::Order So; So.init(MT, WIN, G, blockIdx.x, 1, D);
                EpiIn E{P, (bf16_t*)(a.ws + WS_VTA), (bf16_t*)(a.ws + WS_VTS), dry && ((PROBE_MASK >> 16) & 1), (bf16_t*)(a.ws + WS_G)};
                #ifndef NO_EPIIN
                pg8::gemm_phase<EpiIn, D, D, D>(lds, g, So, E, wave, (int)((blockIdx.x >> 3) & 3) * STAGGER_TICKS);
#endif
            } else if (k == 2) {
                convert_stage_b(a, l, gw, NGW, (LAS float*)(lds + wave * WAVE_LDS), lane);
                rope_k_phase(a, gw, NGW, lane, dry);
                constexpr int N1 = NB * 66 * 8 * 2, N2 = N1 + NB * 128 * 8 * 4 / 2, N3 = N2 + NB * 8 * 16;
                unsigned* ctr = (unsigned*)(a.ws + WS_BAR) + 8 * (2 * l + 0 + 2 * NL * rep);
                for (;;) {
                    const int ln = lane_id_asm();
                    int it = 0; if (ln == 0) it = (int)__hip_atomic_fetch_add(ctr, 1u, __ATOMIC_RELAXED, __HIP_MEMORY_SCOPE_AGENT);
                    it = __builtin_amdgcn_readfirstlane(it);
                    if (it >= (lastl ? N2 : N3)) break;
                    if (it < N1) { if ((PROBE_MASK >> 12) & 1) lru_pass1_item(a, l, it, ln, lds + wave * WAVE_LDS); lru_pass1_item(a, l, it, ln, lds + wave * WAVE_LDS); }
                    else if (it < N2) { if ((PROBE_MASK >> 13) & 1) { na_item(a, l, 2 * (it - N1), lds + wave * WAVE_LDS, true); na_item(a, l, 2 * (it - N1) + 1, lds + wave * WAVE_LDS, true); } na_pair(a, l, it - N1, lds + wave * WAVE_LDS, dry); }
                    else ctx_item(a, l, it - N2, false, ln, lds + wave * WAVE_LDS, dry);
                }
            } else if (k == 3) {
                constexpr int N1 = NB * 66 * 8, N2 = N1 + NB * 4 * 512, N3 = N2 + NB * 8 * 16;
                unsigned* ctr = (unsigned*)(a.ws + WS_BAR) + 8 * (2 * l + 1 + 2 * NL * rep);
                for (;;) {
                    const int ln = lane_id_asm();
                    int it = 0; if (ln == 0) it = (int)__hip_atomic_fetch_add(ctr, 1u, __ATOMIC_RELAXED, __HIP_MEMORY_SCOPE_AGENT);
                    it = __builtin_amdgcn_readfirstlane(it);
                    if (it >= (lastl ? N2 : N3)) break;
                    if (it < N1) { if ((PROBE_MASK >> 14) & 1) lru_pass2_item(a, l, it, ln, lds + wave * WAVE_LDS, true); lru_pass2_item(a, l, it, ln, lds + wave * WAVE_LDS, dry); }
                    else if (it < N2) { if ((PROBE_MASK >> 15) & 1) swa_item(a, l, it - N1, lds + wave * WAVE_LDS, true); swa_item(a, l, it - N1, lds + wave * WAVE_LDS, dry); }
                    else ctx_item(a, l, it - N2, true, ln, lds + wave * WAVE_LDS, dry);
                }
            } else if (k == 4) {
                pg8::Gemm g{P, WB + WB_BR, 3}; pg8::Order So; So.init(Mrows, D, G, blockIdx.x, 3, 512);
                EpiMerge E{(const bf16_t*)(a.ws + WS_G), H};
                #ifndef NO_EPIMERGE
                pg8::gemm_phase<EpiMerge, PW, 512, 512, C_QA, C_GB, C_QS, 524288>(lds, g, So, E, wave);
#endif
            } else if (k == 5) {
                pg8::Gemm g{H, WB + WB_OUT, 1}; pg8::Order So; So.init(ML, D, G, blockIdx.x, 1, D, lastl ? 0 : MC / 256, 4);
                EpiRes E{a.out, a.ws, modl, 2, dry, l == 0 ? a.x : a.out};
#ifndef NO_EPIRES
                pg8::gemm_phase<EpiRes, D, D, D>(lds, g, So, E, wave);
#endif
            } else if (k == 8) {
                pg8::Gemm g{P, WB + WB_FF2, 1}; pg8::Order So; So.init(ML, D, G, blockIdx.x, 1, DFF, lastl ? 0 : MC / 256, 8);
                EpiRes E{a.out, a.ws, modl, 5, dry, a.out};
#ifndef NO_EPIRES
                pg8::gemm_phase<EpiRes, DFF, DFF, DFF>(lds, g, So, E, wave);
#endif
            } else if (k == 6) {
                norm_phase(a, l, true, Mrows, gw, NGW, lane, lastl ? 0 : 4);
            } else if (k == 7) {
                pg8::Gemm g{H, WB + WB_FF1, 1}; pg8::Order So; So.init(Mrows, DFF, G, blockIdx.x, 1, D);
                EpiFF1 E{P};
                #ifndef NO_EPIFF1
                pg8::gemm_phase<EpiFF1, D, D, D>(lds, g, So, E, wave, (int)((blockIdx.x >> 3) & 3) * STAGGER_TICKS);
#endif
            }
            }
        }
        if (ph + 1 < a.ph_hi) { if (ph == 0 || !USE_XCD_BAR) { __syncthreads(); grid.sync(); } else xcd_barrier(xbar); if ((PROBE_MASK >> 9) & 1) xcd_barrier(xbar); }
    }
}

extern "C" void kernel_launch(void* const* d_in, const int* in_sizes, int n_in, void* d_out, int out_size, void* d_ws, size_t ws_size, hipStream_t stream) {
    static int grid = 0;
    if (grid == 0) {
        if (n_in != 23 || ws_size < WS_END) { fprintf(stderr, "kernel_launch: unexpected n_in %d or ws_size %zu (< %zu)\n", n_in, ws_size, (size_t)WS_END); grid = -1; return; }
        int dev = 0, cus = 0, per_cu = 0;
        hipGetDevice(&dev); hipDeviceGetAttribute(&cus, hipDeviceAttributeMultiprocessorCount, dev);
        if (hipFuncSetAttribute((const void*)fwd_kernel, hipFuncAttributeMaxDynamicSharedMemorySize, LDS_BYTES) != hipSuccess) { fprintf(stderr, "hipFuncSetAttribute failed\n"); grid = -1; return; }
        if (hipOccupancyMaxActiveBlocksPerMultiprocessor(&per_cu, (const void*)fwd_kernel, 512, LDS_BYTES) != hipSuccess || per_cu < 1) { fprintf(stderr, "occupancy query: %d\n", per_cu); per_cu = 1; }
        (void)hipGetLastError();
        grid = cus;
    }
    if (grid < 0) return;
    KArgs a{};
    const float** f = (const float**)&a;
    for (int i = 0; i < 23; ++i) f[i] = (const float*)d_in[i];
    a.out = (float*)d_out; a.ws = (unsigned char*)d_ws;
#if N_LAUNCHES == 1
    a.ph_lo = 0; a.ph_hi = 38;
    if (hipMemsetAsync((unsigned char*)d_ws + WS_BAR, 0, XCD_BAR_WORDS * 4, stream) != hipSuccess) { fprintf(stderr, "memset failed\n"); return; }
    void* args[] = {&a};
    hipError_t e = hipLaunchCooperativeKernel((const void*)fwd_kernel, dim3(grid), dim3(512), args, LDS_BYTES, stream);
    if (e != hipSuccess) fprintf(stderr, "cooperative launch failed: %s (grid %d)\n", hipGetErrorString(e), grid);
#else
    for (int ph = 0; ph < 38; ++ph) { a.ph_lo = ph; a.ph_hi = ph + 1; hipLaunchKernelGGL(fwd_kernel, dim3(grid), dim3(512), LDS_BYTES, stream, a); }
#endif
}
```

```cpp
#include <hip/hip_runtime.h>
#include <hip/hip_cooperative_groups.h>
#include <cstdio>
#include <cstdint>
namespace cg = cooperative_groups;

#ifndef N_LAUNCHES
#define N_LAUNCHES 1
#endif

#ifndef USE_XCD_BAR
#define USE_XCD_BAR 1
#endif
#ifndef STAGGER_TICKS
#define STAGGER_TICKS 0
#endif
#ifndef PROBE_MASK
#define PROBE_MASK 0
#endif
#define LAS __attribute__((address_space(3)))
typedef unsigned short bf16_t;
typedef short bf16x8 __attribute__((ext_vector_type(8)));
typedef short s16x4 __attribute__((ext_vector_type(4)));
typedef float f32x4 __attribute__((ext_vector_type(4)));
typedef unsigned u32x4 __attribute__((ext_vector_type(4)));
typedef unsigned u32x2 __attribute__((ext_vector_type(2)));

constexpr int D = 1024, NB = 4, S = 8192, CTX = 256, ML = NB * S, MC = NB * CTX, MT = ML + MC, NL = 4, DFF = 4096;
constexpr int PW = 2688;
constexpr int GCH = 384;
constexpr int C_QA = 0, C_KA = 512, C_XB = 1024, C_GB = 1536, C_QS = 2048, C_KS = 2560, C_GA = 0, C_GR = 1024, C_GS = 2048;
constexpr int VTOK = 8448;
constexpr int WIN = 6400;
constexpr size_t MiB = 1u << 20;
constexpr size_t WS_XC = 0, WS_H = 4 * MiB, WS_P = 70 * MiB, WS_G = WS_P + (size_t)MT * PW * 2, WS_VTA = WS_P + (size_t)MT * 5760 * 2, WS_VTS = WS_VTA + (size_t)NB * 8 * 64 * VTOK * 2,
                 WS_WB = WS_VTS + (size_t)NB * 2 * 64 * VTOK * 2, WS_MOD = WS_WB + 21 * MiB, WS_SUM = WS_MOD + MiB / 2, WS_LW = WS_SUM + 5 * MiB / 2, WS_BAR = WS_LW + MiB, WS_PART = WS_P + 264 * MiB, WS_END = WS_BAR + 16384;
constexpr int WB_BR = 0, WB_OUT = 3 * 524288, WB_FF1 = WB_OUT + 1048576, WB_FF2 = WB_FF1 + 4194304;
constexpr int WAVE_LDS = 19712;
constexpr int LDS_BYTES = 8 * WAVE_LDS + 64;
constexpr float LOG2E = 1.4426950408889634f;
constexpr float NEGBIG = -3.0e38f;

struct KArgs {
    const float *x, *c, *ctx, *c_ctx, *w_mod, *b_mod, *norm1_g, *norm2_g, *w_in, *na_rpb, *conv_w, *conv_b, *lru_wa, *lru_ba, *lru_wx, *lru_bx, *lru_lambda,
        *swa_sink, *w_branch, *w_out, *w_ff1, *w_ff2, *final_g;
    float* out; unsigned char* ws; int ph_lo, ph_hi;
};

typedef __bf16 bf16x2_t __attribute__((ext_vector_type(2)));
typedef float f32x2_t __attribute__((ext_vector_type(2)));
__device__ __forceinline__ unsigned pk2(float lo, float hi) { f32x2_t v = {lo, hi}; bf16x2_t r = __builtin_convertvector(v, bf16x2_t); return __builtin_bit_cast(unsigned, r); }
__device__ __forceinline__ float bf2f(unsigned short b) { return __uint_as_float(((unsigned)b) << 16); }
__device__ __forceinline__ float bflo(unsigned w) { return __uint_as_float(w << 16); }
__device__ __forceinline__ float bfhi(unsigned w) { return __uint_as_float(w & 0xffff0000u); }
__device__ __forceinline__ float fexp2(float x) { return __builtin_amdgcn_exp2f(x); }
__device__ __forceinline__ float frcp(float x) { return __builtin_amdgcn_rcpf(x); }
__device__ __forceinline__ int lane_id_asm() { int l; asm volatile("v_mbcnt_lo_u32_b32 %0, -1, 0\n\tv_mbcnt_hi_u32_b32 %0, -1, %0" : "=v"(l)); return l; }
__device__ __forceinline__ float shfl_lane(float v, int src) { return __uint_as_float((unsigned)__builtin_amdgcn_ds_bpermute(src << 2, (int)__float_as_uint(v))); }
__device__ __forceinline__ float wave_sum(float v, int lane) {
#pragma unroll
    for (int o = 1; o < 64; o <<= 1) v += shfl_lane(v, lane ^ o);
    return v;
}
__device__ __forceinline__ float lane_xor16(float x, int lane) { const unsigned u = __float_as_uint(x); const auto r = __builtin_amdgcn_permlane16_swap(u, u, false, false); return __uint_as_float((lane & 16) ? r[0] : r[1]); }
__device__ __forceinline__ float lane_xor32(float x, int lane) { const unsigned u = __float_as_uint(x); const auto r = __builtin_amdgcn_permlane32_swap(u, u, false, false); return __uint_as_float((lane & 32) ? r[0] : r[1]); }
__device__ __forceinline__ float xmax16(float x) { const unsigned u = __float_as_uint(x); const auto r = __builtin_amdgcn_permlane16_swap(u, u, false, false); const float a = __uint_as_float(r[0]), b = __uint_as_float(r[1]); return a > b ? a : b; }
__device__ __forceinline__ float xmax32(float x) { const unsigned u = __float_as_uint(x); const auto r = __builtin_amdgcn_permlane32_swap(u, u, false, false); const float a = __uint_as_float(r[0]), b = __uint_as_float(r[1]); return a > b ? a : b; }
__device__ __forceinline__ float xsum16(float x) { const unsigned u = __float_as_uint(x); const auto r = __builtin_amdgcn_permlane16_swap(u, u, false, false); return __uint_as_float(r[0]) + __uint_as_float(r[1]); }
__device__ __forceinline__ float xsum32(float x) { const unsigned u = __float_as_uint(x); const auto r = __builtin_amdgcn_permlane32_swap(u, u, false, false); return __uint_as_float(r[0]) + __uint_as_float(r[1]); }
#define MFMA16(a, b, c) __builtin_amdgcn_mfma_f32_16x16x32_bf16((a), (b), (c), 0, 0, 0)

namespace pg8 {
constexpr int BM = 256, BK = 64, HALF = 128, HTB = HALF * BK * 2, STAGE_BYTES = 8 * HTB, NXCD = 8, WGM = 8;
__host__ __device__ __forceinline__ int lds_byte(int r, int c) { const int st = (r >> 4) * 2 + (c >> 5), rr = r & 15, cc = c & 31, ob = rr * 64 + cc * 2; return st * 1024 + (ob ^ (((ob >> 9) & 1) << 5)); }
__host__ __device__ __forceinline__ void stage_rc(int b, int& R, int& C) { const int st = b / 1024, sb = b % 1024, swz = sb ^ (((sb >> 9) & 1) << 5); R = (st >> 1) * 16 + swz / 64; C = (st & 1) * 32 + (swz % 64) / 2; }
__host__ __device__ __forceinline__ int perm32(int rho) { const int n = rho >> 4, i = rho & 15; return 8 * (i >> 2) + 4 * n + (i & 3); }

struct Unit { int pm, pn, sub, koff, nt, split, ks; };
struct Gemm { const bf16_t* A; const bf16_t* Bt; int nsub; };
struct Order {
    int nM, nN, nwg, G, c, nsub, ntK;
    int xM, KS;
    __device__ void init(int M, int N, int G_, int c_, int nsub_, int K, int xM_ = 0, int KS_ = 1) { nM = M / BM; nN = N / BM; nwg = nM * nN; G = G_; c = c_; nsub = nsub_; ntK = K / BK; xM = xM_; KS = KS_; }
    __device__ bool next(int i, Unit& u) const {
        const int ti = i / nsub; u.sub = i - ti * nsub; u.koff = 0; u.nt = ntK; u.split = 0; u.ks = 0;
        const long L = (long)ti * G + c;
        if (L >= nwg) {
            const int idx = (int)(L - nwg); if (idx >= xM * nN * KS) return false;
            const int t = idx / KS, ks = idx - t * KS; u.pm = nM + t / nN; u.pn = t % nN; u.nt = ntK / KS; u.koff = ks * u.nt * BK; u.split = 1; u.ks = ks; return true;
        }
        int wgid = (int)L; { const int q = nwg / NXCD, r = nwg % NXCD, xcd = wgid % NXCD, off = wgid / NXCD; wgid = (xcd < r ? xcd * (q + 1) : r * (q + 1) + (xcd - r) * q) + off; }
        const int nig = WGM * nN, gid = wgid / nig, fm = gid * WGM, gsz = (nM - fm) < WGM ? (nM - fm) : WGM;
        u.pm = fm + ((wgid % nig) % gsz); u.pn = (wgid % nig) / gsz; return true;
    }
};

template <class Epi, int LDA, int LDB, int K, int A0 = 0, int A1 = 0, int A2 = 0, int BS = 0>
__device__ __forceinline__ void gemm_phase(LAS unsigned char* lds, const Gemm g, const Order& S, const Epi& E, int wid, int stagger = 0) {
    if (stagger > 0) { const unsigned long long t0 = __builtin_amdgcn_s_memrealtime(); while (__builtin_amdgcn_s_memrealtime() - t0 < (unsigned long long)stagger) __builtin_amdgcn_s_sleep(8); }
    const int lane = lane_id_asm(), tid = wid * 64 + lane, wr = wid >> 2, wc = wid & 3, fr = lane & 15, fq = lane >> 4;
    unsigned voffA[2], voffB[2];
#pragma unroll
    for (int i = 0; i < 2; ++i) { int R, C; stage_rc(tid * 16 + i * 8192, R, C); const int Rb = Epi::NT ? (64 * (R >> 5) + 4 * (R & 15) + ((R >> 4) & 1)) : (Epi::PERM ? ((R & ~31) + perm32(R & 31)) : R);
        voffA[i] = (unsigned)(R * LDA + C) * 2u; voffB[i] = (unsigned)(Rb * LDB + C) * 2u; }
    constexpr size_t kstep = (size_t)(BK * 2);
    constexpr size_t hstepA = (size_t)HALF * LDA * 2, hstepB = Epi::NT ? (size_t)2 * LDB * 2 : (size_t)HALF * LDB * 2;
    constexpr size_t tstepA = 2 * hstepA, tstepB = (size_t)BM * LDB * 2;
    const unsigned ldsw = (unsigned)wid * 1024u;
    const int aoff = lds_byte(wr * 64 + fr, fq * 8), boff = lds_byte(wc * 32 + fr, fq * 8);
#define PG8_SA(b, h) (((b) * 2 + (h)) * HTB)
#define PG8_SB(b, h) ((4 + (b) * 2 + (h)) * HTB)
#define PG8_STAGE(bufoff, gbase, voff) do { _Pragma("unroll") for (int _i = 0; _i < 2; ++_i) \
        __builtin_amdgcn_global_load_lds((const unsigned*)((const char*)(gbase) + (voff)[_i]), (LAS unsigned*)(lds + (bufoff) + ldsw + _i * 8192), 16, 0, 0); } while (0)
#define PG8_LDA(dst, b, h) do { _Pragma("unroll") for (int m = 0; m < 4; ++m) _Pragma("unroll") for (int k = 0; k < 2; ++k) dst[m][k] = *(const LAS bf16x8*)(lds + PG8_SA(b, h) + aoff + m * 2048 + k * 1024); } while (0)
#define PG8_LDB(dst, b, h) do { _Pragma("unroll") for (int n = 0; n < 2; ++n) _Pragma("unroll") for (int k = 0; k < 2; ++k) dst[n][k] = *(const LAS bf16x8*)(lds + PG8_SB(b, h) + boff + n * 2048 + k * 1024); } while (0)
#define PG8_MMA(ai, bj, At, Bt) do { __builtin_amdgcn_s_setprio(1); _Pragma("unroll") for (int m = 0; m < 4; ++m) _Pragma("unroll") for (int n = 0; n < 2; ++n) _Pragma("unroll") for (int k = 0; k < 2; ++k) \
        acc[ai][bj][m][n] = Epi::NT ? __builtin_amdgcn_mfma_f32_16x16x32_bf16(At[m][k], Bt[n][k], acc[ai][bj][m][n], 0, 0, 0) : __builtin_amdgcn_mfma_f32_16x16x32_bf16(Bt[n][k], At[m][k], acc[ai][bj][m][n], 0, 0, 0); __builtin_amdgcn_s_setprio(0); } while (0)
#define PG8_WAIT_V(n) asm volatile("s_waitcnt vmcnt(" #n ")" ::: "memory")
#define PG8_WAIT_L(n) asm volatile("s_waitcnt lgkmcnt(" #n ")" ::: "memory")
#define PG8_BAR __builtin_amdgcn_s_barrier()
#define PG8_SCHED __builtin_amdgcn_sched_barrier(0)
    Unit cur, nxt; int ui = 0;
    if (!S.next(0, cur)) return;
    f32x4 acc[2][2][4][2];
#pragma unroll
    for (int a = 0; a < 2; ++a)
#pragma unroll
        for (int b = 0; b < 2; ++b)
#pragma unroll
            for (int m = 0; m < 4; ++m)
#pragma unroll
                for (int n = 0; n < 2; ++n) acc[a][b][m][n] = (f32x4){0.f, 0.f, 0.f, 0.f};
    bf16x8 At[4][2], B0[2][2], B1[2][2];
    const char* cA = (const char*)(g.A + (cur.sub == 0 ? A0 : (cur.sub == 1 ? A1 : A2)) + cur.koff) + (size_t)cur.pm * tstepA; const char* cB = (const char*)(g.Bt + (cur.sub * BS) + cur.koff) + (size_t)cur.pn * tstepB;
    PG8_STAGE(PG8_SB(0, 0), cB, voffB); PG8_STAGE(PG8_SA(0, 0), cA, voffA); PG8_STAGE(PG8_SB(0, 1), cB + hstepB, voffB); PG8_STAGE(PG8_SA(0, 1), cA + hstepA, voffA);
    if (wr == 1) PG8_BAR;
    PG8_WAIT_V(4); PG8_BAR;
    PG8_STAGE(PG8_SB(1, 0), cB + kstep, voffB); PG8_STAGE(PG8_SA(1, 0), cA + kstep, voffA); PG8_STAGE(PG8_SB(1, 1), cB + hstepB + kstep, voffB);
    PG8_WAIT_V(6); PG8_BAR;
    for (;;) {
        const bool has_next = S.next(ui + 1, nxt);
        const char* nA = has_next ? (const char*)(g.A + (nxt.sub == 0 ? A0 : (nxt.sub == 1 ? A1 : A2)) + nxt.koff) + (size_t)nxt.pm * tstepA : cA; const char* nB = has_next ? (const char*)(g.Bt + (nxt.sub * BS) + nxt.koff) + (size_t)nxt.pn * tstepB : cB;
        const int nt = cur.nt;
        for (int t = 0; t < nt; t += 2) {
            const bool last = (t == nt - 2);
            const char* a1 = cA + (size_t)(t + 1) * kstep;
            const char* a2 = last ? nA : cA + (size_t)(t + 2) * kstep; const char* b2 = last ? nB : cB + (size_t)(t + 2) * kstep;
            const char* a3 = a2 + kstep; const char* b3 = b2 + kstep;
            PG8_LDB(B0, 0, 0); PG8_SCHED; PG8_LDA(At, 0, 0); PG8_STAGE(PG8_SA(1, 1), a1 + hstepA, voffA);
            PG8_WAIT_L(8); PG8_BAR; PG8_WAIT_L(0); PG8_MMA(0, 0, At, B0); PG8_BAR; PG8_SCHED;
            PG8_LDB(B1, 0, 1); PG8_STAGE(PG8_SB(0, 0), b2, voffB);
            PG8_BAR; PG8_WAIT_L(0); PG8_MMA(0, 1, At, B1); PG8_BAR;
            PG8_LDA(At, 0, 1); PG8_STAGE(PG8_SA(0, 0), a2, voffA);
            PG8_BAR; PG8_WAIT_L(0); PG8_MMA(1, 0, At, B0); PG8_BAR; PG8_SCHED;
            PG8_STAGE(PG8_SB(0, 1), b2 + hstepB, voffB);
            PG8_WAIT_V(6); PG8_BAR; PG8_MMA(1, 1, At, B1); PG8_BAR;
            PG8_LDB(B0, 1, 0); PG8_SCHED; PG8_LDA(At, 1, 0); PG8_STAGE(PG8_SA(0, 1), a2 + hstepA, voffA);
            PG8_WAIT_L(8); PG8_BAR; PG8_WAIT_L(0); PG8_MMA(0, 0, At, B0); PG8_BAR; PG8_SCHED;
            PG8_LDB(B1, 1, 1); PG8_STAGE(PG8_SB(1, 0), b3, voffB);
            PG8_BAR; PG8_WAIT_L(0); PG8_MMA(0, 1, At, B1); PG8_BAR;
            PG8_LDA(At, 1, 1); PG8_STAGE(PG8_SA(1, 0), a3, voffA);
            PG8_BAR; PG8_WAIT_L(0); PG8_MMA(1, 0, At, B0); PG8_BAR; PG8_SCHED;
            PG8_STAGE(PG8_SB(1, 1), b3 + hstepB, voffB);
            PG8_WAIT_V(6); PG8_BAR; PG8_MMA(1, 1, At, B1); PG8_BAR;
        }
        E(acc, cur, wr, wc, fr, fq);
        if (!has_next) break;
        if (!(Epi::KEEP && cur.sub + 1 < g.nsub)) {
#pragma unroll
            for (int a = 0; a < 2; ++a)
#pragma unroll
                for (int b = 0; b < 2; ++b)
#pragma unroll
                    for (int m = 0; m < 4; ++m)
#pragma unroll
                        for (int n = 0; n < 2; ++n) acc[a][b][m][n] = (f32x4){0.f, 0.f, 0.f, 0.f};
        }
        cur = nxt; cA = nA; cB = nB; ++ui;
    }
    PG8_WAIT_V(0);
    if (wr == 0) PG8_BAR;
    PG8_BAR;
#undef PG8_SA
#undef PG8_SB
#undef PG8_STAGE
#undef PG8_LDA
#undef PG8_LDB
#undef PG8_MMA
#undef PG8_WAIT_V
#undef PG8_WAIT_L
#undef PG8_BAR
#undef PG8_SCHED
}
}

typedef f32x4 AccT[2][2][4][2];
__device__ __forceinline__ void store_rows16(LAS unsigned char* slab, int lane, u32x4 w, bf16_t* base  , size_t ld) {
    const int fr = lane & 15, fq = lane >> 4;
    *(LAS u32x4*)(slab + fr * 80 + fq * 16) = w;
    asm volatile("s_waitcnt lgkmcnt(0)" ::: "memory");
    const u32x4 v = *(const LAS u32x4*)(slab + (lane >> 2) * 80 + (lane & 3) * 16);
    asm volatile("s_waitcnt lgkmcnt(0)" ::: "memory");
    __builtin_nontemporal_store(v, (u32x4*)(base + (size_t)(lane >> 2) * ld + (lane & 3) * 8));
}

__device__ __forceinline__ size_t g_base(int gt, int pm, int wr, int wc, int lane) {
    return ((((size_t)gt * (MT / 256) + pm) * 64 + wr * 32) * 4 + wc) * 64 + lane;
}
struct EpiIn {
    static constexpr bool PERM = false, KEEP = false, NT = true;
    bf16_t* P; bf16_t* VTa; bf16_t* VTs; bool dry; bf16_t* G;
    __device__ __forceinline__ void operator()(AccT& acc, const pg8::Unit& u, int wr, int wc, int fr, int fq) const {
        if (dry) return;
        const int trow = u.pm * 256, lane = fq * 16 + fr;
        if (u.pn >= 13) {
            u32x2* Gq = (u32x2*)G + g_base(u.pn - 13, u.pm, wr, wc, lane);
#pragma unroll
            for (int ai = 0; ai < 2; ++ai)
#pragma unroll
                for (int m = 0; m < 4; ++m)
#pragma unroll
                    for (int j = 0; j < 4; ++j) { u32x2 w; w.x = pk2(acc[ai][0][m][0][j], acc[ai][0][m][1][j]); w.y = pk2(acc[ai][1][m][0][j], acc[ai][1][m][1][j]);
                        __builtin_nontemporal_store(w, Gq + ((ai * 4 + m) * 4 + j) * 256); }
            return;
        }
        const bool isV = (u.pn == 10 && wc >= 2) || u.pn == 11 || u.pn == 12;
        if (!isV) {
            const int pc = (u.pn < 10 ? 256 * u.pn : 2560) + 64 * wc + 4 * fr;
            bf16_t* Pb = P + (size_t)(trow + wr * 64 + 4 * fq) * PW + pc;
#pragma unroll
            for (int ai = 0; ai < 2; ++ai)
#pragma unroll
                for (int m = 0; m < 4; ++m)
#pragma unroll
                    for (int j = 0; j < 4; ++j) { u32x2 w; w.x = pk2(acc[ai][0][m][0][j], acc[ai][0][m][1][j]); w.y = pk2(acc[ai][1][m][0][j], acc[ai][1][m][1][j]);
                        __builtin_nontemporal_store(w, (u32x2*)(Pb + (size_t)(ai * 128 + m * 16 + j) * PW)); }
            return;
        }
        int b, tokbase; if (trow < ML) { b = trow >> 13; tokbase = trow & 8191; } else { b = (trow - ML) >> 8; tokbase = 8192; }
        const bool isS = (u.pn == 10); bf16_t* VT = isS ? VTs : VTa; const int nh = isS ? 2 : 8;
        const int cl = (isS ? 64 * (wc - 2) : 256 * (u.pn - 11) + 64 * wc) + 4 * fr;
        bf16_t* vb = VT + ((size_t)(b * nh + (cl >> 6)) * 64 + (cl & 63)) * VTOK + tokbase + wr * 64 + 4 * fq;
#pragma unroll
        for (int ai = 0; ai < 2; ++ai)
#pragma unroll
            for (int m = 0; m < 4; ++m)
#pragma unroll
                for (int c = 0; c < 4; ++c) { const f32x4 v = acc[ai][c >> 1][m][c & 1]; u32x2 w; w.x = pk2(v[0], v[1]); w.y = pk2(v[2], v[3]);
                    *(u32x2*)(vb + (size_t)c * VTOK + ai * 128 + m * 16) = w; }
    }
};
struct EpiMerge {
    static constexpr bool PERM = false, KEEP = true, NT = true;
    const bf16_t* G; bf16_t* Mo;
    __device__ __forceinline__ void operator()(AccT& acc, const pg8::Unit& u, int wr, int wc, int fr, int fq) const {
        const int lane = fq * 16 + fr; const bool lastsub = (u.sub == 2);
        const u32x2* Gc = (const u32x2*)G + g_base(4 * u.sub + u.pn, u.pm, wr, wc, lane); const u32x2* Gn = Gc + (lastsub ? 0 : (size_t)4 * (MT / 256) * 64 * 4 * 64);
        bf16_t* Mb = Mo + (size_t)(u.pm * 256 + wr * 64 + 4 * fq) * D + u.pn * 256 + wc * 64 + 4 * fr;
#pragma unroll
        for (int am = 0; am < 4; ++am) {
            const int ai = am >> 1, m0 = (am & 1) * 2;
            u32x2 wcur[2][4], wnx[2][4];
#pragma unroll
            for (int m = 0; m < 2; ++m)
#pragma unroll
                for (int j = 0; j < 4; ++j) { wcur[m][j] = Gc[((ai * 4 + m0 + m) * 4 + j) * 256]; wnx[m][j] = Gn[((ai * 4 + m0 + m) * 4 + j) * 256]; }
            __builtin_amdgcn_sched_barrier(0);
#pragma unroll
            for (int mm = 0; mm < 2; ++mm)
#pragma unroll
                for (int j = 0; j < 4; ++j) { const int m = m0 + mm;
                    float f[4];
#pragma unroll
                    for (int q = 0; q < 2; ++q) {
                        const float c0 = bflo(wcur[mm][j][q]), c1 = bfhi(wcur[mm][j][q]), n0 = bflo(wnx[mm][j][q]), n1 = bfhi(wnx[mm][j][q]);
                        const float d0 = 1.f + fexp2(fminf(-c0 * LOG2E, 100.f)), d1 = 1.f + fexp2(fminf(-c1 * LOG2E, 100.f));
                        const float u0 = lastsub ? 1.f : 1.f + fexp2(fminf(-n0 * LOG2E, 100.f)), u1 = lastsub ? 1.f : 1.f + fexp2(fminf(-n1 * LOG2E, 100.f));
                        f[2 * q] = u0 * frcp(d0); f[2 * q + 1] = u1 * frcp(d1);
                    }
                    const float v0 = acc[ai][0][m][0][j] * f[0], v1 = acc[ai][0][m][1][j] * f[1], v2 = acc[ai][1][m][0][j] * f[2], v3 = acc[ai][1][m][1][j] * f[3];
                    acc[ai][0][m][0][j] = v0; acc[ai][0][m][1][j] = v1; acc[ai][1][m][0][j] = v2; acc[ai][1][m][1][j] = v3;
                    if (lastsub) { u32x2 w; w.x = pk2(v0, v1); w.y = pk2(v2, v3); *(u32x2*)(Mb + (size_t)(ai * 128 + m * 16 + j) * D) = w; }
                }
            __builtin_amdgcn_sched_barrier(0);
        }
    }
};
struct EpiRes {
    static constexpr bool PERM = false, KEEP = false, NT = true;
    float* XL; unsigned char* ws; const float* modl; int gidx; bool dry; const float* XLsrc;
    __device__ __forceinline__ void operator()(AccT& acc, const pg8::Unit& u, int wr, int wc, int fr_, int fq_) const {
        int lq = fq_ * 16 + fr_; asm volatile("" : "+v"(lq)); const int fr = lq & 15, fq = lq >> 4;
        const int trow = u.pm * 256, row0 = trow + wr * 64 + 4 * fq, col0 = u.pn * 256 + wc * 64 + 4 * fr;
        const int v = trow < ML ? (trow >> 13) : 4;
        const f32x4 gv = *(const f32x4*)(modl + v * 6144 + gidx * 1024 + col0);
        if (u.split) {
#pragma unroll
            for (int ai = 0; ai < 2; ++ai)
#pragma unroll
                for (int m = 0; m < 4; ++m)
#pragma unroll
                    for (int j = 0; j < 4; ++j) { const f32x4 a4 = {acc[ai][0][m][0][j], acc[ai][0][m][1][j], acc[ai][1][m][0][j], acc[ai][1][m][1][j]};
                        if (!dry) *(f32x4*)((float*)(ws + WS_PART) + ((size_t)u.ks * MC + (row0 - ML) + ai * 128 + m * 16 + j) * D + col0) = gv * a4; }
            return;
        }
        float* Xb = (trow < ML ? XL + (size_t)row0 * D : (float*)(ws + WS_XC) + (size_t)(row0 - ML) * D) + col0;
        const float* Xr = (trow < ML ? XLsrc + (size_t)row0 * D : (const float*)(ws + WS_XC) + (size_t)(row0 - ML) * D) + col0;
#pragma unroll
        for (int ai = 0; ai < 2; ++ai) {
            f32x4 xv[4][4];
#pragma unroll
            for (int m = 0; m < 4; ++m)
#pragma unroll
                for (int j = 0; j < 4; ++j) xv[m][j] = *(const f32x4*)(Xr + (size_t)(ai * 128 + m * 16 + j) * D);
            __builtin_amdgcn_sched_barrier(0);
#pragma unroll
            for (int m = 0; m < 4; ++m)
#pragma unroll
                for (int j = 0; j < 4; ++j) { const f32x4 a4 = {acc[ai][0][m][0][j], acc[ai][0][m][1][j], acc[ai][1][m][0][j], acc[ai][1][m][1][j]};
                    const f32x4 o = xv[m][j] + gv * a4; if (!dry) *(f32x4*)(Xb + (size_t)(ai * 128 + m * 16 + j) * D) = o; }
            __builtin_amdgcn_sched_barrier(0);
        }
    }
};
struct EpiFF1 {
    static constexpr bool PERM = false, KEEP = false, NT = true;
    bf16_t* Hd;
    __device__ __forceinline__ void operator()(AccT& acc, const pg8::Unit& u, int wr, int wc, int fr, int fq) const {
        bf16_t* Hb = Hd + (size_t)(u.pm * 256 + wr * 64 + 4 * fq) * DFF + u.pn * 256 + wc * 64 + 4 * fr;
#pragma unroll
        for (int ai = 0; ai < 2; ++ai)
#pragma unroll
            for (int m = 0; m < 4; ++m)
#pragma unroll
                for (int j = 0; j < 4; ++j) {
                    const float a0 = fmaxf(acc[ai][0][m][0][j], 0.f), a1 = fmaxf(acc[ai][0][m][1][j], 0.f), a2 = fmaxf(acc[ai][1][m][0][j], 0.f), a3 = fmaxf(acc[ai][1][m][1][j], 0.f);
                    u32x2 w; w.x = pk2(a0 * a0, a1 * a1); w.y = pk2(a2 * a2, a3 * a3);
                    __builtin_nontemporal_store(w, (u32x2*)(Hb + (size_t)(ai * 128 + m * 16 + j) * DFF)); }
    }
};

__device__ __forceinline__ void transpose_item(const float* W, int ldn, int k0, int nsrc0, bf16_t* WT, int ldt, int ndst0, LAS float* scr, int lane) {
#pragma unroll 8
    for (int i = 0; i < 32; ++i) { const int kk = 2 * i + (lane >> 5); scr[kk * 33 + (lane & 31)] = W[(size_t)(k0 + kk) * ldn + nsrc0 + (lane & 31)]; }
    asm volatile("s_waitcnt lgkmcnt(0)" ::: "memory");
    const int c = lane & 7;
#pragma unroll
    for (int j = 0; j < 4; ++j) { const int n = (lane >> 3) + 8 * j; const LAS float* s = scr + (8 * c) * 33 + n;
        u32x4 o; o.x = pk2(s[0 * 33], s[1 * 33]); o.y = pk2(s[2 * 33], s[3 * 33]); o.z = pk2(s[4 * 33], s[5 * 33]); o.w = pk2(s[6 * 33], s[7 * 33]);
        *(u32x4*)(WT + (size_t)(ndst0 + n) * ldt + k0 + 8 * c) = o; }
    asm volatile("s_waitcnt lgkmcnt(0)" ::: "memory");
}
__device__ __forceinline__ void conv_seg(int& base, int gw, int NGW, const float* W, int K, int ldn, int nsrc0, int ncols, bf16_t* WT, int ldt, int ndst0, LAS float* scr, int lane) {
    const int nblk = ncols / 32, nitems = (K / 64) * nblk;
    int first = base + (((gw - base) % NGW) + NGW) % NGW;
    for (int it = first; it < base + nitems; it += NGW) { const int r = it - base, kb = r / nblk, nb = r - kb * nblk;
        transpose_item(W, ldn, 64 * kb, nsrc0 + 32 * nb, WT, ldt, ndst0 + 32 * nb, scr, lane); }
    base += nitems;
}
__device__ __forceinline__ void convert_stage_a(const KArgs& a, int l, int gw, int NGW, LAS float* scr, int) {
    const int lane = lane_id_asm();
    const float* W = a.w_in + (size_t)l * D * WIN; bf16_t* WT = (bf16_t*)(a.ws + WS_WB); int base = 0;
    conv_seg(base, gw, NGW, W, D, WIN, 0, 1024, WT, D, 0, scr, lane);
    conv_seg(base, gw, NGW, W, D, WIN, 1536, 1024, WT, D, 1024, scr, lane);
    conv_seg(base, gw, NGW, W, D, WIN, 2560, 512, WT, D, 2048, scr, lane);
    conv_seg(base, gw, NGW, W, D, WIN, 3072, 256, WT, D, 2560, scr, lane);
    conv_seg(base, gw, NGW, W, D, WIN, 1024, 512, WT, D, 2816, scr, lane);
    conv_seg(base, gw, NGW, W, D, WIN, 3328, 3072, WT, D, 3328, scr, lane);
}
__device__ __forceinline__ void convert_stage_b(const KArgs& a, int l, int gw, int NGW, LAS float* scr, int) {
    const int lane = lane_id_asm();
    bf16_t* WB = (bf16_t*)(a.ws + WS_WB); int base = 0;
    const float* wbr = a.w_branch + (size_t)l * 1536 * D;
    for (int i = 0; i < 3; ++i) conv_seg(base, gw, NGW, wbr + (size_t)i * 512 * D, 512, D, 0, D, WB + WB_BR + i * 524288, 512, 0, scr, lane);
    conv_seg(base, gw, NGW, a.w_out + (size_t)l * D * D, D, D, 0, D, WB + WB_OUT, D, 0, scr, lane);
    conv_seg(base, gw, NGW, a.w_ff1 + (size_t)l * D * DFF, D, DFF, 0, DFF, WB + WB_FF1, D, 0, scr, lane);
    conv_seg(base, gw, NGW, a.w_ff2 + (size_t)l * DFF * D, DFF, D, 0, D, WB + WB_FF2, DFF, 0, scr, lane);
}

__device__ __forceinline__ void phase0(const KArgs& a, LAS unsigned char* lds, int gw, int NGW, int wave, int lane) {
    LAS float* cond = (LAS float*)lds;
    LAS float* red = (LAS float*)(lds + 20480);
    const int tid = wave * 64 + lane;
    for (int i = tid; i < 5 * D; i += 512) { const int v = i >> 10, k = i & 1023; const float cv = v < 4 ? a.c[v * D + k] : a.c_ctx[k]; cond[i] = cv / (1.f + __expf(-cv)); }
    __syncthreads();
    float* mods = (float*)(a.ws + WS_MOD);
    const int col = tid & 127, kq = tid >> 7;
    for (int task = blockIdx.x; task < NL * 48; task += gridDim.x) {
        const int l = task / 48, cc = (task % 48) * 128 + col;
        const float* W = a.w_mod + (size_t)l * D * 6144 + cc;
        float s0 = 0.f, s1 = 0.f, s2 = 0.f, s3 = 0.f, s4 = 0.f;
#pragma unroll 32
        for (int k = kq * 256; k < kq * 256 + 256; ++k) { const float w = W[(size_t)k * 6144];
            s0 += w * cond[k]; s1 += w * cond[1024 + k]; s2 += w * cond[2048 + k]; s3 += w * cond[3072 + k]; s4 += w * cond[4096 + k]; }
        red[(kq * 5 + 0) * 128 + col] = s0; red[(kq * 5 + 1) * 128 + col] = s1; red[(kq * 5 + 2) * 128 + col] = s2; red[(kq * 5 + 3) * 128 + col] = s3; red[(kq * 5 + 4) * 128 + col] = s4;
        __syncthreads();
        for (int o = tid; o < 5 * 128; o += 512) { const int v = o >> 7, c2 = o & 127, ccol = (task % 48) * 128 + c2;
            const float r = red[(0 * 5 + v) * 128 + c2] + red[(1 * 5 + v) * 128 + c2] + red[(2 * 5 + v) * 128 + c2] + red[(3 * 5 + v) * 128 + c2];
            mods[((size_t)l * 5 + v) * 6144 + ccol] = r + a.b_mod[l * 6144 + ccol]; }
        __syncthreads();
    }
    __syncthreads();
    LAS float* scr = (LAS float*)(lds + 32768 + wave * 8448);
    bf16_t* LW = (bf16_t*)(a.ws + WS_LW);
    for (int it = gw; it < NL * 2 * 2 * 8 * 2; it += NGW) { const int half = it & 1, mi = it >> 1, n = mi & 7, mat = (mi >> 3) & 1, ld = mi >> 4;
        const float* W = (mat ? a.lru_wx : a.lru_wa) + ((size_t)ld * 8 + n) * 4096;
        transpose_item(W, 64, 0, 32 * half, LW + ((size_t)(ld * 2 + mat) * 8 + n) * 4096, 64, 32 * half, scr, lane); }
    convert_stage_a(a, 0, gw, NGW, scr, lane);
}

__device__ __forceinline__ void norm_phase(const KArgs& a, int l, bool second, int nrows, int gw, int NGW, int, int npart) {
    const int lane = lane_id_asm();
    const bool first_read = (l == 0 && !second);
    const float* srcL = first_read ? a.x : a.out; const float* srcC = first_read ? a.ctx : (const float*)(a.ws + WS_XC);
    float* XC = (float*)(a.ws + WS_XC); bf16_t* H = (bf16_t*)(a.ws + WS_H);
    const float* g = (second ? a.norm2_g : a.norm1_g) + l * D; const float* modl = (const float*)(a.ws + WS_MOD) + (size_t)l * 5 * 6144; const int sidx = second ? 3 : 0;
    auto load_row = [&](int row, f32x4 (&xv)[4]) {
        const float* src = row < ML ? srcL + (size_t)row * D : srcC + (size_t)(row - ML) * D;
        const f32x4* xr = (const f32x4*)src + lane;
#pragma unroll
        for (int j = 0; j < 4; ++j) xv[j] = xr[64 * j];
    };
    auto fold_row = [&](int row, f32x4 (&xv)[4]) {
        if (row >= ML && npart > 0) {
            const float* PART = (const float*)(a.ws + WS_PART);
            for (int sp = 0; sp < npart; sp += 4) { f32x4 pv[4][4];
#pragma unroll
                for (int q = 0; q < 4; ++q) { const f32x4* pr = (const f32x4*)(PART + ((size_t)(sp + q) * MC + (row - ML)) * D) + lane;
#pragma unroll
                    for (int j = 0; j < 4; ++j) pv[q][j] = pr[64 * j]; }
#pragma unroll
                for (int q = 0; q < 4; ++q)
#pragma unroll
                    for (int j = 0; j < 4; ++j) xv[j] += pv[q][j]; }
        }
        if (row >= ML && (npart > 0 || first_read)) { f32x4* xw = (f32x4*)(XC + (size_t)(row - ML) * D) + lane;
#pragma unroll
            for (int j = 0; j < 4; ++j) xw[64 * j] = xv[j]; }
    };
    auto ssq = [&](const f32x4 (&xv)[4]) { float s = 0.f;
#pragma unroll
        for (int j = 0; j < 4; ++j) s += (xv[j][0] * xv[j][0] + xv[j][1] * xv[j][1]) + (xv[j][2] * xv[j][2] + xv[j][3] * xv[j][3]);
        return s; };
    auto emit = [&](int row, const f32x4 (&xv)[4], float rstd) {
        const int v = row < ML ? (row >> 13) : 4; u32x2* o8 = (u32x2*)(H + (size_t)row * D) + lane;
#pragma unroll
        for (int j = 0; j < 4; ++j) { const int c = 4 * lane + 256 * j; const f32x4 gg = *(const f32x4*)(g + c), sh = *(const f32x4*)(modl + v * 6144 + sidx * 1024 + c), sc = *(const f32x4*)(modl + v * 6144 + (sidx + 1) * 1024 + c);
            f32x4 h = xv[j] * rstd * gg * (sc + 1.0f) + sh; u32x2 w; w.x = pk2(h[0], h[1]); w.y = pk2(h[2], h[3]); o8[64 * j] = w; }
    };
    for (int row = gw; row < nrows; row += 2 * NGW) {
        const int row1 = row + NGW; const bool has1 = row1 < nrows; const int r1 = has1 ? row1 : row;
        f32x4 xa[4], xb[4];
        load_row(row, xa); load_row(r1, xb);
        fold_row(row, xa); if (has1) fold_row(r1, xb);
        float sa = ssq(xa), sb = ssq(xb);
#pragma unroll
        for (int o = 1; o < 64; o <<= 1) { sa += shfl_lane(sa, lane ^ o); sb += shfl_lane(sb, lane ^ o); }
        emit(row, xa, 1.0f / sqrtf(sa * (1.f / D) + 1e-6f));
        if (has1) emit(r1, xb, 1.0f / sqrtf(sb * (1.f / D) + 1e-6f));
    }
}
__device__ __forceinline__ void final_norm(const KArgs& a, int gw, int NGW, int) {
    const int lane = lane_id_asm();
    for (int row = gw; row < ML; row += 2 * NGW) {
        const int row1 = row + NGW; const bool has1 = row1 < ML; const int r1 = has1 ? row1 : row;
        f32x4* xa = (f32x4*)(a.out + (size_t)row * D) + lane; f32x4* xb = (f32x4*)(a.out + (size_t)r1 * D) + lane; f32x4 va[4], vb[4]; float sa = 0.f, sb = 0.f;
#pragma unroll
        for (int j = 0; j < 4; ++j) { va[j] = xa[64 * j]; vb[j] = xb[64 * j]; }
#pragma unroll
        for (int j = 0; j < 4; ++j) { sa += (va[j][0] * va[j][0] + va[j][1] * va[j][1]) + (va[j][2] * va[j][2] + va[j][3] * va[j][3]); sb += (vb[j][0] * vb[j][0] + vb[j][1] * vb[j][1]) + (vb[j][2] * vb[j][2] + vb[j][3] * vb[j][3]); }
#pragma unroll
        for (int o = 1; o < 64; o <<= 1) { sa += shfl_lane(sa, lane ^ o); sb += shfl_lane(sb, lane ^ o); }
        const float ra = 1.0f / sqrtf(sa * (1.f / D) + 1e-6f), rb = 1.0f / sqrtf(sb * (1.f / D) + 1e-6f);
#pragma unroll
        for (int j = 0; j < 4; ++j) { const f32x4 gg = *(const f32x4*)(a.final_g + 4 * lane + 256 * j); xa[64 * j] = va[j] * ra * gg; if (has1) xb[64 * j] = vb[j] * rb * gg; }
    }
}

struct AttnSt { f32x4 o[4]; float m, l; };
struct KVF { bf16x8 k[4]; bf16x8 v[4]; };
__device__ __forceinline__ void kv_load(KVF& f, const bf16_t* kr0, const bf16_t* kr1, const bf16_t* kr2, const bf16_t* kr3, const bf16_t* vp) {
    f.k[0] = *(const bf16x8*)kr0; f.k[1] = *(const bf16x8*)kr1; f.k[2] = *(const bf16x8*)kr2; f.k[3] = *(const bf16x8*)kr3;
#pragma unroll
    for (int dt = 0; dt < 4; ++dt) f.v[dt] = *(const bf16x8*)(vp + (size_t)dt * 16 * VTOK);
}
__device__ __forceinline__ void k_to_frags(KVF& f, LAS unsigned char* slab, int lane) {
    LAS unsigned char* wp = slab + (lane >> 3) * 144 + (lane & 7) * 16;
    LAS unsigned char* wv = slab + 4608 + (lane >> 2) * 80 + (lane & 3) * 16;
#pragma unroll
    for (int j = 0; j < 4; ++j) { *(LAS bf16x8*)(wp + j * 8 * 144) = f.k[j]; *(LAS bf16x8*)(wv + j * 16 * 80) = f.v[j]; }
    asm volatile("s_waitcnt lgkmcnt(0)" ::: "memory");
    const int c16 = lane & 15, g = lane >> 4;
    const LAS unsigned char* rp = slab + (8 * (c16 >> 2) + (c16 & 3)) * 144 + g * 16;
    const LAS unsigned char* rv = slab + 4608 + c16 * 80 + g * 16;
    f.k[0] = *(const LAS bf16x8*)rp; f.k[1] = *(const LAS bf16x8*)(rp + 64); f.k[2] = *(const LAS bf16x8*)(rp + 4 * 144); f.k[3] = *(const LAS bf16x8*)(rp + 4 * 144 + 64);
#pragma unroll
    for (int dt = 0; dt < 4; ++dt) f.v[dt] = *(const LAS bf16x8*)(rv + dt * 16 * 80);
    asm volatile("s_waitcnt lgkmcnt(0)" ::: "memory");
}
template <class BiasF>
__device__ __forceinline__ void attn_compute(AttnSt& st, const KVF& f, const bf16x8 (&qf)[2], BiasF bias) {
    f32x4 s0 = {0.f, 0.f, 0.f, 0.f}, s1 = {0.f, 0.f, 0.f, 0.f};
    s0 = MFMA16(f.k[0], qf[0], s0); s0 = MFMA16(f.k[1], qf[1], s0); s1 = MFMA16(f.k[2], qf[0], s1); s1 = MFMA16(f.k[3], qf[1], s1);
    float t[8]; const float SC = 0.125f * LOG2E;
#pragma unroll
    for (int j = 0; j < 4; ++j) { t[j] = bias(j, s0[j] * SC); t[4 + j] = bias(4 + j, s1[j] * SC); }
    float bm = fmaxf(fmaxf(fmaxf(t[0], t[1]), fmaxf(t[2], t[3])), fmaxf(fmaxf(t[4], t[5]), fmaxf(t[6], t[7])));
    bm = xmax16(bm); bm = xmax32(bm);
    const bool grow = bm > st.m + 8.0f;
    if (__builtin_amdgcn_ballot_w64(grow) != 0ull) {
        const float mn = grow ? bm : st.m, alpha = fexp2(st.m - mn); st.m = mn; st.l *= alpha;
#pragma unroll
        for (int dt = 0; dt < 4; ++dt) st.o[dt] *= alpha;
    }
    const float mn = st.m;
    float ls = 0.f;
#pragma unroll
    for (int j = 0; j < 8; ++j) { t[j] = fexp2(t[j] - mn); ls += t[j]; }
    st.l += ls;
    u32x4 pw; pw.x = pk2(t[0], t[1]); pw.y = pk2(t[2], t[3]); pw.z = pk2(t[4], t[5]); pw.w = pk2(t[6], t[7]);
    const bf16x8 pf = __builtin_bit_cast(bf16x8, pw);
#pragma unroll
    for (int dt = 0; dt < 4; ++dt) st.o[dt] = MFMA16(f.v[dt], pf, st.o[dt]);
}
__device__ __forceinline__ void attn_init(AttnSt& st) {
#pragma unroll
    for (int dt = 0; dt < 4; ++dt) st.o[dt] = (f32x4){0.f, 0.f, 0.f, 0.f};
    st.m = -1.0e30f; st.l = 0.f;
}
__device__ __forceinline__ void attn_store(const AttnSt& st, float lextra, bf16_t* orow, int lane, bool dry) {
    float l = st.l; l = xsum16(l); l = xsum32(l); l += lextra;
    const float inv = 1.0f / l; const int g = lane >> 4;
#pragma unroll
    for (int dt = 0; dt < 4; ++dt) { const f32x4 o = st.o[dt] * inv; u32x2 w; w.x = pk2(o[0], o[1]); w.y = pk2(o[2], o[3]); if (!dry) *(u32x2*)(orow + 16 * dt + 4 * g) = w; }
}
__device__ __forceinline__ void na_item(const KArgs& a, int l, int item, LAS unsigned char* slab, bool dry) {
    const int lane = lane_id_asm();
    bf16_t* P = (bf16_t*)(a.ws + WS_P); const bf16_t* VT = (const bf16_t*)(a.ws + WS_VTA);
    const int i = item & 3, h = (item >> 2) & 7, r = (item >> 5) & 127, b = item >> 12;
    const int c16 = lane & 15, g = lane >> 4, kk0 = 8 * (c16 >> 2) + (c16 & 3);
    const int cq = 16 * i + c16; const size_t qrow = (size_t)b * S + r * 64 + cq;
    bf16x8 qf[2]; qf[0] = *(const bf16x8*)(P + qrow * PW + C_QA + h * 64 + 8 * g); qf[1] = *(const bf16x8*)(P + qrow * PW + C_QA + h * 64 + 32 + 8 * g);
    const int c0 = (i == 0) ? 0 : (i == 1 ? 8 : (i == 2 ? 24 : 32));
    const int rs = min(max(r - 4, 0), 120), cs = min(max(cq - 8, 0), 48);
    unsigned okm = 0; int idx0 = c0 + 8 * g - cq + 15;
#pragma unroll
    for (int e = 0; e < 8; ++e) { const int kc = c0 + 8 * g + e; okm |= ((kc >= cs) && (kc < cs + 16)) ? (1u << e) : 0u; }
    const float* rpb = a.na_rpb + ((size_t)l * 8 + h) * 15 * 31;
    const bf16_t* kcol = P + C_KA + h * 64 + (lane & 7) * 8 + (size_t)(lane >> 3) * PW; const bf16_t* vrow = VT + (size_t)((b * 8 + h) * 64 + (lane >> 2)) * VTOK + 8 * (lane & 3);
    AttnSt st; attn_init(st);
    KVF cur, nxt; float bc[8], bn[8];
#pragma unroll
    for (int e = 0; e < 8; ++e) { bc[e] = 0.f; bn[e] = 0.f; }
    auto loadblk = [&](int blk, KVF& f, float (&bb)[8]) {
        if (blk < 8) { const int R = rs + blk; const size_t tok0 = (size_t)R * 64 + c0; const bf16_t* kp = kcol + ((size_t)b * S + tok0) * PW;
            kv_load(f, kp, kp + (size_t)8 * PW, kp + (size_t)16 * PW, kp + (size_t)24 * PW, vrow + tok0);
            const float* rp = rpb + (R - r + 7) * 31;
#pragma unroll
            for (int e = 0; e < 8; ++e) bb[e] = rp[min(max(idx0 + e, 0), 30)];
        } else { const int cb = blk - 8; const bf16_t* kp = kcol + ((size_t)ML + b * CTX + 32 * cb) * PW; kv_load(f, kp, kp + (size_t)8 * PW, kp + (size_t)16 * PW, kp + (size_t)24 * PW, vrow + 8192 + 32 * cb); }
    };
    loadblk(0, cur, bc);
    for (int blk = 0; blk < 16; ++blk) {
        loadblk(blk < 15 ? blk + 1 : 15, nxt, bn);
        k_to_frags(cur, slab, lane);
        if (blk < 8) attn_compute(st, cur, qf, [&](int e, float s) { return ((okm >> e) & 1u) ? s + bc[e] * LOG2E : NEGBIG; });
        else attn_compute(st, cur, qf, [](int, float s) { return s; });
        cur = nxt;
#pragma unroll
        for (int e = 0; e < 8; ++e) bc[e] = bn[e];
    }
    attn_store(st, 0.f, P + qrow * PW + C_QA + h * 64, lane, dry);
}
__device__ __forceinline__ void na_pair(const KArgs& a, int l, int pitem, LAS unsigned char* slab, bool dry) {
    const int lane = lane_id_asm();
    bf16_t* P = (bf16_t*)(a.ws + WS_P); const bf16_t* VT = (const bf16_t*)(a.ws + WS_VTA);
    const int i0 = 2 * (pitem & 1), h = (pitem >> 1) & 7, r = (pitem >> 4) & 127, b = pitem >> 11;
    const int c16 = lane & 15, g = lane >> 4;
    const int rs = min(max(r - 4, 0), 120);
    const float* rpb = a.na_rpb + ((size_t)l * 8 + h) * 15 * 31;
    const bf16_t* kcol = P + C_KA + h * 64 + (lane & 7) * 8 + (size_t)(lane >> 3) * PW; const bf16_t* vrow = VT + (size_t)((b * 8 + h) * 64 + (lane >> 2)) * VTOK + 8 * (lane & 3);
    AttnSt stA, stB; attn_init(stA); attn_init(stB);
    bf16x8 qA[2], qB[2];
    const size_t qrowA = (size_t)b * S + r * 64 + 16 * i0 + c16, qrowB = qrowA + 16;
    qA[0] = *(const bf16x8*)(P + qrowA * PW + C_QA + h * 64 + 8 * g); qA[1] = *(const bf16x8*)(P + qrowA * PW + C_QA + h * 64 + 32 + 8 * g);
    qB[0] = *(const bf16x8*)(P + qrowB * PW + C_QA + h * 64 + 8 * g); qB[1] = *(const bf16x8*)(P + qrowB * PW + C_QA + h * 64 + 32 + 8 * g);
    auto local_pass = [&](AttnSt& st, const bf16x8 (&qf)[2], int i) {
        const int cq = 16 * i + c16, c0 = (i == 0) ? 0 : (i == 1 ? 8 : (i == 2 ? 24 : 32)), cs = min(max(cq - 8, 0), 48);
        unsigned okm = 0; const int idx0 = c0 + 8 * g - cq + 15;
#pragma unroll
        for (int e = 0; e < 8; ++e) { const int kc = c0 + 8 * g + e; okm |= ((kc >= cs) && (kc < cs + 16)) ? (1u << e) : 0u; }
        KVF cur, nxt; float bc[8], bn[8];
        auto loadblk = [&](int blk, KVF& f, float (&bb)[8]) { const int R = rs + blk; const size_t tok0 = (size_t)R * 64 + c0; const bf16_t* kp = kcol + ((size_t)b * S + tok0) * PW;
            kv_load(f, kp, kp + (size_t)8 * PW, kp + (size_t)16 * PW, kp + (size_t)24 * PW, vrow + tok0);
            const float* rp = rpb + (R - r + 7) * 31;
#pragma unroll
            for (int e = 0; e < 8; ++e) bb[e] = rp[min(max(idx0 + e, 0), 30)]; };
        loadblk(0, cur, bc);
        for (int blk = 0; blk < 8; ++blk) {
            loadblk(blk < 7 ? blk + 1 : 7, nxt, bn);
            k_to_frags(cur, slab, lane);
            attn_compute(st, cur, qf, [&](int e, float s) { return ((okm >> e) & 1u) ? s + bc[e] * LOG2E : NEGBIG; });
            cur = nxt;
#pragma unroll
            for (int e = 0; e < 8; ++e) bc[e] = bn[e];
        }
    };
    local_pass(stA, qA, i0);
    local_pass(stB, qB, i0 + 1);
    {
        KVF cur, nxt;
        auto loadctx = [&](int cb, KVF& f) { const bf16_t* kp = kcol + ((size_t)ML + b * CTX + 32 * cb) * PW; kv_load(f, kp, kp + (size_t)8 * PW, kp + (size_t)16 * PW, kp + (size_t)24 * PW, vrow + 8192 + 32 * cb); };
        loadctx(0, cur);
        for (int cb = 0; cb < 8; ++cb) {
            loadctx(cb < 7 ? cb + 1 : 7, nxt);
            k_to_frags(cur, slab, lane);
            attn_compute(stA, cur, qA, [](int, float s) { return s; }); attn_compute(stB, cur, qB, [](int, float s) { return s; });
            cur = nxt;
        }
    }
    attn_store(stA, 0.f, P + qrowA * PW + C_QA + h * 64, lane, dry);
    attn_store(stB, 0.f, P + qrowB * PW + C_QA + h * 64, lane, dry);
}
__device__ __forceinline__ void ctx_item(const KArgs& a, int l, int item, bool swa, int lane, LAS unsigned char* slab, bool dry) {
    bf16_t* P = (bf16_t*)(a.ws + WS_P);
    const int i = item & 15, h = (item >> 4) & 7, b = item >> 7;
    const int c16 = lane & 15, g = lane >> 4, kk0 = 8 * (c16 >> 2) + (c16 & 3);
    const size_t qrow = (size_t)ML + b * CTX + 16 * i + c16; const int qc = (swa ? C_QS : C_QA) + h * 64;
    bf16x8 qf[2]; qf[0] = *(const bf16x8*)(P + qrow * PW + qc + 8 * g); qf[1] = *(const bf16x8*)(P + qrow * PW + qc + 32 + 8 * g);
    const bf16_t* kcol = P + (swa ? C_KS + (h >> 2) * 64 : C_KA + h * 64) + (lane & 7) * 8 + (size_t)(lane >> 3) * PW;
    const bf16_t* vrow = (swa ? (const bf16_t*)(a.ws + WS_VTS) + (size_t)((b * 2 + (h >> 2)) * 64 + (lane >> 2)) * VTOK : (const bf16_t*)(a.ws + WS_VTA) + (size_t)((b * 8 + h) * 64 + (lane >> 2)) * VTOK) + 8 * (lane & 3);
    AttnSt st; attn_init(st);
    for (int cb = 0; cb < 8; ++cb) { KVF f; const bf16_t* kp = kcol + ((size_t)ML + b * CTX + 32 * cb) * PW; kv_load(f, kp, kp + (size_t)8 * PW, kp + (size_t)16 * PW, kp + (size_t)24 * PW, vrow + 8192 + 32 * cb);
        k_to_frags(f, slab, lane);
        attn_compute(st, f, qf, [](int, float s) { return s; }); }
    const float lex = swa ? fexp2(a.swa_sink[l * 8 + h] * LOG2E - st.m) : 0.f;
    attn_store(st, lex, P + qrow * PW + qc, lane, dry);
}
__device__ __forceinline__ float inv_freq(int f) { return exp2f(-(float)f * (13.287712379549449f / 16.0f)); }
__device__ __forceinline__ void rope_cs(int pos, int f, float& c, float& s) {
    const float ang = (float)pos * inv_freq(f); float rev = ang * 0.15915494309189535f; rev -= rintf(rev);
    c = __builtin_amdgcn_cosf(rev); s = __builtin_amdgcn_sinf(rev);
}
__device__ __forceinline__ void rope_q(bf16x8 (&qf)[2], int tq, int g) {
    const int pos = (g < 2) ? (tq >> 6) : (tq & 63);
    u32x4 w0 = __builtin_bit_cast(u32x4, qf[0]), w1 = __builtin_bit_cast(u32x4, qf[1]);
#pragma unroll
    for (int q = 0; q < 4; ++q) {
        float c0, s0, c1, s1; rope_cs(pos, 8 * (g & 1) + 2 * q, c0, s0); rope_cs(pos, 8 * (g & 1) + 2 * q + 1, c1, s1);
        const float a0 = bflo(w0[q]), a1 = bfhi(w0[q]), b0 = bflo(w1[q]), b1 = bfhi(w1[q]);
        w0[q] = pk2(a0 * c0 - b0 * s0, a1 * c1 - b1 * s1); w1[q] = pk2(b0 * c0 + a0 * s0, b1 * c1 + a1 * s1);
    }
    qf[0] = __builtin_bit_cast(bf16x8, w0); qf[1] = __builtin_bit_cast(bf16x8, w1);
}
__device__ __forceinline__ void swa_item(const KArgs& a, int l, int item, LAS unsigned char* slab, bool dry) {
    const int lane = lane_id_asm();
    bf16_t* P = (bf16_t*)(a.ws + WS_P); const bf16_t* VT = (const bf16_t*)(a.ws + WS_VTS);
    const int qt = item & 511, hp = (item >> 9) & 1, kvh = (item >> 10) & 1, b = item >> 11, h0 = 4 * kvh + 2 * hp;
    const int c16 = lane & 15, g = lane >> 4, kk0 = 8 * (c16 >> 2) + (c16 & 3);
    const int tq = 16 * qt + c16; const size_t qrow = (size_t)b * S + tq;
    bf16x8 qa[2], qb[2];
    qa[0] = *(const bf16x8*)(P + qrow * PW + C_QS + h0 * 64 + 8 * g); qa[1] = *(const bf16x8*)(P + qrow * PW + C_QS + h0 * 64 + 32 + 8 * g);
    qb[0] = *(const bf16x8*)(P + qrow * PW + C_QS + h0 * 64 + 64 + 8 * g); qb[1] = *(const bf16x8*)(P + qrow * PW + C_QS + h0 * 64 + 96 + 8 * g);
    rope_q(qa, tq, g); rope_q(qb, tq, g);
    const bf16_t* kcol = P + C_KS + kvh * 64 + (lane & 7) * 8; const bf16_t* vrow = VT + (size_t)((b * 2 + kvh) * 64 + (lane >> 2)) * VTOK + 8 * (lane & 3); const int lr = lane >> 3;
    AttnSt sa, sb; attn_init(sa); attn_init(sb);
    const int kstart = 16 * qt - 128;
    int bfirst = 0, blast = 8; while (kstart + 32 * bfirst + 31 < 0) ++bfirst; while (kstart + 32 * blast >= S) --blast;
    const int nblk = (blast - bfirst + 1) + 8;
    KVF cur, nxt;
    auto loadblk = [&](int q, KVF& f) {
        const int lb = bfirst + q;
        if (lb <= blast) { const int k0 = kstart + 32 * lb + lr; const int r0 = min(max(k0, 0), S - 1), r1 = min(max(k0 + 8, 0), S - 1), r2 = min(max(k0 + 16, 0), S - 1), r3 = min(max(k0 + 24, 0), S - 1), vt = min(max(k0 - lr + 8 * (lane & 3), 0), S - 8);
            const bf16_t* kb = kcol + (size_t)b * S * PW;
            kv_load(f, kb + (size_t)r0 * PW, kb + (size_t)r1 * PW, kb + (size_t)r2 * PW, kb + (size_t)r3 * PW, VT + (size_t)((b * 2 + kvh) * 64 + (lane >> 2)) * VTOK + vt);
        } else { const int cb = lb - blast - 1; const bf16_t* kp = kcol + ((size_t)ML + b * CTX + 32 * cb + lr) * PW; kv_load(f, kp, kp + (size_t)8 * PW, kp + (size_t)16 * PW, kp + (size_t)24 * PW, vrow + 8192 + 32 * cb); }
    };
    loadblk(0, cur);
    for (int q = 0; q < nblk; ++q) {
        loadblk(q + 1 < nblk ? q + 1 : q, nxt);
        k_to_frags(cur, slab, lane);
        const int lb = bfirst + q;
        if (lb <= blast) { const int kbase = kstart + 32 * lb + 8 * g;
            auto msk = [&](int e, float s) { const int k = kbase + e, dlt = k - tq; return ((k >= 0) && (k < S) && (dlt <= 128) && (dlt >= -128)) ? s : NEGBIG; };
            attn_compute(sa, cur, qa, msk); attn_compute(sb, cur, qb, msk);
        } else { attn_compute(sa, cur, qa, [](int, float s) { return s; }); attn_compute(sb, cur, qb, [](int, float s) { return s; }); }
        cur = nxt;
    }
    attn_store(sa, fexp2(a.swa_sink[l * 8 + h0] * LOG2E - sa.m), P + qrow * PW + C_QS + h0 * 64, lane, dry);
    attn_store(sb, fexp2(a.swa_sink[l * 8 + h0 + 1] * LOG2E - sb.m), P + qrow * PW + C_QS + h0 * 64 + 64, lane, dry);
}
__device__ __forceinline__ void rope_k_phase(const KArgs& a, int gw, int NGW, int, bool dry) {
    const int lane = lane_id_asm();
    bf16_t* P = (bf16_t*)(a.ws + WS_P);
    const int hd = lane >> 5, i = lane & 31;
    for (int row = gw; row < ML; row += NGW) {
        const int t = row & (S - 1); const int pos = (i < 16) ? (t >> 6) : (t & 63);
        float c, s; rope_cs(pos, i & 15, c, s);
        bf16_t* p = P + (size_t)row * PW + C_KS + hd * 64;
        const float t1 = bf2f(p[i]), t2 = bf2f(p[i + 32]);
        const unsigned w = pk2(t1 * c - t2 * s, t2 * c + t1 * s);
        if (!dry) { p[i] = (bf16_t)(w & 0xffff); p[i + 32] = (bf16_t)(w >> 16); }
    }
}

__device__ __forceinline__ float softplus_neg(float lam) {
    const float x = __expf(-fmaxf(lam, -80.f));
    const float ser = x * (1.f - x * (0.5f - x * (0.33333334f - x * (0.25f - x * 0.2f))));
    const float big = (lam < -15.f) ? -lam : __builtin_amdgcn_logf(1.f + x) * 0.6931471806f;
    return x < 0.03f ? ser : big;
}
__device__ __forceinline__ float neg_expm1(float x) {
    const float ser = -x * (1.f + x * (0.5f + x * (0.16666667f + x * (0.041666668f + x * (0.0083333338f + x * 0.0013888889f)))));
    return x > -0.25f ? ser : 1.f - __expf(x);
}
template <int DIR, bool WRITE>
__device__ __forceinline__ void lru_sweep(const KArgs& a, int l, int b, int n, int sp, float (&carry)[4], float (&arun)[4], int lane, LAS unsigned char* wl, bool dry = false) {
    bf16_t* P = (bf16_t*)(a.ws + WS_P); float* HT = (float*)(a.ws + WS_H); const bf16_t* LW = (const bf16_t*)(a.ws + WS_LW);
    const int c16 = lane & 15, g = lane >> 4; const int gg = DIR ? 3 - g : g;
    const bool lat = sp < 64; const int rowbase = lat ? b * S : ML + b * CTX, seglen = lat ? S : CTX, t0 = (lat ? sp : sp - 64) * 128;
    float ba[4], bx[4], spc[4];
#pragma unroll
    for (int nt = 0; nt < 4; ++nt) { const int ch = n * 64 + 16 * nt + c16, o = (l * 2 + DIR) * 512 + ch;
        ba[nt] = a.lru_ba[o]; bx[nt] = a.lru_bx[o]; const float lam = a.lru_lambda[o]; spc[nt] = softplus_neg(lam); }
    LAS float* cwl = (LAS float*)(wl + 18432);
    {
        const float* cw = a.conv_w + (size_t)l * 4 * 512 + n * 64; const float* cbias = a.conv_b + (size_t)l * 512 + n * 64;
        int lq = lane; asm volatile("" : "+v"(lq));
        const bf16_t* wsrc = LW + ((size_t)((l * 2 + DIR) * 2) * 8 + n) * 4096 + lq * 8;
        LAS unsigned char* wdst = wl + (lq >> 3) * 144 + (lq & 7) * 16;
#pragma unroll
        for (int mat = 0; mat < 2; ++mat) {
            u32x4 wv[8];
#pragma unroll
            for (int k = 0; k < 8; ++k) wv[k] = *(const u32x4*)(wsrc + mat * 32768 + k * 512);
#pragma unroll
            for (int k = 0; k < 8; ++k) *(LAS u32x4*)(wdst + mat * 9216 + k * 1152) = wv[k];
        }
        float cv[5];
#pragma unroll
        for (int i = 0; i < 4; ++i) cv[i] = cw[i * 512 + lq];
        cv[4] = cbias[lq];
#pragma unroll
        for (int i = 0; i < 5; ++i) cwl[i * 64 + lq] = cv[i];
        asm volatile("s_waitcnt lgkmcnt(0)" ::: "memory");
    }
    const LAS unsigned char* wfr = wl + c16 * 144 + 16 * g;
    const int srcm = DIR ? lane + 16 : lane - 16, srcm2 = DIR ? lane + 32 : lane - 32, srct = DIR ? c16 : 48 + c16;
    for (int ti = 0; ti < 8; ++ti) {
        asm volatile("" ::: "memory");
        const int tile = DIR ? 7 - ti : ti; const int tt = t0 + 16 * tile; const int t = tt + c16;
        int lv = lane; asm volatile("" : "+v"(lv)); const int idt = (lv & 15) - 8 * (lv >> 4);
        f32x4* HT4 = (f32x4*)HT + ((size_t)((rowbase + tt) >> 2) + g) * 512 + n * 64 + c16;
        f32x4 htv[4]; unsigned short gbr[4][4];
        if (WRITE && DIR == 1) {
#pragma unroll
            for (int nt = 0; nt < 4; ++nt) { htv[nt] = HT4[16 * nt];
#pragma unroll
                for (int j = 0; j < 4; ++j) gbr[nt][j] = P[(size_t)(rowbase + tt + 4 * g + j) * PW + C_GB + n * 64 + 16 * nt + c16]; }
        }
        bf16x8 uf[2];
        u32x4 xr[2][4];
#pragma unroll
        for (int ks = 0; ks < 2; ++ks)
#pragma unroll
            for (int i = 0; i < 4; ++i) { const int tc = min(max(t + i - 2, 0), seglen - 1); xr[ks][i] = *(const u32x4*)(P + (size_t)(rowbase + tc) * PW + C_XB + n * 64 + 32 * ks + 8 * g); }
#pragma unroll
        for (int ks = 0; ks < 2; ++ks) { const int chl = 32 * ks + 8 * g;
            f32x4 u0 = *(const LAS f32x4*)(cwl + 256 + chl), u1 = *(const LAS f32x4*)(cwl + 256 + chl + 4);
#pragma unroll
            for (int i = 0; i < 4; ++i) { const int tp = t + i - 2; const bool ok = (tp >= 0) && (tp < seglen);
                const u32x4 xw = xr[ks][i];
                f32x4 w0 = *(const LAS f32x4*)(cwl + i * 64 + chl), w1 = *(const LAS f32x4*)(cwl + i * 64 + chl + 4);
                if (!ok) { w0 = (f32x4){0.f, 0.f, 0.f, 0.f}; w1 = w0; }
                u0[0] += w0[0] * bflo(xw[0]); u0[1] += w0[1] * bfhi(xw[0]); u0[2] += w0[2] * bflo(xw[1]); u0[3] += w0[3] * bfhi(xw[1]);
                u1[0] += w1[0] * bflo(xw[2]); u1[1] += w1[1] * bfhi(xw[2]); u1[2] += w1[2] * bflo(xw[3]); u1[3] += w1[3] * bfhi(xw[3]); }
            u32x4 pw; pw.x = pk2(u0[0], u0[1]); pw.y = pk2(u0[2], u0[3]); pw.z = pk2(u1[0], u1[1]); pw.w = pk2(u1[2], u1[3]);
            uf[ks] = __builtin_bit_cast(bf16x8, pw); }
#pragma unroll
        for (int nt = 0; nt < 4; ++nt) {
            f32x4 ga = {0.f, 0.f, 0.f, 0.f}, gx = ga, ud = ga;
#pragma unroll
            for (int ks = 0; ks < 2; ++ks) {
                const bf16x8 wa = *(const LAS bf16x8*)(wfr + nt * 2304 + ks * 64), wx = *(const LAS bf16x8*)(wfr + 9216 + nt * 2304 + ks * 64);
                bf16x8 idf;
#pragma unroll
                for (int j = 0; j < 8; ++j) idf[j] = (32 * ks + j == 16 * nt + idt) ? (short)0x3F80 : (short)0;
                ga = MFMA16(uf[ks], wa, ga); gx = MFMA16(uf[ks], wx, gx); ud = MFMA16(uf[ks], idf, ud);
            }
            float av[4], bv[4];
#pragma unroll
            for (int j = 0; j < 4; ++j) {
                const float r = frcp(1.f + __expf(-(ga[j] + ba[nt]))), ii = frcp(1.f + __expf(-(gx[j] + bx[nt])));
                const float la = -8.0f * r * spc[nt];
                av[j] = __expf(la); bv[j] = __builtin_amdgcn_sqrtf(neg_expm1(2.0f * la)) * ii * ud[j];
            }
            float Pj[4], Hj[4];
#pragma unroll
            for (int jj = 0; jj < 4; ++jj) { const int j = DIR ? 3 - jj : jj;
                if (jj == 0) { Pj[0] = av[j]; Hj[0] = bv[j]; } else { Pj[jj] = Pj[jj - 1] * av[j]; Hj[jj] = av[j] * Hj[jj - 1] + bv[j]; } }
            float Ai = Pj[3], Hi = Hj[3];
            { const float A1 = shfl_lane(Ai, srcm), H1 = shfl_lane(Hi, srcm); if (gg >= 1) { Hi = Ai * H1 + Hi; Ai = Ai * A1; } }
            { const float A2 = shfl_lane(Ai, srcm2), H2 = shfl_lane(Hi, srcm2); if (gg >= 2) { Hi = Ai * H2 + Hi; Ai = Ai * A2; } }
            float Ae = shfl_lane(Ai, srcm), He = shfl_lane(Hi, srcm); if (gg == 0) { Ae = 1.f; He = 0.f; }
            const float At = shfl_lane(Ai, srct), Ht = shfl_lane(Hi, srct);
            const float cin = Ae * carry[nt] + He;
            if (WRITE) {
                f32x4 hv4;
#pragma unroll
                for (int jj = 0; jj < 4; ++jj) { const int j = DIR ? 3 - jj : jj; hv4[j] = Hj[jj] + Pj[jj] * cin; }
                if (DIR == 0) HT4[16 * nt] = hv4;
                else {
#pragma unroll
                    for (int j = 0; j < 4; ++j) { const float gbv = bf2f(gbr[nt][j]); const float y = htv[nt][j] + hv4[j];
                        const float z = 0.7978845608028654f * (gbv + 0.044715f * gbv * gbv * gbv); const float th = 1.f - 2.f * frcp(1.f + __expf(2.f * z));
                        const float ge = 0.5f * gbv * (1.f + th);
                        if (!dry) P[(size_t)(rowbase + tt + 4 * g + j) * PW + C_GB + n * 64 + 16 * nt + c16] = (bf16_t)(pk2(y * ge, 0.f) & 0xffff); }
                }
            }
            carry[nt] = At * carry[nt] + Ht; arun[nt] *= At;
        }
    }
}
__device__ __forceinline__ void lru_pass1_item(const KArgs& a, int l, int item, int lane, LAS unsigned char* wl) {
    const int dir = item & 1, n = (item >> 1) & 7, rest = item >> 4, sp = rest % 66, b = rest / 66;
    float carry[4] = {0.f, 0.f, 0.f, 0.f}, arun[4] = {1.f, 1.f, 1.f, 1.f};
    if (dir) lru_sweep<1, false>(a, l, b, n, sp, carry, arun, lane, wl); else lru_sweep<0, false>(a, l, b, n, sp, carry, arun, lane, wl);
    float* SUM = (float*)(a.ws + WS_SUM);
    if (lane < 16) {
#pragma unroll
        for (int nt = 0; nt < 4; ++nt) { float* p = SUM + ((size_t)((b * 66 + sp) * 2 + dir) * 512 + n * 64 + 16 * nt + lane) * 2; p[0] = arun[nt]; p[1] = carry[nt]; }
    }
}
template <int DIR>
__device__ __forceinline__ void lru_carry(const float* SUM, int b, int n, int sp, int lane, float (&carry)[4]) {
    typedef float f32x2v __attribute__((ext_vector_type(2)));
    const int c16 = lane & 15, g = lane >> 4;
    const int npred = DIR ? 65 - sp : (sp < 64 ? sp + 2 : sp - 64);
    const int q = (npred + 3) >> 2, i0 = g * q, i1 = min(i0 + q, npred);
    float Ac[4] = {1.f, 1.f, 1.f, 1.f}, Hc[4] = {0.f, 0.f, 0.f, 0.f};
    for (int i = i0; i < i1; i += 4) {
        f32x2v v[4][4];
#pragma unroll
        for (int u = 0; u < 4; ++u) { const int ii = min(i + u, i1 - 1); const int p = DIR ? 65 - ii : (ii < 2 ? 64 + ii : ii - 2);
#pragma unroll
            for (int nt = 0; nt < 4; ++nt) { v[u][nt] = *(const f32x2v*)(SUM + ((size_t)((b * 66 + p) * 2 + DIR) * 512 + n * 64 + 16 * nt + c16) * 2); if (i + u >= i1) v[u][nt] = (f32x2v){1.f, 0.f}; } }
#pragma unroll
        for (int u = 0; u < 4; ++u)
#pragma unroll
            for (int nt = 0; nt < 4; ++nt) { Hc[nt] = v[u][nt].x * Hc[nt] + v[u][nt].y; Ac[nt] = v[u][nt].x * Ac[nt]; }
    }
#pragma unroll
    for (int nt = 0; nt < 4; ++nt) { float c = 0.f;
#pragma unroll
        for (int gi = 0; gi < 4; ++gi) { const float Ag = shfl_lane(Ac[nt], c16 + 16 * gi), Hg = shfl_lane(Hc[nt], c16 + 16 * gi); c = Ag * c + Hg; }
        carry[nt] = c; }
}
__device__ __forceinline__ void lru_pass2_item(const KArgs& a, int l, int item, int lane, LAS unsigned char* wl, bool dry) {
    const int n = item & 7, rest = item >> 3, sp = rest % 66, b = rest / 66;
    const float* SUM = (const float*)(a.ws + WS_SUM);
    float carry[4], arun[4] = {1.f, 1.f, 1.f, 1.f};
    lru_carry<0>(SUM, b, n, sp, lane, carry);
    lru_sweep<0, true>(a, l, b, n, sp, carry, arun, lane, wl);
    lru_carry<1>(SUM, b, n, sp, lane, carry);
    lru_sweep<1, true>(a, l, b, n, sp, carry, arun, lane, wl, dry);
}

#define XB_TMO      128
#define XB_XCNT(j)  (256  + 64 * (j))
#define XB_XSUB(j)  (1280 + 64 * (j))
#define XB_XGEN(j)  (2304 + 64 * (j))
#define XB_TOP      3328
#define XB_TOPGEN   3392
#define XCD_BAR_WORDS 3456
#define XB_SPIN_CAP (1u << 18)
__device__ __forceinline__ unsigned xb_ld(unsigned* p)              { return __hip_atomic_load(p, __ATOMIC_RELAXED, __HIP_MEMORY_SCOPE_AGENT); }
__device__ __forceinline__ unsigned xb_add(unsigned* p, unsigned v) { return __hip_atomic_fetch_add(p, v, __ATOMIC_RELAXED, __HIP_MEMORY_SCOPE_AGENT); }
__device__ __forceinline__ unsigned xb_xcc_id() { return (unsigned)__builtin_amdgcn_s_getreg((3 << 11) | 20) & 0xFu; }
#define XB_SPIN(cond, bar) do { unsigned _sp = 0; while (cond) { __builtin_amdgcn_s_sleep(1); \
    if ((++_sp & 255u) == 0u) { if (xb_ld(&(bar)[XB_TMO])) break; if (_sp > XB_SPIN_CAP) { atomicAdd(&(bar)[XB_TMO], 1u); break; } } } } while (0)
struct XcdBarrier { unsigned* bar; unsigned x; volatile LAS unsigned* st; };
__device__ __forceinline__ XcdBarrier xcd_barrier_post(unsigned* bar, volatile LAS unsigned* st) {
    XcdBarrier b; b.bar = bar; b.x = xb_xcc_id(); b.st = st;
    if (threadIdx.x == 0) (void)xb_add(&bar[XB_XCNT(b.x)], 1u);
    return b;
}
__device__ __forceinline__ void xcd_barrier_complete(unsigned* bar, unsigned x, unsigned& nloc, unsigned& nx) {
    const unsigned G = gridDim.x * gridDim.y * gridDim.z;
    unsigned sum, cnt, mine, sp = 0u;
    for (;;) {
        sum = 0u; cnt = 0u; mine = 0u;
#pragma unroll
        for (unsigned j = 0; j < 16; ++j) { const unsigned c = xb_ld(&bar[XB_XCNT(j)]); sum += c; cnt += (c > 0u) ? 1u : 0u; mine = (j == x) ? c : mine; }
        if (sum == G) break;
        __builtin_amdgcn_s_sleep(1);
        if ((++sp & 255u) == 0u) { if (xb_ld(&bar[XB_TMO])) break; if (sp > XB_SPIN_CAP) { atomicAdd(&bar[XB_TMO], 1u); break; } }
    }
    nloc = mine > 0u ? mine : 1u; nx = cnt > 0u ? cnt : 1u;
}
__device__ __forceinline__ void xcd_barrier(const XcdBarrier& b) {
    asm volatile("s_waitcnt vmcnt(0)" ::: "memory");
    __syncthreads();
    if (threadIdx.x == 0) {
        unsigned* bar = b.bar;
        __builtin_amdgcn_s_waitcnt(0);
        unsigned nloc = b.st[0], nx = b.st[1];
        if (nloc == 0u) { xcd_barrier_complete(bar, b.x, nloc, nx); b.st[0] = nloc; b.st[1] = nx; }
        const unsigned old = xb_add(&bar[XB_XSUB(b.x)], 1u);
        const unsigned gen = old / nloc;
        if (old + 1u == (gen + 1u) * nloc) {
            __builtin_amdgcn_fence(__ATOMIC_RELEASE, "agent");
            asm volatile("s_waitcnt vmcnt(0)" ::: "memory");
            const unsigned og = xb_add(&bar[XB_TOP], 1u);
            const unsigned tg = og / nx;
            if (og + 1u == (tg + 1u) * nx) xb_add(&bar[XB_TOPGEN], 1u);
            else XB_SPIN(xb_ld(&bar[XB_TOPGEN]) == tg, bar);
            __builtin_amdgcn_fence(__ATOMIC_ACQUIRE, "agent");
            xb_add(&bar[XB_XGEN(b.x)], 1u);
            asm volatile("s_waitcnt vmcnt(0)" ::: "memory");
        } else {
            XB_SPIN(xb_ld(&bar[XB_XGEN(b.x)]) == gen, bar);
            __builtin_amdgcn_fence(__ATOMIC_ACQUIRE, "agent");
            asm volatile("s_waitcnt vmcnt(0)" ::: "memory");
        }
    }
    __syncthreads();
}

__global__ void __launch_bounds__(512, 2) fwd_kernel(KArgs a) {
    extern __shared__ __attribute__((aligned(16))) unsigned char smem[];
    LAS unsigned char* lds = (LAS unsigned char*)smem;
    cg::grid_group grid = cg::this_grid();
    const int G = gridDim.x, NGW = G * 8;
    const int wave = __builtin_amdgcn_readfirstlane(threadIdx.x >> 6);
    volatile LAS unsigned* bst = (volatile LAS unsigned*)(lds + 8 * WAVE_LDS);
    if (threadIdx.x < 2) bst[threadIdx.x] = 0u;
    __syncthreads();
    XcdBarrier xbar; xbar.bar = (unsigned*)(a.ws + WS_BAR); xbar.x = 0; xbar.st = bst;
    if (a.ph_hi - a.ph_lo > 1) xbar = xcd_barrier_post((unsigned*)(a.ws + WS_BAR), bst);
    for (int ph = a.ph_lo; ph < a.ph_hi; ++ph) {
        bf16_t* P = (bf16_t*)(a.ws + WS_P); bf16_t* H = (bf16_t*)(a.ws + WS_H); bf16_t* WB = (bf16_t*)(a.ws + WS_WB);
        float* XC = (float*)(a.ws + WS_XC);
        int lane = lane_id_asm(); const int gw = blockIdx.x * 8 + wave;
        if (ph == 0) phase0(a, lds, gw, NGW, wave, lane);
        else if (ph == 37) final_norm(a, gw, NGW, lane);
        else {
            const int l = (ph - 1) / 9, k = (ph - 1) % 9; const bool lastl = (l == NL - 1); const int Mrows = lastl ? ML : MT;
            const float* modl = (const float*)(a.ws + WS_MOD) + (size_t)l * 5 * 6144;
            const int reps = ((PROBE_MASK >> k) & 1) ? 2 : 1;
            for (int rep = 0; rep < reps; ++rep) { const bool dry = (rep + 1 < reps);
            if (rep) { xcd_barrier(xbar); lane = lane_id_asm(); }
            if (k == 0) {
                norm_phase(a, l, false, MT, gw, NGW, lane, l > 0 ? 8 : 0);
                if (l > 0) convert_stage_a(a, l, gw, NGW, (LAS float*)(lds + wave * WAVE_LDS), lane);
            } else if (k == 1) {
                pg8::Gemm g{H, WB, 1}; pg8::Order So; So.init(MT, WIN, G, blockIdx.x, 1, D);
                EpiIn E{P, (bf16_t*)(a.ws + WS_VTA), (bf16_t*)(a.ws + WS_VTS), dry && ((PROBE_MASK >> 16) & 1), (bf16_t*)(a.ws + WS_G)};
                #ifndef NO_EPIIN
                pg8::gemm_phase<EpiIn, D, D, D>(lds, g, So, E, wave, (int)((blockIdx.x >> 3) & 3) * STAGGER_TICKS);
#endif
            } else if (k == 2) {
                convert_stage_b(a, l, gw, NGW, (LAS float*)(lds + wave * WAVE_LDS), lane);
                rope_k_phase(a, gw, NGW, lane, dry);
                constexpr int N1 = NB * 66 * 8 * 2, N2 = N1 + NB * 128 * 8 * 4 / 2, N3 = N2 + NB * 8 * 16;
                unsigned* ctr = (unsigned*)(a.ws + WS_BAR) + 8 * (2 * l + 0 + 2 * NL * rep);
                for (;;) {
                    const int ln = lane_id_asm();
                    int it = 0; if (ln == 0) it = (int)__hip_atomic_fetch_add(ctr, 1u, __ATOMIC_RELAXED, __HIP_MEMORY_SCOPE_AGENT);
                    it = __builtin_amdgcn_readfirstlane(it);
                    if (it >= (lastl ? N2 : N3)) break;
                    if (it < N1) { if ((PROBE_MASK >> 12) & 1) lru_pass1_item(a, l, it, ln, lds + wave * WAVE_LDS); lru_pass1_item(a, l, it, ln, lds + wave * WAVE_LDS); }
                    else if (it < N2) { if ((PROBE_MASK >> 13) & 1) { na_item(a, l, 2 * (it - N1), lds + wave * WAVE_LDS, true); na_item(a, l, 2 * (it - N1) + 1, lds + wave * WAVE_LDS, true); } na_pair(a, l, it - N1, lds + wave * WAVE_LDS, dry); }
                    else ctx_item(a, l, it - N2, false, ln, lds + wave * WAVE_LDS, dry);
                }
            } else if (k == 3) {
                constexpr int N1 = NB * 66 * 8, N2 = N1 + NB * 4 * 512 / 2, N3 = N2 + NB * 8 * 16;
                unsigned* ctr = (unsigned*)(a.ws + WS_BAR) + 8 * (2 * l + 1 + 2 * NL * rep);
                for (;;) {
                    const int ln = lane_id_asm();
                    int it = 0; if (ln == 0) it = (int)__hip_atomic_fetch_add(ctr, 1u, __ATOMIC_RELAXED, __HIP_MEMORY_SCOPE_AGENT);
                    it = __builtin_amdgcn_readfirstlane(it);
                    if (it >= (lastl ? N2 : N3)) break;
                    if (it < N1) { if ((PROBE_MASK >> 14) & 1) lru_pass2_item(a, l, it, ln, lds + wave * WAVE_LDS, true); lru_pass2_item(a, l, it, ln, lds + wave * WAVE_LDS, dry); }
                    else if (it < N2) {
#pragma nounroll
                        for (int t2 = 0; t2 < 2; ++t2) swa_item(a, l, 2 * (it - N1) + t2, lds + wave * WAVE_LDS, dry); }
                    else ctx_item(a, l, it - N2, true, ln, lds + wave * WAVE_LDS, dry);
                }
            } else if (k == 4) {
                pg8::Gemm g{P, WB + WB_BR, 3}; pg8::Order So; So.init(Mrows, D, G, blockIdx.x, 3, 512);
                EpiMerge E{(const bf16_t*)(a.ws + WS_G), H};
                #ifndef NO_EPIMERGE
                pg8::gemm_phase<EpiMerge, PW, 512, 512, C_QA, C_GB, C_QS, 524288>(lds, g, So, E, wave);
#endif
            } else if (k == 5) {
                pg8::Gemm g{H, WB + WB_OUT, 1}; pg8::Order So; So.init(ML, D, G, blockIdx.x, 1, D, lastl ? 0 : MC / 256, 4);
                EpiRes E{a.out, a.ws, modl, 2, dry, l == 0 ? a.x : a.out};
#ifndef NO_EPIRES
                pg8::gemm_phase<EpiRes, D, D, D>(lds, g, So, E, wave);
#endif
            } else if (k == 8) {
                pg8::Gemm g{P, WB + WB_FF2, 1}; pg8::Order So; So.init(ML, D, G, blockIdx.x, 1, DFF, lastl ? 0 : MC / 256, 8);
                EpiRes E{a.out, a.ws, modl, 5, dry, a.out};
#ifndef NO_EPIRES
                pg8::gemm_phase<EpiRes, DFF, DFF, DFF>(lds, g, So, E, wave);
#endif
            } else if (k == 6) {
                norm_phase(a, l, true, Mrows, gw, NGW, lane, lastl ? 0 : 4);
            } else if (k == 7) {
                pg8::Gemm g{H, WB + WB_FF1, 1}; pg8::Order So; So.init(Mrows, DFF, G, blockIdx.x, 1, D);
                EpiFF1 E{P};
                #ifndef NO_EPIFF1
                pg8::gemm_phase<EpiFF1, D, D, D>(lds, g, So, E, wave, (int)((blockIdx.x >> 3) & 3) * STAGGER_TICKS);
#endif
            }
            }
        }
        if (ph + 1 < a.ph_hi) { if (ph == 0 || !USE_XCD_BAR) { __syncthreads(); grid.sync(); } else xcd_barrier(xbar); if ((PROBE_MASK >> 9) & 1) xcd_barrier(xbar); }
    }
}

extern "C" void kernel_launch(void* const* d_in, const int* in_sizes, int n_in, void* d_out, int out_size, void* d_ws, size_t ws_size, hipStream_t stream) {
    static int grid = 0;
    if (grid == 0) {
        if (n_in != 23 || ws_size < WS_END) { fprintf(stderr, "kernel_launch: unexpected n_in %d or ws_size %zu (< %zu)\n", n_in, ws_size, (size_t)WS_END); grid = -1; return; }
        int dev = 0, cus = 0, per_cu = 0;
        hipGetDevice(&dev); hipDeviceGetAttribute(&cus, hipDeviceAttributeMultiprocessorCount, dev);
        if (hipFuncSetAttribute((const void*)fwd_kernel, hipFuncAttributeMaxDynamicSharedMemorySize, LDS_BYTES) != hipSuccess) { fprintf(stderr, "hipFuncSetAttribute failed\n"); grid = -1; return; }
        if (hipOccupancyMaxActiveBlocksPerMultiprocessor(&per_cu, (const void*)fwd_kernel, 512, LDS_BYTES) != hipSuccess || per_cu < 1) { fprintf(stderr, "occupancy query: %d\n", per_cu); per_cu = 1; }
        (void)hipGetLastError();
        grid = cus;
    }
    if (grid < 0) return;
    KArgs a{};
    const float** f = (const float**)&a;
    for (int i = 0; i < 23; ++i) f[i] = (const float*)d_in[i];
    a.out = (float*)d_out; a.ws = (unsigned char*)d_ws;
#if N_LAUNCHES == 1
    a.ph_lo = 0; a.ph_hi = 38;
    if (hipMemsetAsync((unsigned char*)d_ws + WS_BAR, 0, XCD_BAR_WORDS * 4, stream) != hipSuccess) { fprintf(stderr, "memset failed\n"); return; }
    void* args[] = {&a};
    hipError_t e = hipLaunchCooperativeKernel((const void*)fwd_kernel, dim3(grid), dim3(512), args, LDS_BYTES, stream);
    if (e != hipSuccess) fprintf(stderr, "cooperative launch failed: %s (grid %d)\n", hipGetErrorString(e), grid);
#else
    for (int ph = 0; ph < 38; ++ph) { a.ph_lo = ph; a.ph_hi = ph + 1; hipLaunchKernelGGL(fwd_kernel, dim3(grid), dim3(512), LDS_BYTES, stream, a); }
#endif
}
```
